# Optimizing an MI355X kernel written in HIP

```python
import math
import jax
import jax.numpy as jnp
from jax import lax
import numpy as np

D_MODEL = 2048
BATCH = 4
SEQ = 2048
DEPTH = 4
DEC_BATCH = 128
DEC_SEQ = 1
PAST_LEN = 16384
PAGE_SIZE = 128

F32 = jnp.float32
N_AB = (DEPTH + 1) // 2
N_C = DEPTH // 2
A_HEAD_DIM = 64
A_WIDTH = D_MODEL // 2
A_HEADS = A_WIDTH // A_HEAD_DIM
LORA_W = 64
LORA_A = 64
LORA_G = 160
P_A = 3 * A_WIDTH + LORA_W + LORA_A + LORA_G
A_GN_EPS = 64e-5
B_WIDTH = D_MODEL - A_WIDTH
B_BLOCK_DIM = 64
B_BLOCKS = B_WIDTH // B_BLOCK_DIM
LRU_CONV = 4
LRU_C = 8.0
P_B = 2 * B_WIDTH
C_HEAD_K = 128
C_HEAD_V = 128
C_K_HEADS = D_MODEL // C_HEAD_K
C_V_HEADS = 2 * C_K_HEADS
C_KEY_DIM = C_K_HEADS * C_HEAD_K
C_VAL_DIM = C_V_HEADS * C_HEAD_V
C_QKV_DIM = 2 * C_KEY_DIM + C_VAL_DIM
C_CONV = 4
GDN_CHUNK = 64
P_C = C_QKV_DIM + C_VAL_DIM + 2 * C_V_HEADS
D_FF = 256 * (-(-8 * D_MODEL // (3 * 256)))
FFN_CONV = 3
NORM_EPS = 1e-6

kernel_name = 'hybrid_rwkv7_rglru_gdn_convffn_step'


def _rms_norm(x, gain):
    xf = x.astype(F32)
    y = xf * lax.rsqrt(jnp.mean(xf * xf, axis=-1, keepdims=True) + NORM_EPS)
    return (y * gain.astype(F32)).astype(x.dtype)


def _l2norm(t, eps):
    return t * lax.rsqrt(jnp.sum(t * t, axis=-1, keepdims=True) + eps)


def _causal_dwconv(x, buf, w, b=None):
    width = w.shape[0]
    T = x.shape[1]
    xp = jnp.concatenate([buf.astype(x.dtype), x], axis=1)
    y = sum(xp[:, j:j + T] * w[j] for j in range(width))
    if b is not None:
        y = y + b
    return y, xp[:, T:]


def _wkv7_scan(r, w, k, v, kk, a, S0):
    def step(S, xs):
        r_t, w_t, k_t, v_t, kk_t, a_t = xs
        s_kk = jnp.einsum('bhij,bhj->bhi', S, kk_t)
        S = (S * w_t[:, :, None, :] - s_kk[..., None] * (kk_t * a_t)[:, :, None, :]
             + v_t[..., None] * k_t[:, :, None, :])
        return S, jnp.einsum('bhij,bhj->bhi', S, r_t)
    xs = tuple(jnp.moveaxis(t, 1, 0) for t in (r, w, k, v, kk, a))
    S, ys = lax.scan(step, S0, xs)
    return jnp.moveaxis(ys, 0, 1), S


def _rwkv7_mix(p, prev, S0, mu, w0, w2, a0, a2, g2, k_k, k_a, r_k, gn_w, gn_b):
    Bsz, T, _ = p.shape
    p_prev = jnp.concatenate([prev[:, None].astype(p.dtype), p[:, :-1]], axis=1)
    pm = p + (p_prev - p) * mu
    r, k, v, xw, xa, xg = jnp.split(pm, [A_WIDTH, 2 * A_WIDTH, 3 * A_WIDTH, 3 * A_WIDTH + LORA_W,
                                         3 * A_WIDTH + LORA_W + LORA_A], axis=-1)
    w_ll = -jax.nn.softplus(-(w0 + jnp.tanh(xw) @ w2).astype(F32)) - 0.5
    decay = jnp.exp(-jnp.exp(w_ll))
    a = jax.nn.sigmoid((a0 + xa @ a2).astype(F32))
    g = (jax.nn.sigmoid(xg) @ g2).astype(F32)
    heads = lambda t: t.reshape(Bsz, T, A_HEADS, A_HEAD_DIM)
    kf = k.astype(F32)
    kk = _l2norm(heads(kf * k_k), 1e-12)
    kf = kf * (1.0 + (a - 1.0) * k_a)
    r_h, k_h, v_h, a_h, w_h = heads(r.astype(F32)), heads(kf), heads(v.astype(F32)), heads(a), heads(decay)
    y, S = _wkv7_scan(r_h, w_h, k_h, v_h, kk, a_h, S0.astype(F32))
    mean = jnp.mean(y, axis=-1, keepdims=True)
    var = jnp.mean(jnp.square(y - mean), axis=-1, keepdims=True)
    y = ((y - mean) * lax.rsqrt(var + A_GN_EPS)).reshape(Bsz, T, A_WIDTH) * gn_w + gn_b
    bonus = (jnp.sum(r_h * k_h * r_k, axis=-1, keepdims=True) * v_h).reshape(Bsz, T, A_WIDTH)
    y = (y + bonus) * g
    return y.astype(p.dtype), S, p[:, -1]


def _linear_scan(a, b, h0):
    b = b.at[:, 0].add(a[:, 0] * h0)
    def combine(lhs, rhs):
        a_l, b_l = lhs
        a_r, b_r = rhs
        return a_l * a_r, a_r * b_l + b_r
    _, h = lax.associative_scan(combine, (a, b), axis=1)
    return h, h[:, -1]


def _rglru_mix(p, conv_buf, h0, conv_w, conv_b, wa, ba, wx, bx, lam):
    gate, xb = jnp.split(p, 2, axis=-1)
    xc, new_buf = _causal_dwconv(xb, conv_buf, conv_w, conv_b)
    Bsz, T, _ = xc.shape
    xh = xc.reshape(Bsz, T, B_BLOCKS, B_BLOCK_DIM)
    r_gate = jax.nn.sigmoid((jnp.einsum('bthi,hij->bthj', xh, wa).reshape(Bsz, T, B_WIDTH) + ba).astype(F32))
    i_gate = jax.nn.sigmoid((jnp.einsum('bthi,hij->bthj', xh, wx).reshape(Bsz, T, B_WIDTH) + bx).astype(F32))
    log_a = -LRU_C * r_gate * jax.nn.softplus(-lam.astype(F32))
    a = jnp.exp(log_a)
    b = jnp.sqrt(-jnp.expm1(2.0 * log_a)) * (i_gate * xc.astype(F32))
    h, h_last = _linear_scan(a, b, h0.astype(F32))
    y = h * jax.nn.gelu(gate.astype(F32))
    return y.astype(p.dtype), new_buf, h_last


def _gated_delta_chunked(q, k, v, g, beta, S0):
    Bsz, T, H, DK = k.shape
    DV = v.shape[-1]
    C = min(GDN_CHUNK, T)
    n = -(-T // C)
    pad = n * C - T
    if pad:
        pt = lambda t: jnp.pad(t, [(0, 0), (0, pad)] + [(0, 0)] * (t.ndim - 2))
        q, k, v, g, beta = pt(q), pt(k), pt(v), pt(g), pt(beta)
    ch4 = lambda t: t.reshape(Bsz, n, C, H, t.shape[-1]).transpose(1, 0, 3, 2, 4)
    ch3 = lambda t: t.reshape(Bsz, n, C, H).transpose(1, 0, 3, 2)
    q, k, v = ch4(q), ch4(k), ch4(v)
    g, beta = ch3(g), ch3(beta)
    G = jnp.cumsum(g, axis=-1)
    idx = jnp.arange(C)
    incl = idx[:, None] >= idx[None, :]
    strict = idx[:, None] > idx[None, :]
    decay = jnp.exp(jnp.where(incl, G[..., :, None] - G[..., None, :], -jnp.inf))
    kb = k * beta[..., None]
    L = jnp.einsum('nbhid,nbhjd->nbhij', kb, k) * jnp.where(strict, decay, 0.0)
    eye = jnp.eye(C, dtype=L.dtype)
    rhs = jnp.concatenate([v * beta[..., None], kb * jnp.exp(G)[..., None]], axis=-1)
    sol = lax.linalg.triangular_solve(eye + L, rhs, left_side=True, lower=True, unit_diagonal=True)
    u, w = sol[..., :DV], sol[..., DV:]
    qk = jnp.einsum('nbhid,nbhjd->nbhij', q, k) * decay
    qg = q * jnp.exp(G)[..., None]
    k_tail = k * jnp.exp(G[..., -1:] - G)[..., None]
    g_end = jnp.exp(G[..., -1])
    def step(S, xs):
        u_c, w_c, qg_c, qk_c, kt_c, ge_c = xs
        v_new = u_c - jnp.einsum('bhcd,bhde->bhce', w_c, S)
        o = jnp.einsum('bhcd,bhde->bhce', qg_c, S) + jnp.einsum('bhij,bhje->bhie', qk_c, v_new)
        S = S * ge_c[..., None, None] + jnp.einsum('bhcd,bhce->bhde', kt_c, v_new)
        return S, o
    S, o = lax.scan(step, S0, (u, w, qg, qk, k_tail, g_end))
    o = o.transpose(1, 0, 3, 2, 4).reshape(Bsz, n * C, H, DV)[:, :T]
    return o, S


def _gdn_mix(p, conv_buf, S0, conv_w, a_log, dt_bias, norm_w):
    Bsz, T, _ = p.shape
    qkv, z, b, a = jnp.split(p, [C_QKV_DIM, C_QKV_DIM + C_VAL_DIM, C_QKV_DIM + C_VAL_DIM + C_V_HEADS], axis=-1)
    qkv, new_buf = _causal_dwconv(qkv, conv_buf, conv_w)
    qkv = jax.nn.silu(qkv.astype(F32))
    q = qkv[..., :C_KEY_DIM].reshape(Bsz, T, C_K_HEADS, C_HEAD_K)
    k = qkv[..., C_KEY_DIM:2 * C_KEY_DIM].reshape(Bsz, T, C_K_HEADS, C_HEAD_K)
    v = qkv[..., 2 * C_KEY_DIM:].reshape(Bsz, T, C_V_HEADS, C_HEAD_V)
    rep = C_V_HEADS // C_K_HEADS
    q = jnp.repeat(_l2norm(q, 1e-6) * (C_HEAD_K ** -0.5), rep, axis=2)
    k = jnp.repeat(_l2norm(k, 1e-6), rep, axis=2)
    beta = jax.nn.sigmoid(b.astype(F32))
    g = -jnp.exp(a_log.astype(F32)) * jax.nn.softplus(a.astype(F32) + dt_bias)
    o, S = _gated_delta_chunked(q, k, v, g, beta, S0.astype(F32))
    o = o * lax.rsqrt(jnp.mean(o * o, axis=-1, keepdims=True) + NORM_EPS) * norm_w
    o = o * jax.nn.silu(z.astype(F32).reshape(Bsz, T, C_V_HEADS, C_HEAD_V))
    return o.reshape(Bsz, T, C_VAL_DIM).astype(p.dtype), new_buf, S


def _conv_ffn(h, buf, w_gate, w_up, conv_w, conv_b, w_down):
    u, new_buf = _causal_dwconv(h @ w_gate, buf, conv_w, conv_b)
    return (jax.nn.gelu(u) * (h @ w_up)) @ w_down, new_buf


def _trunk(x, c, wkv0, shift0, lru_h0, lru_conv0, gdn0, gdn_conv0, ffn_conv0, prm):
    n_wkv, n_shift, n_h, n_lconv, n_gdn, n_gconv, n_fconv = [], [], [], [], [], [], []
    for layer in range(DEPTH):
        mod = jax.nn.silu(c) @ prm['w_mod'][layer] + prm['b_mod'][layer]
        sh1, sc1, gt1, sh2, sc2, gt2 = jnp.split(mod[:, None, :], 6, axis=-1)
        h = _rms_norm(x, prm['norm_mix'][layer]) * (1.0 + sc1) + sh1
        i = layer // 2
        if layer % 2 == 0:
            proj = h @ prm['w_in_ab'][i]
            ya, s_new, last = _rwkv7_mix(proj[..., :P_A], shift0[i], wkv0[i], prm['rwkv_mu'][i], prm['rwkv_w0'][i],
                                         prm['rwkv_w2'][i], prm['rwkv_a0'][i], prm['rwkv_a2'][i], prm['rwkv_g2'][i],
                                         prm['rwkv_k_k'][i], prm['rwkv_k_a'][i], prm['rwkv_r_k'][i],
                                         prm['rwkv_gn_w'][i], prm['rwkv_gn_b'][i])
            yb, lbuf, h_last = _rglru_mix(proj[..., P_A:], lru_conv0[i], lru_h0[i], prm['lru_conv_w'][i],
                                          prm['lru_conv_b'][i], prm['lru_wa'][i], prm['lru_ba'][i],
                                          prm['lru_wx'][i], prm['lru_bx'][i], prm['lru_lambda'][i])
            mix = jnp.concatenate([ya, yb], axis=-1) @ prm['w_out_ab'][i]
            n_wkv.append(s_new)
            n_shift.append(last)
            n_h.append(h_last)
            n_lconv.append(lbuf)
        else:
            proj = h @ prm['w_in_c'][i]
            yc, gbuf, s_new = _gdn_mix(proj, gdn_conv0[i], gdn0[i], prm['gdn_conv_w'][i], prm['gdn_a_log'][i],
                                       prm['gdn_dt_bias'][i], prm['gdn_norm_w'][i])
            mix = yc @ prm['w_out_c'][i]
            n_gdn.append(s_new)
            n_gconv.append(gbuf)
        x = x + gt1 * mix
        h = _rms_norm(x, prm['norm_ffn'][layer]) * (1.0 + sc2) + sh2
        f, fbuf = _conv_ffn(h, ffn_conv0[layer], prm['ffn_w_gate'][layer], prm['ffn_w_up'][layer],
                            prm['ffn_conv_w'][layer], prm['ffn_conv_b'][layer], prm['ffn_w_down'][layer])
        x = x + gt2 * f
        n_fconv.append(fbuf)
    y = _rms_norm(x, prm['norm_out'])
    stk = lambda lst, like: jnp.stack(lst).astype(like.dtype)
    return (y, stk(n_wkv, wkv0), stk(n_shift, shift0), stk(n_h, lru_h0), stk(n_lconv, lru_conv0),
            stk(n_gdn, gdn0), stk(n_gconv, gdn_conv0), stk(n_fconv, ffn_conv0))


def setup_inputs(seed: int = 0) -> dict:
    key = jax.random.key(seed)
    keys = jax.random.split(key, 64)
    counter = iter(range(64))
    D = D_MODEL

    def nrm(shape, scale=1.0):
        return scale * jax.random.normal(keys[next(counter)], shape, F32)

    def uni(shape, lo, hi):
        return jax.random.uniform(keys[next(counter)], shape, F32, lo, hi)

    inp = {
        'x_prompt': nrm((BATCH, SEQ, D)),
        'x_sample': nrm((DEC_BATCH, DEC_SEQ, D)),
        'c_prompt': nrm((BATCH, D)),
        'c_sample': nrm((DEC_BATCH, D)),
        'state_rwkv_wkv': nrm((N_AB, DEC_BATCH, A_HEADS, A_HEAD_DIM, A_HEAD_DIM), 0.3),
        'state_rwkv_shift': nrm((N_AB, DEC_BATCH, P_A)),
        'state_lru_h': nrm((N_AB, DEC_BATCH, B_WIDTH), 0.5),
        'state_lru_conv': nrm((N_AB, DEC_BATCH, LRU_CONV - 1, B_WIDTH)),
        'state_gdn': nrm((N_C, DEC_BATCH, C_V_HEADS, C_HEAD_K, C_HEAD_V), 0.1),
        'state_gdn_conv': nrm((N_C, DEC_BATCH, C_CONV - 1, C_QKV_DIM)),
        'state_ffn_conv': nrm((DEPTH, DEC_BATCH, FFN_CONV - 1, D_FF)),
        'w_mod': nrm((DEPTH, D, 6 * D), 0.5 * D ** -0.5),
        'b_mod': nrm((DEPTH, 6 * D), 0.05),
        'norm_mix': 1.0 + nrm((DEPTH, D), 0.05),
        'norm_ffn': 1.0 + nrm((DEPTH, D), 0.05),
        'norm_out': 1.0 + nrm((D,), 0.05),
        'w_in_ab': nrm((N_AB, D, P_A + P_B), D ** -0.5),
        'w_out_ab': nrm((N_AB, A_WIDTH + B_WIDTH, D), (A_WIDTH + B_WIDTH) ** -0.5),
        'rwkv_mu': uni((N_AB, P_A), 0.0, 1.0),
        'rwkv_w0': uni((N_AB, A_WIDTH), -4.0, 1.5),
        'rwkv_w2': nrm((N_AB, LORA_W, A_WIDTH), 0.1 * LORA_W ** -0.5),
        'rwkv_a0': nrm((N_AB, A_WIDTH), 0.1),
        'rwkv_a2': nrm((N_AB, LORA_A, A_WIDTH), LORA_A ** -0.5),
        'rwkv_g2': nrm((N_AB, LORA_G, A_WIDTH), LORA_G ** -0.5),
        'rwkv_k_k': 0.85 + nrm((N_AB, A_WIDTH), 0.05),
        'rwkv_k_a': 1.0 + nrm((N_AB, A_WIDTH), 0.05),
        'rwkv_r_k': nrm((N_AB, A_HEADS, A_HEAD_DIM), 0.1),
        'rwkv_gn_w': 1.0 + nrm((N_AB, A_WIDTH), 0.05),
        'rwkv_gn_b': nrm((N_AB, A_WIDTH), 0.02),
        'lru_conv_w': nrm((N_AB, LRU_CONV, B_WIDTH), LRU_CONV ** -0.5),
        'lru_conv_b': nrm((N_AB, B_WIDTH), 0.02),
        'lru_wa': nrm((N_AB, B_BLOCKS, B_BLOCK_DIM, B_BLOCK_DIM), B_BLOCK_DIM ** -0.5),
        'lru_ba': nrm((N_AB, B_WIDTH), 0.02),
        'lru_wx': nrm((N_AB, B_BLOCKS, B_BLOCK_DIM, B_BLOCK_DIM), B_BLOCK_DIM ** -0.5),
        'lru_bx': nrm((N_AB, B_WIDTH), 0.02),
    }
    a_base = uni((N_AB, B_WIDTH), 0.9, 0.999) ** (1.0 / LRU_C)
    inp['lru_lambda'] = jnp.log(a_base) - jnp.log1p(-a_base)
    inp['w_in_c'] = nrm((N_C, D, P_C), D ** -0.5)
    inp['w_out_c'] = nrm((N_C, C_VAL_DIM, D), C_VAL_DIM ** -0.5)
    inp['gdn_conv_w'] = nrm((N_C, C_CONV, C_QKV_DIM), C_CONV ** -0.5)
    inp['gdn_a_log'] = jnp.log(uni((N_C, C_V_HEADS), 1.0, 16.0))
    dt = jnp.exp(uni((N_C, C_V_HEADS), math.log(1e-3), math.log(1e-1)))
    inp['gdn_dt_bias'] = dt + jnp.log(-jnp.expm1(-dt))
    inp['gdn_norm_w'] = 1.0 + nrm((N_C, C_HEAD_V), 0.05)
    inp['ffn_w_gate'] = nrm((DEPTH, D, D_FF), D ** -0.5)
    inp['ffn_w_up'] = nrm((DEPTH, D, D_FF), D ** -0.5)
    inp['ffn_conv_w'] = nrm((DEPTH, FFN_CONV, D_FF), FFN_CONV ** -0.5)
    inp['ffn_conv_b'] = nrm((DEPTH, D_FF), 0.02)
    inp['ffn_w_down'] = nrm((DEPTH, D_FF, D), D_FF ** -0.5)
    return inp


def reference(x_prompt, x_sample, c_prompt, c_sample, state_rwkv_wkv, state_rwkv_shift, state_lru_h,
              state_lru_conv, state_gdn, state_gdn_conv, state_ffn_conv, w_mod, b_mod, norm_mix, norm_ffn,
              norm_out, w_in_ab, w_out_ab, rwkv_mu, rwkv_w0, rwkv_w2, rwkv_a0, rwkv_a2, rwkv_g2, rwkv_k_k,
              rwkv_k_a, rwkv_r_k, rwkv_gn_w, rwkv_gn_b, lru_conv_w, lru_conv_b, lru_wa, lru_ba, lru_wx, lru_bx,
              lru_lambda, w_in_c, w_out_c, gdn_conv_w, gdn_a_log, gdn_dt_bias, gdn_norm_w, ffn_w_gate,
              ffn_w_up, ffn_conv_w, ffn_conv_b, ffn_w_down):
    prm = dict(w_mod=w_mod, b_mod=b_mod, norm_mix=norm_mix, norm_ffn=norm_ffn, norm_out=norm_out,
               w_in_ab=w_in_ab, w_out_ab=w_out_ab, rwkv_mu=rwkv_mu, rwkv_w0=rwkv_w0, rwkv_w2=rwkv_w2,
               rwkv_a0=rwkv_a0, rwkv_a2=rwkv_a2, rwkv_g2=rwkv_g2, rwkv_k_k=rwkv_k_k, rwkv_k_a=rwkv_k_a,
               rwkv_r_k=rwkv_r_k, rwkv_gn_w=rwkv_gn_w, rwkv_gn_b=rwkv_gn_b, lru_conv_w=lru_conv_w,
               lru_conv_b=lru_conv_b, lru_wa=lru_wa, lru_ba=lru_ba, lru_wx=lru_wx, lru_bx=lru_bx,
               lru_lambda=lru_lambda, w_in_c=w_in_c, w_out_c=w_out_c, gdn_conv_w=gdn_conv_w,
               gdn_a_log=gdn_a_log, gdn_dt_bias=gdn_dt_bias, gdn_norm_w=gdn_norm_w, ffn_w_gate=ffn_w_gate,
               ffn_w_up=ffn_w_up, ffn_conv_w=ffn_conv_w, ffn_conv_b=ffn_conv_b, ffn_w_down=ffn_w_down)
    bp = x_prompt.shape[0]
    zero = lambda st: jnp.zeros((st.shape[0], bp) + st.shape[2:], st.dtype)
    (y_prompt, p_wkv, p_shift, p_lru_h, p_lru_conv, p_gdn, p_gdn_conv, p_ffn_conv) = _trunk(
        x_prompt, c_prompt, zero(state_rwkv_wkv), zero(state_rwkv_shift), zero(state_lru_h),
        zero(state_lru_conv), zero(state_gdn), zero(state_gdn_conv), zero(state_ffn_conv), prm)
    (y_sample, s_wkv, s_shift, s_lru_h, s_lru_conv, s_gdn, s_gdn_conv, s_ffn_conv) = _trunk(
        x_sample, c_sample, state_rwkv_wkv, state_rwkv_shift, state_lru_h, state_lru_conv, state_gdn,
        state_gdn_conv, state_ffn_conv, prm)
    return (y_prompt, y_sample, p_wkv, p_shift, p_lru_h, p_lru_conv, p_gdn, p_gdn_conv, p_ffn_conv,
            s_wkv, s_shift, s_lru_h, s_lru_conv, s_gdn, s_gdn_conv, s_ffn_conv)
```

```cpp
#include <hip/hip_runtime.h>
#include <cstdio>
#include <cstdint>

#define GAS __attribute__((address_space(1)))
#define LAS __attribute__((address_space(3)))
typedef unsigned short bf16_t;
typedef short bf16x8 __attribute__((ext_vector_type(8)));
typedef float f32x4 __attribute__((ext_vector_type(4)));
typedef float f32x2 __attribute__((ext_vector_type(2)));
typedef unsigned u32x4 __attribute__((ext_vector_type(4)));
typedef unsigned u32x2 __attribute__((ext_vector_type(2)));

constexpr int D = 2048, SEQ = 2048, NBP = 4, NBS = 128;
constexpr int MP = NBP * SEQ;
constexpr int MV = MP + NBS;
constexpr int MPAD = 8448;
constexpr int NSEQ = NBP + NBS;
constexpr int PA = 3360, PAB = 5408, PAB_PAD = 5632, XB_OFF = 4384, GATE_OFF = 3360;
constexpr int PC = 12352, PC_PAD = 12544, QKV = 8192, Z_OFF = 8192, B_OFF = 12288, A_OFF = 12320;
constexpr int DFF = 5632;
constexpr int MODLD = 4 * 6 * D;

enum { I_XP = 0, I_XS, I_CP, I_CS, I_SWKV, I_SSHIFT, I_SLRUH, I_SLRUC, I_SGDN, I_SGDNC, I_SFFNC, I_WMOD, I_BMOD, I_NMIX, I_NFFN, I_NOUT,
       I_WINAB, I_WOUTAB, I_MU, I_W0, I_W2, I_A0, I_A2, I_G2, I_KK, I_KA, I_RK, I_GNW, I_GNB, I_LCW, I_LCB, I_LWA, I_LBA, I_LWX, I_LBX, I_LLAM,
       I_WINC, I_WOUTC, I_GCW, I_GALOG, I_GDTB, I_GNORM, I_FWG, I_FWU, I_FCW, I_FCB, I_FWD, N_IN };

constexpr size_t O_YP = 0, O_YS = 16777216, O_PWKV = 17039360, O_PSHIFT = 17563648, O_PLRUH = 17590528, O_PLRUC = 17598720, O_PGDN = 17623296,
                 O_PGDNC = 21817600, O_PFFNC = 22014208, O_SWKV = 22194432, O_SSHIFT = 38971648, O_SLRUH = 39831808, O_SLRUC = 40093952,
                 O_SGDN = 40880384, O_SGDNC = 175098112, O_SFFNC = 181389568, O_TOTAL = 187156736;

constexpr size_t al256(size_t x) { return (x + 255) & ~(size_t)255; }
constexpr size_t WS_CTL = 0, CTL_BYTES = 1 << 20;
constexpr size_t WS_WINAB = WS_CTL + CTL_BYTES;
constexpr size_t WS_WOUTAB = WS_WINAB + (size_t)2 * PAB_PAD * D * 2;
constexpr size_t WS_WINC = WS_WOUTAB + (size_t)2 * D * D * 2;
constexpr size_t WS_WOUTC = WS_WINC + (size_t)2 * PC_PAD * D * 2;
constexpr size_t WS_WGATE = WS_WOUTC + (size_t)2 * D * 4096 * 2;
constexpr size_t WS_WUP = WS_WGATE + (size_t)4 * DFF * D * 2;
constexpr size_t WS_WDOWN = WS_WUP + (size_t)4 * DFF * D * 2;
constexpr size_t WS_W2T = WS_WDOWN + (size_t)4 * D * DFF * 2;
constexpr size_t WS_A2T = WS_W2T + (size_t)2 * 1024 * 64 * 2;
constexpr size_t WS_G2T = WS_A2T + (size_t)2 * 1024 * 64 * 2;
constexpr size_t WS_WAT = WS_G2T + (size_t)2 * 1024 * 160 * 2;
constexpr size_t WS_WXT = WS_WAT + (size_t)2 * 16 * 64 * 64 * 2;
constexpr size_t WS_SC = WS_WXT + (size_t)2 * 16 * 64 * 64 * 2;
constexpr size_t WS_MOD = WS_SC + (size_t)256 * D * 2;
constexpr size_t WS_X = WS_MOD + (size_t)256 * MODLD * 4;
constexpr size_t WS_H = WS_X + (size_t)MPAD * D * 4;
constexpr size_t WS_PROJ = WS_H + (size_t)MPAD * D * 2;
constexpr size_t WS_YE = WS_PROJ + (size_t)MPAD * PC_PAD * 4;
constexpr size_t WS_YO = WS_YE + (size_t)MPAD * D * 2;
constexpr size_t WS_GBUF = WS_YO + (size_t)MPAD * 4096 * 2;
constexpr size_t WS_ACT = WS_GBUF + (size_t)MPAD * DFF * 4;
constexpr size_t WS_MIX = WS_ACT + (size_t)MPAD * DFF * 2;
constexpr size_t WS_WMOD = WS_MIX;
constexpr size_t MX_SCB = 0;
constexpr size_t MX_GG = MX_SCB + (size_t)16 * MV * 384 * 4;
constexpr size_t MX_C123 = MX_GG + (size_t)MV * 1024 * 4;
constexpr size_t MX_YRAW = MX_C123 + (size_t)MV * 64 * 4;
constexpr size_t MX_LA = MX_YRAW + (size_t)MV * 1024 * 4;
constexpr size_t MX_LB = MX_LA + (size_t)MV * 1024 * 4;
constexpr size_t MX_HL = MX_LB + (size_t)MV * 1024 * 4;
constexpr size_t MX_PP = MX_HL + (size_t)MV * 1024 * 4;
constexpr size_t MX_HEND = MX_PP + (size_t)MV * 1024 * 4;
constexpr size_t MX_PEND = MX_HEND + (size_t)128 * 1024 * 4;
constexpr size_t MX_CARRY = MX_PEND + (size_t)128 * 1024 * 4;
constexpr size_t MX_EVEN_END = MX_CARRY + (size_t)128 * 1024 * 4;
constexpr size_t MX_QN = 0;
constexpr size_t MX_KN = MX_QN + (size_t)MPAD * D * 2;
constexpr size_t MX_KT = MX_KN + (size_t)MPAD * D * 2;
constexpr size_t MX_VT = MX_KT + (size_t)4 * 16 * 32 * 128 * 64 * 2;
constexpr size_t MX_VNAT = MX_VT + (size_t)4 * 32 * 32 * 128 * 64 * 2;
constexpr size_t MX_BETA = MX_VNAT + (size_t)128 * 4096 * 4;
constexpr size_t MX_GL = MX_BETA + (size_t)MV * 32 * 4;
constexpr size_t MX_U = MX_GL + (size_t)MV * 32 * 4;
constexpr size_t MX_W = MX_U + (size_t)4096 * 64 * 128 * 2;
constexpr size_t MX_O = MX_W + (size_t)4096 * 64 * 128 * 2;
constexpr size_t MX_ODD_END = MX_O + (size_t)MV * 4096 * 4;
constexpr size_t MX_SIZE = (MX_EVEN_END > MX_ODD_END ? MX_EVEN_END : MX_ODD_END) > (size_t)MODLD * D * 2 ? (MX_EVEN_END > MX_ODD_END ? MX_EVEN_END : MX_ODD_END) : (size_t)MODLD * D * 2;
constexpr size_t WS_END = WS_MIX + MX_SIZE;
static_assert(WS_END <= (size_t)2147483648u, "workspace map exceeds 2 GiB");

constexpr int LDS_BYTES = 152 * 1024;
constexpr int NT = 512;

struct P { const float* in[N_IN]; float* out; unsigned char* ws; };

__device__ __forceinline__ float bf2f(unsigned b) { return __uint_as_float(b << 16); }
__device__ __forceinline__ unsigned f2bf(float f) { unsigned u = __float_as_uint(f); return (u + 0x7fffu + ((u >> 16) & 1u)) >> 16; }
__device__ __forceinline__ unsigned pk2(float lo, float hi) { return f2bf(lo) | (f2bf(hi) << 16); }
__device__ __forceinline__ float sigmoid_(float x) { return 1.f / (1.f + __expf(-x)); }
__device__ __forceinline__ float softplus_(float x) { return x > 15.f ? x : log1pf(__expf(x)); }
__device__ __forceinline__ float silu_(float x) { return x * sigmoid_(x); }
__device__ __forceinline__ float gelu_tanh_(float x) { const float u = 0.7978845608028654f * (x + 0.044715f * x * x * x); return x * sigmoid_(2.f * u); }
__device__ __forceinline__ float tanh_(float x) { return 1.f - 2.f / (1.f + __expf(2.f * x)); }
__device__ __forceinline__ float wave_sum(float v) {
#pragma unroll
    for (int o = 1; o < 64; o <<= 1) v += __shfl_xor(v, o);
    return v;
}
template <int CTRL> __device__ __forceinline__ float dpp_add(float v) {
    const int t = __builtin_amdgcn_update_dpp(0, __float_as_int(v), CTRL, 0xF, 0xF, true);
    return v + __int_as_float(t);
}
__device__ __forceinline__ float allreduce4(float v) { v = dpp_add<0xB1>(v); v = dpp_add<0x4E>(v); return v; }
__device__ __forceinline__ float allreduce8(float v) { v = allreduce4(v); v = dpp_add<0x141>(v); return v; }
__device__ __forceinline__ float allreduce16(float v) { v = allreduce8(v); v = dpp_add<0x140>(v); return v; }
__device__ __forceinline__ f32x4 mfma16(bf16x8 a, bf16x8 b, f32x4 c) { return __builtin_amdgcn_mfma_f32_16x16x32_bf16(a, b, c, 0, 0, 0); }
__device__ __forceinline__ int bidx_of(int r) { const int s = 4 + r - MP; return r < MP ? (r >> 11) : (s < 255 ? s : 255); }
namespace pg8 {
#define PG8_LAS __attribute__((address_space(3)))
typedef unsigned short bf16_t;
typedef short bf16x8 __attribute__((ext_vector_type(8)));
typedef float f32x4 __attribute__((ext_vector_type(4)));
typedef unsigned u32x4 __attribute__((ext_vector_type(4)));
constexpr int BM = 256, BK = 64, HALF = 128, HTB = HALF * BK * 2  , STAGE_BYTES = 8 * HTB, NXCD = 8, WGM = 8;

__host__ __device__ __forceinline__ int lds_byte(int r, int c) { const int st = (r >> 4) * 2 + (c >> 5), rr = r & 15, cc = c & 31, ob = rr * 64 + cc * 2; return st * 1024 + (ob ^ (((ob >> 9) & 1) << 5)); }
__host__ __device__ __forceinline__ void stage_rc(int b, int& R, int& C) { const int st = b / 1024, sb = b % 1024, swz = sb ^ (((sb >> 9) & 1) << 5); R = (st >> 1) * 16 + swz / 64; C = (st & 1) * 32 + (swz % 64) / 2; }
__host__ __device__ __forceinline__ int perm32(int rho) { const int n = rho >> 4, i = rho & 15; return 8 * (i >> 2) + 4 * n + (i & 3); }

struct Unit { int pm, pn; };
struct Gemm { const bf16_t* A; const bf16_t* Bt; int M, N, K; };

struct StaticOrder {
    int nM, nN, nwg, G, c;
    __host__ __device__ void init(int M, int N, int G_, int c_) { nM = M / BM; nN = N / BM; nwg = nM * nN; G = G_; c = c_; }
    __host__ __device__ bool next(int i, Unit& u) const {
        const long L = (long)i * G + c; if (L >= nwg) return false;
        int wgid = (int)L; { const int q = nwg / NXCD, r = nwg % NXCD, xcd = wgid % NXCD, off = wgid / NXCD; wgid = (xcd < r ? xcd * (q + 1) : r * (q + 1) + (xcd - r) * q) + off; }
        const int nig = WGM * nN, gid = wgid / nig, fm = gid * WGM, gsz = (nM - fm) < WGM ? (nM - fm) : WGM;
        u.pm = fm + ((wgid % nig) % gsz); u.pn = (wgid % nig) / gsz; return true;
    }
    __device__ __forceinline__ void a_ready(const Unit&) const {}
    __device__ __forceinline__ void done(const Unit&) const {}
};

__device__ __forceinline__ unsigned cvt_pk_bf16(float lo, float hi) { unsigned r; asm volatile("v_cvt_pk_bf16_f32 %0, %1, %2" : "=v"(r) : "v"(lo), "v"(hi)); return r; }

struct EpiF32 {
    static constexpr bool PERM = false, AFTER_DRAIN = false;
    float* C; int ldc; const float* bias;
    __device__ __forceinline__ void operator()(const f32x4 (&acc)[2][2][4][2], const Unit& u, int wr, int wc, int fr, int fq) const {
        const int row0 = u.pm * BM + wr * 64 + fr, col0 = u.pn * BM + wc * 32 + 4 * fq;
        f32x4 bv[2][2];
#pragma unroll
        for (int bj = 0; bj < 2; ++bj)
#pragma unroll
            for (int n = 0; n < 2; ++n) bv[bj][n] = bias ? *(const f32x4*)(bias + col0 + bj * HALF + n * 16) : (f32x4){0.f, 0.f, 0.f, 0.f};
#pragma unroll
        for (int ai = 0; ai < 2; ++ai)
#pragma unroll
            for (int m = 0; m < 4; ++m) { float* rowp = C + (size_t)(row0 + ai * HALF + m * 16) * ldc + col0;
#pragma unroll
                for (int bj = 0; bj < 2; ++bj)
#pragma unroll
                    for (int n = 0; n < 2; ++n) *(f32x4*)(rowp + bj * HALF + n * 16) = acc[ai][bj][m][n] + bv[bj][n]; }
    }
};

struct EpiResid {
    static constexpr bool PERM = false, AFTER_DRAIN = false;
    float* X; const float* gate;
    __device__ __forceinline__ void operator()(const f32x4 (&acc)[2][2][4][2], const Unit& u, int wr, int wc, int fr, int fq) const {
        const int row0 = u.pm * BM + wr * 64 + fr, col0 = u.pn * BM + wc * 32 + 4 * fq;
#pragma unroll
        for (int ai = 0; ai < 2; ++ai)
#pragma unroll
            for (int m = 0; m < 4; ++m) { const int r = row0 + ai * HALF + m * 16; const int s = 4 + r - 8192; const int bi = r < 8192 ? (r >> 11) : (s < 255 ? s : 255);
                float* xp = X + (size_t)r * 2048 + col0; const float* gp = gate + (size_t)bi * 49152 + col0;
#pragma unroll
                for (int bj = 0; bj < 2; ++bj)
#pragma unroll
                    for (int n = 0; n < 2; ++n) { const int o = bj * HALF + n * 16; const f32x4 g = *(const f32x4*)(gp + o); f32x4 x = *(const f32x4*)(xp + o); x = x + g * acc[ai][bj][m][n]; *(f32x4*)(xp + o) = x; } }
    }
};

struct EpiFfnUp {
    static constexpr bool PERM = true, AFTER_DRAIN = false;
    bf16_t* O; const float* G; const float* cw; const float* cb; const float* sbuf;
    __device__ __forceinline__ void operator()(const f32x4 (&acc)[2][2][4][2], const Unit& u, int wr, int wc, int fr, int fq) const {
        const int row0 = u.pm * BM + wr * 64 + fr, col0 = u.pn * BM + wc * 32 + 8 * fq;
#pragma unroll
        for (int bj = 0; bj < 2; ++bj) {
            const int c = col0 + bj * HALF;
            f32x4 w0[2], w1[2], w2[2], bb[2];
#pragma unroll
            for (int n = 0; n < 2; ++n) { w0[n] = *(const f32x4*)(cw + c + 4 * n); w1[n] = *(const f32x4*)(cw + 5632 + c + 4 * n); w2[n] = *(const f32x4*)(cw + 2 * 5632 + c + 4 * n); bb[n] = *(const f32x4*)(cb + c + 4 * n); }
#pragma unroll
            for (int ai = 0; ai < 2; ++ai)
#pragma unroll
                for (int m = 0; m < 4; ++m) {
                    const int r = row0 + ai * HALF + m * 16;
                    const float* g0p = G + (size_t)r * 5632 + c; const float* g1p; const float* g2p; bool h1, h2;
                    if (r < 8192) { const int t = r & 2047; h1 = t >= 1; h2 = t >= 2; g1p = g0p - 5632; g2p = g0p - 2 * 5632; }
                    else { const int b = r - 8192; h1 = h2 = (b < 128); const int bb_ = b < 128 ? b : 0; g1p = sbuf + ((size_t)bb_ * 2 + 1) * 5632 + c; g2p = sbuf + ((size_t)bb_ * 2 + 0) * 5632 + c; }
                    u32x4 w;
#pragma unroll
                    for (int n = 0; n < 2; ++n) {
                        const f32x4 g0 = *(const f32x4*)(g0p + 4 * n);
                        const f32x4 g1 = h1 ? *(const f32x4*)(g1p + 4 * n) : (f32x4){0.f, 0.f, 0.f, 0.f};
                        const f32x4 g2 = h2 ? *(const f32x4*)(g2p + 4 * n) : (f32x4){0.f, 0.f, 0.f, 0.f};
                        const f32x4 uu = w0[n] * g2 + w1[n] * g1 + w2[n] * g0 + bb[n];
                        f32x4 o;
#pragma unroll
                        for (int j = 0; j < 4; ++j) { const float x = uu[j]; const float z = 0.7978845608028654f * (x + 0.044715f * x * x * x); o[j] = x / (1.f + __expf(-2.f * z)) * acc[ai][bj][m][n][j]; }
                        if (n == 0) { w.x = cvt_pk_bf16(o[0], o[1]); w.y = cvt_pk_bf16(o[2], o[3]); } else { w.z = cvt_pk_bf16(o[0], o[1]); w.w = cvt_pk_bf16(o[2], o[3]); }
                    }
                    *(u32x4*)(O + (size_t)r * 5632 + c) = w;
                }
        }
    }
};
template <class Epi, class Sched, bool ALIGN_EPI = false, bool SP2 = false>
__device__ __forceinline__ void gemm_phase(PG8_LAS unsigned char* lds, const Gemm g, const Sched& S, const Epi& E) {
    const int tid = threadIdx.x, wid = __builtin_amdgcn_readfirstlane(tid >> 6), lane = tid & 63, wr = wid >> 2, wc = wid & 3, fr = lane & 15, fq = lane >> 4;
    const int K = g.K, nt = K / BK;
    unsigned voffA[2], voffB[2];
#pragma unroll
    for (int i = 0; i < 2; ++i) { int R, C; stage_rc(tid * 16 + i * 8192, R, C); const int Rb = Epi::PERM ? ((R & ~31) + perm32(R & 31)) : R;
        voffA[i] = (unsigned)(R * K + C) * 2u; voffB[i] = (unsigned)(Rb * K + C) * 2u; }
    const size_t kstep = (size_t)(BK * 2);
    const size_t hstep = (size_t)HALF * K * 2;
    const size_t tstep = 2 * hstep;
    const unsigned ldsw = (unsigned)wid * 1024u;
    const int aoff = lds_byte(wr * 64 + fr, fq * 8), boff = lds_byte(wc * 32 + fr, fq * 8);
#define PG8_SA(b, h) (((b) * 2 + (h)) * HTB)
#define PG8_SB(b, h) ((4 + (b) * 2 + (h)) * HTB)
#define PG8_STAGE(bufoff, gbase, voff) do { _Pragma("unroll") for (int _i = 0; _i < 2; ++_i) \
        __builtin_amdgcn_global_load_lds((const unsigned*)((const char*)(gbase) + (voff)[_i]), (PG8_LAS unsigned*)(lds + (bufoff) + ldsw + _i * 8192), 16, 0, 0); } while (0)
#define PG8_LDA(dst, b, h) do { _Pragma("unroll") for (int m = 0; m < 4; ++m) _Pragma("unroll") for (int k = 0; k < 2; ++k) dst[m][k] = *(const PG8_LAS bf16x8*)(lds + PG8_SA(b, h) + aoff + m * 2048 + k * 1024); } while (0)
#define PG8_LDB(dst, b, h) do { _Pragma("unroll") for (int n = 0; n < 2; ++n) _Pragma("unroll") for (int k = 0; k < 2; ++k) dst[n][k] = *(const PG8_LAS bf16x8*)(lds + PG8_SB(b, h) + boff + n * 2048 + k * 1024); } while (0)
#define PG8_MMA(ai, bj, At, Bt) do { __builtin_amdgcn_s_setprio(1); _Pragma("unroll") for (int m = 0; m < 4; ++m) _Pragma("unroll") for (int n = 0; n < 2; ++n) _Pragma("unroll") for (int k = 0; k < 2; ++k) \
        acc[ai][bj][m][n] = __builtin_amdgcn_mfma_f32_16x16x32_bf16(Bt[n][k], At[m][k], acc[ai][bj][m][n], 0, 0, 0); __builtin_amdgcn_s_setprio(0); } while (0)
#define PG8_WAIT_V(n) asm volatile("s_waitcnt vmcnt(" #n ")" ::: "memory")
#define PG8_WAIT_L(n) asm volatile("s_waitcnt lgkmcnt(" #n ")" ::: "memory")
#define PG8_BAR __builtin_amdgcn_s_barrier()
#define PG8_SCHED __builtin_amdgcn_sched_barrier(0)
    Unit cur, nxt; int ui = 0;
    if (!S.next(0, cur)) return;
    f32x4 acc[2][2][4][2];
#pragma unroll
    for (int a = 0; a < 2; ++a)
#pragma unroll
        for (int b = 0; b < 2; ++b)
#pragma unroll
            for (int m = 0; m < 4; ++m)
#pragma unroll
                for (int n = 0; n < 2; ++n) acc[a][b][m][n] = (f32x4){0.f, 0.f, 0.f, 0.f};
    bf16x8 At[4][2], B0[2][2], B1[2][2];
    const char* cA = (const char*)g.A + (size_t)cur.pm * tstep; const char* cB = (const char*)g.Bt + (size_t)cur.pn * tstep;
    S.a_ready(cur);
    if constexpr (SP2) {
        PG8_STAGE(PG8_SB(0, 0), cB, voffB); PG8_STAGE(PG8_SB(0, 1), cB + hstep, voffB); PG8_STAGE(PG8_SA(0, 0), cA, voffA); PG8_STAGE(PG8_SA(0, 1), cA + hstep, voffA);
        if (wr == 1) PG8_BAR;
        PG8_WAIT_V(2); PG8_BAR;
        PG8_STAGE(PG8_SB(1, 0), cB + kstep, voffB); PG8_STAGE(PG8_SA(1, 0), cA + kstep, voffA); PG8_STAGE(PG8_SB(1, 1), cB + hstep + kstep, voffB);
        PG8_WAIT_V(6); PG8_BAR;
    } else {
        PG8_STAGE(PG8_SB(0, 0), cB, voffB); PG8_STAGE(PG8_SA(0, 0), cA, voffA); PG8_STAGE(PG8_SB(0, 1), cB + hstep, voffB); PG8_STAGE(PG8_SA(0, 1), cA + hstep, voffA);
        if (wr == 1) PG8_BAR;
        PG8_WAIT_V(4); PG8_BAR;
        PG8_STAGE(PG8_SB(1, 0), cB + kstep, voffB); PG8_STAGE(PG8_SA(1, 0), cA + kstep, voffA); PG8_STAGE(PG8_SB(1, 1), cB + hstep + kstep, voffB);
        PG8_WAIT_V(6); PG8_BAR;
    }
    for (;;) {
        const bool has_next = S.next(ui + 1, nxt);
        const char* nA = has_next ? (const char*)g.A + (size_t)nxt.pm * tstep : cA; const char* nB = has_next ? (const char*)g.Bt + (size_t)nxt.pn * tstep : cB;
        for (int t = 0; t < nt; t += 2) {
            const bool last = (t == nt - 2);
            const char* a1 = cA + (size_t)(t + 1) * kstep;
            const char* a2 = last ? nA : cA + (size_t)(t + 2) * kstep; const char* b2 = last ? nB : cB + (size_t)(t + 2) * kstep;
            const char* a3 = a2 + kstep; const char* b3 = b2 + kstep;
            if (last && has_next) S.a_ready(nxt);
            if constexpr (SP2) {
            PG8_LDB(B0, 0, 0); PG8_LDB(B1, 0, 1); PG8_SCHED; PG8_LDA(At, 0, 0); PG8_STAGE(PG8_SA(1, 1), a1 + hstep, voffA);
            PG8_WAIT_V(8); PG8_WAIT_L(0); PG8_BAR; PG8_MMA(0, 0, At, B0); PG8_MMA(0, 1, At, B1); PG8_BAR; PG8_SCHED;
            PG8_LDA(At, 0, 1); PG8_STAGE(PG8_SB(0, 0), b2, voffB); PG8_STAGE(PG8_SB(0, 1), b2 + hstep, voffB); PG8_STAGE(PG8_SA(0, 0), a2, voffA);
            PG8_WAIT_V(8); PG8_WAIT_L(0); PG8_BAR; PG8_MMA(1, 0, At, B0); PG8_MMA(1, 1, At, B1); PG8_BAR; PG8_SCHED;
            PG8_LDB(B0, 1, 0); PG8_LDB(B1, 1, 1); PG8_SCHED; PG8_LDA(At, 1, 0); PG8_STAGE(PG8_SA(0, 1), a2 + hstep, voffA);
            PG8_WAIT_V(8); PG8_WAIT_L(0); PG8_BAR; PG8_MMA(0, 0, At, B0); PG8_MMA(0, 1, At, B1); PG8_BAR; PG8_SCHED;
            PG8_LDA(At, 1, 1); PG8_STAGE(PG8_SB(1, 0), b3, voffB); PG8_STAGE(PG8_SB(1, 1), b3 + hstep, voffB); PG8_STAGE(PG8_SA(1, 0), a3, voffA);
            PG8_WAIT_V(8); PG8_WAIT_L(0); PG8_BAR; PG8_MMA(1, 0, At, B0); PG8_MMA(1, 1, At, B1); PG8_BAR; PG8_SCHED;
            } else {
            PG8_LDB(B0, 0, 0); PG8_SCHED; PG8_LDA(At, 0, 0); PG8_STAGE(PG8_SA(1, 1), a1 + hstep, voffA);
            PG8_WAIT_L(8); PG8_BAR; PG8_WAIT_L(0); PG8_MMA(0, 0, At, B0); PG8_BAR; PG8_SCHED;
            PG8_LDB(B1, 0, 1); PG8_STAGE(PG8_SB(0, 0), b2, voffB);
            PG8_BAR; PG8_WAIT_L(0); PG8_MMA(0, 1, At, B1); PG8_BAR;
            PG8_LDA(At, 0, 1); PG8_STAGE(PG8_SA(0, 0), a2, voffA);
            PG8_BAR; PG8_WAIT_L(0); PG8_MMA(1, 0, At, B0); PG8_BAR; PG8_SCHED;
            PG8_STAGE(PG8_SB(0, 1), b2 + hstep, voffB);
            PG8_WAIT_V(6); PG8_BAR; PG8_MMA(1, 1, At, B1); PG8_BAR;
            PG8_LDB(B0, 1, 0); PG8_SCHED; PG8_LDA(At, 1, 0); PG8_STAGE(PG8_SA(0, 1), a2 + hstep, voffA);
            PG8_WAIT_L(8); PG8_BAR; PG8_WAIT_L(0); PG8_MMA(0, 0, At, B0); PG8_BAR; PG8_SCHED;
            PG8_LDB(B1, 1, 1); PG8_STAGE(PG8_SB(1, 0), b3, voffB);
            PG8_BAR; PG8_WAIT_L(0); PG8_MMA(0, 1, At, B1); PG8_BAR;
            PG8_LDA(At, 1, 1); PG8_STAGE(PG8_SA(1, 0), a3, voffA);
            PG8_BAR; PG8_WAIT_L(0); PG8_MMA(1, 0, At, B0); PG8_BAR; PG8_SCHED;
            PG8_STAGE(PG8_SB(1, 1), b3 + hstep, voffB);
            PG8_WAIT_V(6); PG8_BAR; PG8_MMA(1, 1, At, B1); PG8_BAR;
            }
        }
        if constexpr (ALIGN_EPI) { if (wr == 0) PG8_BAR; }
        if constexpr (!Epi::AFTER_DRAIN) { E(acc, cur, wr, wc, fr, fq); S.done(cur); }
        if (!has_next) break;
#pragma unroll
        for (int a = 0; a < 2; ++a)
#pragma unroll
            for (int b = 0; b < 2; ++b)
#pragma unroll
                for (int m = 0; m < 4; ++m)
#pragma unroll
                    for (int n = 0; n < 2; ++n) acc[a][b][m][n] = (f32x4){0.f, 0.f, 0.f, 0.f};
        cur = nxt; cA = nA; cB = nB; ++ui;
        if constexpr (ALIGN_EPI) { if (wr == 1) PG8_BAR; }
    }
    PG8_WAIT_V(0);
    if constexpr (!ALIGN_EPI) { if (wr == 0) PG8_BAR; }
    PG8_BAR;
    if constexpr (Epi::AFTER_DRAIN) { E.fused(acc, cur, wr, wc, fr, fq, lds, wid, lane); S.done(cur); }
#undef PG8_SA
#undef PG8_SB
#undef PG8_STAGE
#undef PG8_LDA
#undef PG8_LDB
#undef PG8_MMA
#undef PG8_WAIT_V
#undef PG8_WAIT_L
#undef PG8_BAR
#undef PG8_SCHED
}
}

#define LDS_WAIT() asm volatile("s_waitcnt lgkmcnt(0)" ::: "memory")

__device__ __forceinline__ void transpose_item(const float* W, int K, int N, bf16_t* WT, LAS float* scr, int item, int lane) {
    const int nblk = N / 32, kb = item / nblk, nb = item % nblk, k0 = 64 * kb, n0 = 32 * nb;
#pragma unroll 8
    for (int i = 0; i < 32; ++i) { const int kk = 2 * i + (lane >> 5); scr[kk * 33 + (lane & 31)] = W[(size_t)(k0 + kk) * N + n0 + (lane & 31)]; }
    LDS_WAIT(); asm volatile("" ::: "memory");
    const int c = lane & 7;
#pragma unroll
    for (int j = 0; j < 4; ++j) { const int n = (lane >> 3) + 8 * j; const LAS float* s = scr + (8 * c) * 33 + n;
        u32x4 o; o.x = pk2(s[0 * 33], s[1 * 33]); o.y = pk2(s[2 * 33], s[3 * 33]); o.z = pk2(s[4 * 33], s[5 * 33]); o.w = pk2(s[6 * 33], s[7 * 33]);
        *(u32x4*)(WT + (size_t)(n0 + n) * K + k0 + 8 * c) = o; }
    LDS_WAIT(); asm volatile("" ::: "memory");
}

struct CvtFam { int in_idx, cnt, K, N, Npad, pad_; size_t dst; };
__constant__ CvtFam c_fam[8] = {
    {I_WMOD, 4, 2048, 12288, 12288, 0, WS_WMOD}, {I_WINAB, 2, 2048, PAB, PAB_PAD, 0, WS_WINAB}, {I_WOUTAB, 2, 2048, 2048, 2048, 0, WS_WOUTAB},
    {I_WINC, 2, 2048, PC, PC_PAD, 0, WS_WINC}, {I_WOUTC, 2, 4096, 2048, 2048, 0, WS_WOUTC}, {I_FWG, 4, 2048, DFF, DFF, 0, WS_WGATE},
    {I_FWU, 4, 2048, DFF, DFF, 0, WS_WUP}, {I_FWD, 4, DFF, 2048, 2048, 0, WS_WDOWN} };
__device__ __forceinline__ void phase_convert(const P& p, LAS unsigned char* lds) {
    const int tid = threadIdx.x, lane = tid & 63, wave = tid >> 6;
    const int gw = blockIdx.x * 8 + wave, NGW = gridDim.x * 8;
    LAS float* scr = (LAS float*)(lds + wave * 8704);
    const CvtFam* fam = c_fam;
#pragma unroll 1
    for (int f = 0; f < 8; ++f) {
        const int K = fam[f].K, N = fam[f].N, per = (K / 64) * (N / 32), total = per * fam[f].cnt;
        for (int it = gw; it < total; it += NGW) {
            const int mi = it / per, li = it % per;
            transpose_item(p.in[fam[f].in_idx] + (size_t)mi * K * N, K, N, (bf16_t*)(p.ws + fam[f].dst) + (size_t)mi * fam[f].Npad * K, scr, li, lane);
        }
        const int padrows = fam[f].Npad - N;
        if (padrows > 0) {
            const size_t nvec = (size_t)padrows * K / 8;
            for (int mi = 0; mi < fam[f].cnt; ++mi) {
                u32x4* dst = (u32x4*)((bf16_t*)(p.ws + fam[f].dst) + ((size_t)mi * fam[f].Npad + N) * K);
                for (size_t i = (size_t)blockIdx.x * NT + tid; i < nvec; i += (size_t)gridDim.x * NT) dst[i] = (u32x4){0u, 0u, 0u, 0u};
            }
        }
    }
    const size_t gt = (size_t)blockIdx.x * NT + tid, GT = (size_t)gridDim.x * NT;
    { bf16_t* w2t = (bf16_t*)(p.ws + WS_W2T); bf16_t* a2t = (bf16_t*)(p.ws + WS_A2T);
      for (size_t i = gt; i < (size_t)2 * 1024 * 64; i += GT) { const int k = i & 63, n = (i >> 6) & 1023, l = i >> 16;
          w2t[i] = (bf16_t)f2bf(p.in[I_W2][((size_t)l * 64 + k) * 1024 + n]); a2t[i] = (bf16_t)f2bf(p.in[I_A2][((size_t)l * 64 + k) * 1024 + n]); } }
    { bf16_t* g2t = (bf16_t*)(p.ws + WS_G2T);
      for (size_t i = gt; i < (size_t)2 * 1024 * 160; i += GT) { const int k = i % 160, n = (i / 160) & 1023, l = i / (160 * 1024);
          g2t[i] = (bf16_t)f2bf(p.in[I_G2][((size_t)l * 160 + k) * 1024 + n]); } }
    { bf16_t* wat = (bf16_t*)(p.ws + WS_WAT); bf16_t* wxt = (bf16_t*)(p.ws + WS_WXT);
      for (size_t i = gt; i < (size_t)2 * 16 * 64 * 64; i += GT) { const int k = i & 63, n = (i >> 6) & 63, lh = i >> 12;
          wat[i] = (bf16_t)f2bf(p.in[I_LWA][((size_t)lh * 64 + k) * 64 + n]); wxt[i] = (bf16_t)f2bf(p.in[I_LWX][((size_t)lh * 64 + k) * 64 + n]); } }
}

__device__ __forceinline__ void phase_init(const P& p) {
    const size_t gt = (size_t)blockIdx.x * NT + threadIdx.x, GT = (size_t)gridDim.x * NT;
    f32x4* X = (f32x4*)(p.ws + WS_X);
    const f32x4* xp = (const f32x4*)p.in[I_XP]; const f32x4* xs = (const f32x4*)p.in[I_XS];
    for (size_t i = gt; i < (size_t)MPAD * D / 4; i += GT) {
        const size_t r = i / (D / 4);
        X[i] = r < MP ? xp[i] : (r < MV ? xs[i - (size_t)MP * D / 4] : (f32x4){0.f, 0.f, 0.f, 0.f});
    }
    bf16_t* sc = (bf16_t*)(p.ws + WS_SC);
    for (size_t i = gt; i < (size_t)256 * D; i += GT) {
        const int r = i / D, c = i % D; float v = 0.f;
        if (r < NBP) v = silu_(p.in[I_CP][(size_t)r * D + c]); else if (r < NSEQ) v = silu_(p.in[I_CS][(size_t)(r - NBP) * D + c]);
        sc[i] = (bf16_t)f2bf(v);
    }
    { u32x4* ye = (u32x4*)((bf16_t*)(p.ws + WS_YE) + (size_t)MV * D); for (size_t i = gt; i < (size_t)(MPAD - MV) * D / 8; i += GT) ye[i] = (u32x4){0u, 0u, 0u, 0u}; }
    { u32x4* yo = (u32x4*)((bf16_t*)(p.ws + WS_YO) + (size_t)MV * 4096); for (size_t i = gt; i < (size_t)(MPAD - MV) * 4096 / 8; i += GT) yo[i] = (u32x4){0u, 0u, 0u, 0u}; }
}

__device__ __forceinline__ void phase_norm(const P& p, int layer, int which  ) {
    const int lane = threadIdx.x & 63, wave = threadIdx.x >> 6;
    const float* X = (const float*)(p.ws + WS_X); bf16_t* H = (bf16_t*)(p.ws + WS_H); const float* MOD = (const float*)(p.ws + WS_MOD);
    const float* gain = p.in[which ? I_NFFN : I_NMIX] + (size_t)layer * D;
    for (int r = blockIdx.x * 8 + wave; r < MPAD; r += gridDim.x * 8) {
        u32x2* hr = (u32x2*)(H + (size_t)r * D);
        if (r >= MV) {
#pragma unroll
            for (int j = 0; j < 8; ++j) hr[lane + 64 * j] = (u32x2){0u, 0u};
            continue; }
        const f32x4* xr = (const f32x4*)(X + (size_t)r * D);
        f32x4 v[8]; float s = 0.f;
#pragma unroll
        for (int j = 0; j < 8; ++j) { v[j] = xr[lane + 64 * j]; s += v[j].x * v[j].x + v[j].y * v[j].y + v[j].z * v[j].z + v[j].w * v[j].w; }
        const float rstd = rsqrtf(wave_sum(s) * (1.f / D) + 1e-6f);
        const float* mrow = MOD + (size_t)bidx_of(r) * MODLD + (size_t)layer * 12288 + (which ? 3 * D : 0);
#pragma unroll
        for (int j = 0; j < 8; ++j) {
            const int c = (lane + 64 * j) * 4;
            const f32x4 g = *(const f32x4*)(gain + c), sh = *(const f32x4*)(mrow + c), sc = *(const f32x4*)(mrow + D + c);
            const f32x4 o = v[j] * rstd * g * (sc + 1.f) + sh;
            hr[lane + 64 * j] = (u32x2){pk2(o.x, o.y), pk2(o.z, o.w)};
        }
    }
}

__device__ __forceinline__ void phase_final_norm(const P& p) {
    const int lane = threadIdx.x & 63, wave = threadIdx.x >> 6;
    const float* X = (const float*)(p.ws + WS_X); const float* gain = p.in[I_NOUT];
    for (int r = blockIdx.x * 8 + wave; r < MV; r += gridDim.x * 8) {
        const f32x4* xr = (const f32x4*)(X + (size_t)r * D); f32x4* yr = (f32x4*)(p.out + (size_t)r * D);
        f32x4 v[8]; float s = 0.f;
#pragma unroll
        for (int j = 0; j < 8; ++j) { v[j] = xr[lane + 64 * j]; s += v[j].x * v[j].x + v[j].y * v[j].y + v[j].z * v[j].z + v[j].w * v[j].w; }
        const float rstd = rsqrtf(wave_sum(s) * (1.f / D) + 1e-6f);
#pragma unroll
        for (int j = 0; j < 8; ++j) { const f32x4 g = *(const f32x4*)(gain + (lane + 64 * j) * 4); yr[lane + 64 * j] = v[j] * rstd * g; }
    }
}

constexpr int PLD_E = PAB_PAD;

__device__ __forceinline__ float rw_prev(const P& p, const float* proj, int il, int R, int col) {
    if (R < MP) return (R & (SEQ - 1)) ? proj[(size_t)(R - 1) * PLD_E + col] : 0.f;
    return p.in[I_SSHIFT][((size_t)il * NBS + (R - MP)) * PA + col];
}
__device__ __forceinline__ f32x4 rw_prev4(const P& p, const float* proj, int il, int R, int col) {
    if (R < MP) return (R & (SEQ - 1)) ? *(const f32x4*)(proj + (size_t)(R - 1) * PLD_E + col) : (f32x4){0.f, 0.f, 0.f, 0.f};
    return *(const f32x4*)(p.in[I_SSHIFT] + ((size_t)il * NBS + (R - MP)) * PA + col);
}

__device__ __forceinline__ void phase_rwkv_prep(const P& p, int il, LAS unsigned char* lds) {
    const int tid = threadIdx.x, lane = tid & 63, wave = tid >> 6, l15 = lane & 15, kq = lane >> 4;
    const float* proj = (const float*)(p.ws + WS_PROJ);
    float* SCB = (float*)(p.ws + WS_MIX + MX_SCB); float* GG = (float*)(p.ws + WS_MIX + MX_GG); float* C123 = (float*)(p.ws + WS_MIX + MX_C123);
    const bf16_t* w2t = (const bf16_t*)(p.ws + WS_W2T) + (size_t)il * 1024 * 64;
    const bf16_t* a2t = (const bf16_t*)(p.ws + WS_A2T) + (size_t)il * 1024 * 64;
    const bf16_t* g2t = (const bf16_t*)(p.ws + WS_G2T) + (size_t)il * 1024 * 160;
    const float* mu = p.in[I_MU] + (size_t)il * PA;
    const float* w0 = p.in[I_W0] + (size_t)il * 1024; const float* a0 = p.in[I_A0] + (size_t)il * 1024;
    const float* k_k = p.in[I_KK] + (size_t)il * 1024; const float* k_a = p.in[I_KA] + (size_t)il * 1024; const float* r_k = p.in[I_RK] + (size_t)il * 1024;
    LAS bf16_t* XS = (LAS bf16_t*)lds;
    constexpr int XLD = 296;
    for (int u = blockIdx.x; u < MV / 16; u += gridDim.x) {
        const int R0 = u * 16;
        __syncthreads();
        for (int idx = tid; idx < 16 * 288; idx += NT) {
            const int r = idx / 288, c = idx % 288, col = 3072 + c, R = R0 + r;
            const float cur = proj[(size_t)R * PLD_E + col], prev = rw_prev(p, proj, il, R, col);
            float x = cur + (prev - cur) * mu[col];
            if (c < 64) x = tanh_(x); else if (c >= 128) x = sigmoid_(x);
            XS[r * XLD + c] = (bf16_t)f2bf(x);
        }
        __syncthreads();
#pragma unroll 1
        for (int hh = 0; hh < 2; ++hh) {
            const int h = wave * 2 + hh;
            f32x4 accw[4], acca[4], accg[4];
#pragma unroll
            for (int nb = 0; nb < 4; ++nb) { accw[nb] = (f32x4){0.f, 0.f, 0.f, 0.f}; acca[nb] = accw[nb]; accg[nb] = accw[nb]; }
#pragma unroll
            for (int ks = 0; ks < 2; ++ks) {
                const bf16x8 bw = *(const LAS bf16x8*)(XS + l15 * XLD + ks * 32 + kq * 8);
                const bf16x8 ba = *(const LAS bf16x8*)(XS + l15 * XLD + 64 + ks * 32 + kq * 8);
#pragma unroll
                for (int nb = 0; nb < 4; ++nb) {
                    const int n = h * 64 + nb * 16 + l15;
                    accw[nb] = mfma16(*(const bf16x8*)(w2t + (size_t)n * 64 + ks * 32 + kq * 8), bw, accw[nb]);
                    acca[nb] = mfma16(*(const bf16x8*)(a2t + (size_t)n * 64 + ks * 32 + kq * 8), ba, acca[nb]);
                }
            }
#pragma unroll
            for (int ks = 0; ks < 5; ++ks) {
                const bf16x8 bg = *(const LAS bf16x8*)(XS + l15 * XLD + 128 + ks * 32 + kq * 8);
#pragma unroll
                for (int nb = 0; nb < 4; ++nb) { const int n = h * 64 + nb * 16 + l15; accg[nb] = mfma16(*(const bf16x8*)(g2t + (size_t)n * 160 + ks * 32 + kq * 8), bg, accg[nb]); }
            }
            const int R = R0 + l15;
            float ss = 0.f;
#pragma unroll
            for (int nb = 0; nb < 4; ++nb) {
                const int c = h * 64 + nb * 16 + kq * 4;
                const f32x4 kc = *(const f32x4*)(proj + (size_t)R * PLD_E + 1024 + c), kpv = rw_prev4(p, proj, il, R, c + 1024), mk = *(const f32x4*)(mu + 1024 + c), kkv = *(const f32x4*)(k_k + c);
                const f32x4 kx = (kc + (kpv - kc) * mk) * kkv;
                ss += kx.x * kx.x + kx.y * kx.y + kx.z * kx.z + kx.w * kx.w;
            }
            ss += __shfl_xor(ss, 16); ss += __shfl_xor(ss, 32);
            const float rn = rsqrtf(ss + 1e-12f);
            float c1 = 0.f, c2 = 0.f, c3 = 0.f;
            float* sb = SCB + ((size_t)h * MV + R) * 384;
#pragma unroll 1
            for (int nb = 0; nb < 4; ++nb) {
                const int cl = nb * 16 + kq * 4, c = h * 64 + cl;
                const float* pr = proj + (size_t)R * PLD_E + c;
                const f32x4 rc = *(const f32x4*)(pr), kc = *(const f32x4*)(pr + 1024), vc = *(const f32x4*)(pr + 2048);
                const f32x4 rp = rw_prev4(p, proj, il, R, c), kpv = rw_prev4(p, proj, il, R, c + 1024), vp = rw_prev4(p, proj, il, R, c + 2048);
                const f32x4 mr = *(const f32x4*)(mu + c), mk = *(const f32x4*)(mu + 1024 + c), mv = *(const f32x4*)(mu + 2048 + c);
                const f32x4 r = rc + (rp - rc) * mr, k = kc + (kpv - kc) * mk, v = vc + (vp - vc) * mv;
                const f32x4 w0v = *(const f32x4*)(w0 + c), a0v = *(const f32x4*)(a0 + c), kkv = *(const f32x4*)(k_k + c), kav = *(const f32x4*)(k_a + c), rkv = *(const f32x4*)(r_k + c);
                const f32x4 aw = nb == 0 ? accw[0] : nb == 1 ? accw[1] : nb == 2 ? accw[2] : accw[3];
                const f32x4 aA = nb == 0 ? acca[0] : nb == 1 ? acca[1] : nb == 2 ? acca[2] : acca[3];
                const f32x4 ag = nb == 0 ? accg[0] : nb == 1 ? accg[1] : nb == 2 ? accg[2] : accg[3];
                f32x4 kk, kka, wr, ww, kp;
#pragma unroll
                for (int j = 0; j < 4; ++j) {
                    const float wl = -softplus_(-(w0v[j] + aw[j])) - 0.5f;
                    ww[j] = __expf(-__expf(wl));
                    const float a = sigmoid_(a0v[j] + aA[j]);
                    kk[j] = k[j] * kkv[j] * rn; kka[j] = kk[j] * a;
                    kp[j] = k[j] * (1.f + (a - 1.f) * kav[j]);
                    wr[j] = ww[j] * r[j];
                    c1 += kka[j] * r[j]; c2 += kp[j] * r[j]; c3 += r[j] * kp[j] * rkv[j];
                }
                *(f32x4*)(sb + 0 * 64 + cl) = kk; *(f32x4*)(sb + 1 * 64 + cl) = ww; *(f32x4*)(sb + 2 * 64 + cl) = kka;
                *(f32x4*)(sb + 3 * 64 + cl) = kp; *(f32x4*)(sb + 4 * 64 + cl) = wr; *(f32x4*)(sb + 5 * 64 + cl) = v;
                *(f32x4*)(GG + (size_t)R * 1024 + c) = ag;
            }
            c1 += __shfl_xor(c1, 16); c1 += __shfl_xor(c1, 32);
            c2 += __shfl_xor(c2, 16); c2 += __shfl_xor(c2, 32);
            c3 += __shfl_xor(c3, 16); c3 += __shfl_xor(c3, 32);
            if (kq == 0) *(f32x4*)(C123 + ((size_t)R * 16 + h) * 4) = (f32x4){c1, c2, c3, 0.f};
        }
    }
}

__device__ __forceinline__ void phase_rwkv_scan(const P& p, int il, LAS unsigned char* lds) {
    const int tid = threadIdx.x, il_ = tid >> 4, jq = tid & 15;
    const float* SCB = (const float*)(p.ws + WS_MIX + MX_SCB); const float* C123 = (const float*)(p.ws + WS_MIX + MX_C123);
    float* YRAW = (float*)(p.ws + WS_MIX + MX_YRAW);
    constexpr int TC = 32;
    LAS float* buf = (LAS float*)lds;
    LAS float* scal = (LAS float*)(lds + 2 * TC * 384 * 4);
    LAS float* ybuf = scal + 2 * TC * 4;
    const int NU = NSEQ * 32;
    for (int u = blockIdx.x; u < NU; u += gridDim.x) {
        const int s = u >> 5, h = (u >> 1) & 15, half = u & 1;
        const int T = s < NBP ? SEQ : 1, Rb = s < NBP ? s * SEQ : MP + (s - NBP);
        const int irow = half * 32 + il_;
        float S[4];
        if (s < NBP) { S[0] = S[1] = S[2] = S[3] = 0.f; }
        else { const f32x4 s0 = *(const f32x4*)(p.in[I_SWKV] + (((size_t)il * NBS + (s - NBP)) * 16 + h) * 4096 + irow * 64 + jq * 4); S[0] = s0.x; S[1] = s0.y; S[2] = s0.z; S[3] = s0.w; }
        const float* src = SCB + ((size_t)h * MV + Rb) * 384;
        __syncthreads();
        { const int n = (T < TC ? T : TC) * 96;
          for (int i = tid; i < n; i += NT) *(LAS f32x4*)(buf + i * 4) = *(const f32x4*)(src + (size_t)i * 4);
          if (tid < (T < TC ? T : TC)) *(LAS f32x4*)(scal + tid * 4) = *(const f32x4*)(C123 + ((size_t)(Rb + tid) * 16 + h) * 4); }
        __syncthreads();
        for (int t0 = 0, cb = 0; t0 < T; t0 += TC, cb ^= 1) {
            const int ns = (T - t0) < TC ? (T - t0) : TC;
            const int t1 = t0 + TC; const int nn = t1 < T ? ((T - t1) < TC ? (T - t1) : TC) : 0;
            f32x4 pre[6]; f32x4 pres = (f32x4){0.f, 0.f, 0.f, 0.f};
#pragma unroll
            for (int k = 0; k < 6; ++k) { const int i = tid + k * NT; pre[k] = (i < nn * 96) ? *(const f32x4*)(src + ((size_t)t1 * 96 + i) * 4) : (f32x4){0.f, 0.f, 0.f, 0.f}; }
            if (tid < nn) pres = *(const f32x4*)(C123 + ((size_t)(Rb + t1 + tid) * 16 + h) * 4);
            const LAS float* cbuf = buf + cb * TC * 384; const LAS float* csc = scal + cb * TC * 4;
#pragma unroll 2
            for (int t = 0; t < ns; ++t) {
                const LAS float* st = cbuf + t * 384;
                const f32x4 kk = *(const LAS f32x4*)(st + jq * 4), w = *(const LAS f32x4*)(st + 64 + jq * 4), kka = *(const LAS f32x4*)(st + 128 + jq * 4);
                const f32x4 kp = *(const LAS f32x4*)(st + 192 + jq * 4), wr = *(const LAS f32x4*)(st + 256 + jq * 4);
                const float vi = st[320 + irow]; const float c1 = csc[t * 4], c2 = csc[t * 4 + 1];
                float sa = S[0] * kk.x + S[1] * kk.y + S[2] * kk.z + S[3] * kk.w;
                float sr = S[0] * wr.x + S[1] * wr.y + S[2] * wr.z + S[3] * wr.w;
                sa = allreduce16(sa); sr = allreduce16(sr);
                S[0] = S[0] * w.x - sa * kka.x + vi * kp.x; S[1] = S[1] * w.y - sa * kka.y + vi * kp.y;
                S[2] = S[2] * w.z - sa * kka.z + vi * kp.z; S[3] = S[3] * w.w - sa * kka.w + vi * kp.w;
                const float y = sr - sa * c1 + vi * c2;
                if (jq == 0) ybuf[t * 32 + il_] = y;
            }
            __syncthreads();
            for (int i = tid; i < ns * 32; i += NT) { const int t = i >> 5, r = i & 31; YRAW[(size_t)(Rb + t0 + t) * 1024 + h * 64 + half * 32 + r] = ybuf[i]; }
            { LAS float* nb_ = buf + (cb ^ 1) * TC * 384;
#pragma unroll
              for (int k = 0; k < 6; ++k) { const int i = tid + k * NT; if (i < nn * 96) *(LAS f32x4*)(nb_ + i * 4) = pre[k]; }
              if (tid < nn) *(LAS f32x4*)(scal + (cb ^ 1) * TC * 4 + tid * 4) = pres; }
            __syncthreads();
        }
        float* so = p.out + (s < NBP ? O_PWKV + (((size_t)il * NBP + s) * 16 + h) * 4096 : O_SWKV + (((size_t)il * NBS + (s - NBP)) * 16 + h) * 4096);
        *(f32x4*)(so + irow * 64 + jq * 4) = (f32x4){S[0], S[1], S[2], S[3]};
    }
}

__device__ __forceinline__ void phase_rwkv_post(const P& p, int il) {
    const int lane = threadIdx.x & 63, wave = threadIdx.x >> 6;
    const float* SCB = (const float*)(p.ws + WS_MIX + MX_SCB); const float* GG = (const float*)(p.ws + WS_MIX + MX_GG); const float* C123 = (const float*)(p.ws + WS_MIX + MX_C123);
    const float* YRAW = (const float*)(p.ws + WS_MIX + MX_YRAW); bf16_t* YE = (bf16_t*)(p.ws + WS_YE);
    const float* gnw = p.in[I_GNW] + (size_t)il * 1024; const float* gnb = p.in[I_GNB] + (size_t)il * 1024;
    for (int task = blockIdx.x * 8 + wave; task < MV * 16; task += gridDim.x * 8) {
        const int R = task >> 4, h = task & 15, c = h * 64 + lane;
        const float y = YRAW[(size_t)R * 1024 + c];
        const float mean = wave_sum(y) * (1.f / 64.f); const float d = y - mean; const float var = wave_sum(d * d) * (1.f / 64.f);
        const float v = SCB[((size_t)h * MV + R) * 384 + 320 + lane], c3 = C123[((size_t)R * 16 + h) * 4 + 2], g = GG[(size_t)R * 1024 + c];
        const float o = (d * rsqrtf(var + 64e-5f) * gnw[c] + gnb[c] + c3 * v) * g;
        YE[(size_t)R * D + c] = (bf16_t)f2bf(o);
    }
}

__device__ __forceinline__ f32x4 lru_conv4(const P& p, const float* proj, int il, int R, int c) {
    const float* cw = p.in[I_LCW] + (size_t)il * 4 * 1024; const float* cbias = p.in[I_LCB] + (size_t)il * 1024;
    f32x4 acc = *(const f32x4*)(cbias + c);
    if (R < MP) {
        const int t = R & (SEQ - 1);
#pragma unroll
        for (int j = 0; j < 4; ++j) { if (t - (3 - j) >= 0) acc = acc + *(const f32x4*)(cw + j * 1024 + c) * *(const f32x4*)(proj + (size_t)(R - (3 - j)) * PLD_E + XB_OFF + c); }
    } else {
        const float* st = p.in[I_SLRUC] + ((size_t)il * NBS + (R - MP)) * 3 * 1024;
#pragma unroll
        for (int j = 0; j < 3; ++j) acc = acc + *(const f32x4*)(cw + j * 1024 + c) * *(const f32x4*)(st + j * 1024 + c);
        acc = acc + *(const f32x4*)(cw + 3 * 1024 + c) * *(const f32x4*)(proj + (size_t)R * PLD_E + XB_OFF + c);
    }
    return acc;
}

__device__ __forceinline__ void phase_lru_gates(const P& p, int il, LAS unsigned char* lds) {
    const int tid = threadIdx.x, lane = tid & 63, wave = tid >> 6, l15 = lane & 15, kq = lane >> 4;
    const float* proj = (const float*)(p.ws + WS_PROJ);
    float* LA = (float*)(p.ws + WS_MIX + MX_LA); float* LB = (float*)(p.ws + WS_MIX + MX_LB);
    const bf16_t* wat = (const bf16_t*)(p.ws + WS_WAT) + (size_t)il * 16 * 4096; const bf16_t* wxt = (const bf16_t*)(p.ws + WS_WXT) + (size_t)il * 16 * 4096;
    const float* ba = p.in[I_LBA] + (size_t)il * 1024; const float* bx = p.in[I_LBX] + (size_t)il * 1024; const float* lam = p.in[I_LLAM] + (size_t)il * 1024;
    constexpr int XLD = 72;
    LAS bf16_t* XC = (LAS bf16_t*)(lds + wave * (64 * XLD * 2));
    for (int tile = blockIdx.x; tile < MV / 64; tile += gridDim.x) {
        const int R0 = tile * 64;
#pragma unroll 1
        for (int hi = 0; hi < 2; ++hi) {
            const int hb = wave + hi * 8;
#pragma unroll 4
            for (int k = 0; k < 16; ++k) { const int idx = lane + 64 * k, r = idx >> 4, c4 = idx & 15;
                const f32x4 xc = lru_conv4(p, proj, il, R0 + r, hb * 64 + c4 * 4);
                *(LAS u32x2*)(XC + r * XLD + c4 * 4) = (u32x2){pk2(xc.x, xc.y), pk2(xc.z, xc.w)}; }
            LDS_WAIT(); asm volatile("" ::: "memory");
            bf16x8 fa[4][2], fx[4][2];
#pragma unroll
            for (int nb = 0; nb < 4; ++nb)
#pragma unroll
                for (int ks = 0; ks < 2; ++ks) { const size_t o = ((size_t)hb * 64 + nb * 16 + l15) * 64 + ks * 32 + kq * 8; fa[nb][ks] = *(const bf16x8*)(wat + o); fx[nb][ks] = *(const bf16x8*)(wxt + o); }
#pragma unroll 1
            for (int tb = 0; tb < 4; ++tb) {
                f32x4 ar[4], ai[4];
#pragma unroll
                for (int nb = 0; nb < 4; ++nb) { ar[nb] = (f32x4){0.f, 0.f, 0.f, 0.f}; ai[nb] = ar[nb]; }
#pragma unroll
                for (int ks = 0; ks < 2; ++ks) { const bf16x8 bx_ = *(const LAS bf16x8*)(XC + (tb * 16 + l15) * XLD + ks * 32 + kq * 8);
#pragma unroll
                    for (int nb = 0; nb < 4; ++nb) { ar[nb] = mfma16(fa[nb][ks], bx_, ar[nb]); ai[nb] = mfma16(fx[nb][ks], bx_, ai[nb]); } }
                const int R = R0 + tb * 16 + l15;
#pragma unroll
                for (int nb = 0; nb < 4; ++nb) {
                    const int c = hb * 64 + nb * 16 + kq * 4;
                    const f32x4 xc = lru_conv4(p, proj, il, R, c);
                    const f32x4 bav = *(const f32x4*)(ba + c), bxv = *(const f32x4*)(bx + c), lv = *(const f32x4*)(lam + c);
                    f32x4 av, bv;
#pragma unroll
                    for (int j = 0; j < 4; ++j) {
                        const float rg = sigmoid_(ar[nb][j] + bav[j]), ig = sigmoid_(ai[nb][j] + bxv[j]);
                        const float la = -8.f * rg * softplus_(-lv[j]);
                        av[j] = __expf(la); bv[j] = sqrtf(-expm1f(2.f * la)) * (ig * xc[j]);
                    }
                    *(f32x4*)(LA + (size_t)R * 1024 + c) = av; *(f32x4*)(LB + (size_t)R * 1024 + c) = bv;
                }
            }
            LDS_WAIT(); asm volatile("" ::: "memory");
        }
    }
}

__device__ __forceinline__ void phase_lru_local(const P& p) {
    const int tid = threadIdx.x;
    const float* LA = (const float*)(p.ws + WS_MIX + MX_LA); const float* LB = (const float*)(p.ws + WS_MIX + MX_LB);
    float* HL = (float*)(p.ws + WS_MIX + MX_HL); float* PP = (float*)(p.ws + WS_MIX + MX_PP);
    float* HEND = (float*)(p.ws + WS_MIX + MX_HEND); float* PEND = (float*)(p.ws + WS_MIX + MX_PEND);
    for (int ch = blockIdx.x; ch < 128; ch += gridDim.x) {
        const size_t base = (size_t)ch * 64 * 1024 + tid * 2;
        f32x2 h = (f32x2){0.f, 0.f}, pr = (f32x2){1.f, 1.f};
#pragma unroll 8
        for (int t = 0; t < 64; ++t) {
            const f32x2 a = *(const f32x2*)(LA + base + (size_t)t * 1024), b = *(const f32x2*)(LB + base + (size_t)t * 1024);
            h = a * h + b; pr = pr * a;
            *(f32x2*)(HL + base + (size_t)t * 1024) = h; *(f32x2*)(PP + base + (size_t)t * 1024) = pr;
        }
        *(f32x2*)(HEND + (size_t)ch * 1024 + tid * 2) = h; *(f32x2*)(PEND + (size_t)ch * 1024 + tid * 2) = pr;
    }
}
__device__ __forceinline__ void phase_lru_carry(const P& p, int il) {
    const float* HEND = (const float*)(p.ws + WS_MIX + MX_HEND); const float* PEND = (const float*)(p.ws + WS_MIX + MX_PEND);
    float* CARRY = (float*)(p.ws + WS_MIX + MX_CARRY);
    for (int i = blockIdx.x * NT + threadIdx.x; i < NBP * 1024; i += gridDim.x * NT) {
        const int b = i >> 10, c = i & 1023; float cr = 0.f;
        for (int n = 0; n < 32; ++n) { const size_t o = (size_t)(b * 32 + n) * 1024 + c; CARRY[o] = cr; cr = HEND[o] + PEND[o] * cr; }
        p.out[O_PLRUH + ((size_t)il * NBP + b) * 1024 + c] = cr;
    }
}
__device__ __forceinline__ void phase_lru_apply(const P& p, int il) {
    const float* proj = (const float*)(p.ws + WS_PROJ);
    const float* LA = (const float*)(p.ws + WS_MIX + MX_LA); const float* LB = (const float*)(p.ws + WS_MIX + MX_LB);
    const float* HL = (const float*)(p.ws + WS_MIX + MX_HL); const float* PP = (const float*)(p.ws + WS_MIX + MX_PP); const float* CARRY = (const float*)(p.ws + WS_MIX + MX_CARRY);
    bf16_t* YE = (bf16_t*)(p.ws + WS_YE);
    for (size_t i = (size_t)blockIdx.x * NT + threadIdx.x; i < (size_t)MV * 256; i += (size_t)gridDim.x * NT) {
        const int R = (int)(i >> 8), c = (int)(i & 255) * 4;
        f32x4 h;
        if (R < MP) { h = *(const f32x4*)(HL + (size_t)R * 1024 + c) + *(const f32x4*)(PP + (size_t)R * 1024 + c) * *(const f32x4*)(CARRY + (size_t)(R >> 6) * 1024 + c); }
        else { const int b = R - MP; h = *(const f32x4*)(LB + (size_t)R * 1024 + c) + *(const f32x4*)(LA + (size_t)R * 1024 + c) * *(const f32x4*)(p.in[I_SLRUH] + ((size_t)il * NBS + b) * 1024 + c);
               *(f32x4*)(p.out + O_SLRUH + ((size_t)il * NBS + b) * 1024 + c) = h; }
        const f32x4 g = *(const f32x4*)(proj + (size_t)R * PLD_E + GATE_OFF + c);
        const f32x4 y = (f32x4){h.x * gelu_tanh_(g.x), h.y * gelu_tanh_(g.y), h.z * gelu_tanh_(g.z), h.w * gelu_tanh_(g.w)};
        *(u32x2*)(YE + (size_t)R * D + 1024 + c) = (u32x2){pk2(y.x, y.y), pk2(y.z, y.w)};
    }
}

__device__ __forceinline__ void phase_states_even(const P& p, int il) {
    const float* proj = (const float*)(p.ws + WS_PROJ);
    const size_t gt = (size_t)blockIdx.x * NT + threadIdx.x, GT = (size_t)gridDim.x * NT;
    for (size_t i = gt; i < (size_t)NSEQ * PA; i += GT) {
        const int s = (int)(i / PA), c = (int)(i % PA);
        if (s < NBP) p.out[O_PSHIFT + ((size_t)il * NBP + s) * PA + c] = proj[(size_t)(s * SEQ + SEQ - 1) * PLD_E + c];
        else p.out[O_SSHIFT + ((size_t)il * NBS + (s - NBP)) * PA + c] = proj[(size_t)(MP + s - NBP) * PLD_E + c];
    }
    for (size_t i = gt; i < (size_t)NSEQ * 3 * 1024; i += GT) {
        const int s = (int)(i / 3072), j = (int)(i / 1024) % 3, c = (int)(i & 1023);
        if (s < NBP) p.out[O_PLRUC + (((size_t)il * NBP + s) * 3 + j) * 1024 + c] = proj[(size_t)(s * SEQ + SEQ - 3 + j) * PLD_E + XB_OFF + c];
        else { const int b = s - NBP; p.out[O_SLRUC + (((size_t)il * NBS + b) * 3 + j) * 1024 + c] =
                   j < 2 ? p.in[I_SLRUC][(((size_t)il * NBS + b) * 3 + j + 1) * 1024 + c] : proj[(size_t)(MP + b) * PLD_E + XB_OFF + c]; }
    }
}
__device__ __forceinline__ void phase_states_odd(const P& p, int ic) {
    const float* proj = (const float*)(p.ws + WS_PROJ);
    const size_t gt = (size_t)blockIdx.x * NT + threadIdx.x, GT = (size_t)gridDim.x * NT;
    for (size_t i = gt; i < (size_t)NSEQ * 3 * QKV; i += GT) {
        const int s = (int)(i / (3 * QKV)), j = (int)(i / QKV) % 3, c = (int)(i % QKV);
        if (s < NBP) p.out[O_PGDNC + (((size_t)ic * NBP + s) * 3 + j) * QKV + c] = proj[(size_t)(s * SEQ + SEQ - 3 + j) * PC_PAD + c];
        else { const int b = s - NBP; p.out[O_SGDNC + (((size_t)ic * NBS + b) * 3 + j) * QKV + c] =
                   j < 2 ? p.in[I_SGDNC][(((size_t)ic * NBS + b) * 3 + j + 1) * QKV + c] : proj[(size_t)(MP + b) * PC_PAD + c]; }
    }
}
__device__ __forceinline__ void phase_states_ffn(const P& p, int layer) {
    const float* G = (const float*)(p.ws + WS_GBUF);
    const size_t gt = (size_t)blockIdx.x * NT + threadIdx.x, GT = (size_t)gridDim.x * NT;
    for (size_t i = gt; i < (size_t)NSEQ * 2 * DFF; i += GT) {
        const int s = (int)(i / (2 * DFF)), j = (int)(i / DFF) % 2, c = (int)(i % DFF);
        if (s < NBP) p.out[O_PFFNC + (((size_t)layer * NBP + s) * 2 + j) * DFF + c] = G[(size_t)(s * SEQ + SEQ - 2 + j) * DFF + c];
        else { const int b = s - NBP; p.out[O_SFFNC + (((size_t)layer * NBS + b) * 2 + j) * DFF + c] =
                   j < 1 ? p.in[I_SFFNC][(((size_t)layer * NBS + b) * 2 + 1) * DFF + c] : G[(size_t)(MP + b) * DFF + c]; }
    }
}

constexpr int PLD_O = PC_PAD;

__device__ __forceinline__ void phase_gdn_prep(const P& p, int ic, LAS unsigned char* lds) {
    const int tid = threadIdx.x, row = tid >> 3, cg = tid & 7;
    const float* proj = (const float*)(p.ws + WS_PROJ);
    bf16_t* QN = (bf16_t*)(p.ws + WS_MIX + MX_QN); bf16_t* KN = (bf16_t*)(p.ws + WS_MIX + MX_KN);
    bf16_t* KT = (bf16_t*)(p.ws + WS_MIX + MX_KT); bf16_t* VT = (bf16_t*)(p.ws + WS_MIX + MX_VT);
    float* VNAT = (float*)(p.ws + WS_MIX + MX_VNAT); float* BETA = (float*)(p.ws + WS_MIX + MX_BETA); float* GL = (float*)(p.ws + WS_MIX + MX_GL);
    const float* cw = p.in[I_GCW] + (size_t)ic * 4 * QKV;
    constexpr int TLD = 72;
    LAS bf16_t* TB = (LAS bf16_t*)lds;
    const int NU = (MV / 64) * 64;
    for (int u = blockIdx.x; u < NU; u += gridDim.x) {
        const int tile = u >> 6, slot = u & 63, R = tile * 64 + row, chb = slot * 128 + cg * 16;
        float x[16];
#pragma unroll
        for (int q4 = 0; q4 < 4; ++q4) {
            const int c = chb + q4 * 4; f32x4 acc = (f32x4){0.f, 0.f, 0.f, 0.f};
            if (R < MP) { const int t = R & (SEQ - 1);
#pragma unroll
                for (int j = 0; j < 4; ++j) if (t - (3 - j) >= 0) acc = acc + *(const f32x4*)(cw + (size_t)j * QKV + c) * *(const f32x4*)(proj + (size_t)(R - (3 - j)) * PLD_O + c);
            } else { const float* st = p.in[I_SGDNC] + ((size_t)ic * NBS + (R - MP)) * 3 * QKV;
#pragma unroll
                for (int j = 0; j < 3; ++j) acc = acc + *(const f32x4*)(cw + (size_t)j * QKV + c) * *(const f32x4*)(st + (size_t)j * QKV + c);
                acc = acc + *(const f32x4*)(cw + (size_t)3 * QKV + c) * *(const f32x4*)(proj + (size_t)R * PLD_O + c); }
#pragma unroll
            for (int j = 0; j < 4; ++j) x[q4 * 4 + j] = silu_(acc[j]);
        }
        if (slot < 32) {
            float ss = 0.f;
#pragma unroll
            for (int j = 0; j < 16; ++j) ss += x[j] * x[j];
            ss = allreduce8(ss);
            const float sc = rsqrtf(ss + 1e-6f) * (slot < 16 ? 0.08838834764831845f : 1.f);
#pragma unroll
            for (int j = 0; j < 16; ++j) x[j] *= sc;
            bf16_t* dst = (slot < 16 ? QN : KN) + (size_t)R * D + (slot & 15) * 128 + cg * 16;
            *(u32x4*)(dst) = (u32x4){pk2(x[0], x[1]), pk2(x[2], x[3]), pk2(x[4], x[5]), pk2(x[6], x[7])};
            *(u32x4*)(dst + 8) = (u32x4){pk2(x[8], x[9]), pk2(x[10], x[11]), pk2(x[12], x[13]), pk2(x[14], x[15])};
        }
        if (slot >= 32 && R >= MP) {
            float* dst = VNAT + (size_t)(R - MP) * 4096 + (slot - 32) * 128 + cg * 16;
#pragma unroll
            for (int q4 = 0; q4 < 4; ++q4) *(f32x4*)(dst + q4 * 4) = (f32x4){x[q4 * 4], x[q4 * 4 + 1], x[q4 * 4 + 2], x[q4 * 4 + 3]};
        }
        if (slot >= 16 && tile < MP / 64) {
            __syncthreads();
#pragma unroll
            for (int j = 0; j < 16; ++j) TB[(cg * 16 + j) * TLD + row] = (bf16_t)f2bf(x[j]);
            __syncthreads();
            const int b = tile >> 5, chunk = tile & 31, ch = tid >> 2, part = tid & 3;
            bf16_t* dst = slot < 32 ? KT + ((((size_t)b * 16 + (slot - 16)) * 32 + chunk) * 128 + ch) * 64 + part * 16
                                    : VT + ((((size_t)b * 32 + (slot - 32)) * 32 + chunk) * 128 + ch) * 64 + part * 16;
            *(u32x4*)(dst) = *(const LAS u32x4*)(TB + ch * TLD + part * 16);
            *(u32x4*)(dst + 8) = *(const LAS u32x4*)(TB + ch * TLD + part * 16 + 8);
        }
        if (slot == 0) {
            for (int i = tid; i < 64 * 32; i += NT) { const int r = tile * 64 + (i >> 5), hv = i & 31;
                const float bv = proj[(size_t)r * PLD_O + B_OFF + hv], av = proj[(size_t)r * PLD_O + A_OFF + hv];
                BETA[(size_t)r * 32 + hv] = sigmoid_(bv);
                GL[(size_t)r * 32 + hv] = -__expf(p.in[I_GALOG][ic * 32 + hv]) * softplus_(av + p.in[I_GDTB][ic * 32 + hv]); }
        }
    }
}

__device__ __forceinline__ void phase_gdn_wy(const P& p, LAS unsigned char* lds) {
    const int tid = threadIdx.x, lane = tid & 63, wave = tid >> 6, l15 = lane & 15, kq = lane >> 4;
    const bf16_t* KN = (const bf16_t*)(p.ws + WS_MIX + MX_KN); const bf16_t* KT = (const bf16_t*)(p.ws + WS_MIX + MX_KT); const bf16_t* VT = (const bf16_t*)(p.ws + WS_MIX + MX_VT);
    const float* BETA = (const float*)(p.ws + WS_MIX + MX_BETA); const float* GL = (const float*)(p.ws + WS_MIX + MX_GL);
    bf16_t* U = (bf16_t*)(p.ws + WS_MIX + MX_U); bf16_t* W = (bf16_t*)(p.ws + WS_MIX + MX_W);
    constexpr int TLD = 72;
    LAS unsigned char* wl = lds + wave * 18432;
    LAS float* Lm = (LAS float*)wl;
    LAS bf16_t* Tb = (LAS bf16_t*)wl;
    LAS bf16_t* Tg = (LAS bf16_t*)(wl + 64 * TLD * 2);
    for (int u = blockIdx.x * 8 + wave; u < 4096; u += gridDim.x * 8) {
        const int b = u >> 10, hv = (u >> 5) & 31, ch = u & 31, hk = hv >> 1, R0 = b * SEQ + ch * 64;
        const float beta = BETA[(size_t)(R0 + lane) * 32 + hv];
        float G = GL[(size_t)(R0 + lane) * 32 + hv];
#pragma unroll
        for (int o = 1; o < 64; o <<= 1) { const float t = __shfl_up(G, o); if (lane >= o) G += t; }
        bf16x8 kf[4][4];
#pragma unroll
        for (int ib = 0; ib < 4; ++ib)
#pragma unroll
            for (int ks = 0; ks < 4; ++ks) kf[ib][ks] = *(const bf16x8*)(KN + (size_t)(R0 + ib * 16 + l15) * D + hk * 128 + ks * 32 + kq * 8);
        const float Gj[4] = {__shfl(G, l15), __shfl(G, 16 + l15), __shfl(G, 32 + l15), __shfl(G, 48 + l15)};
#pragma unroll
        for (int ib = 0; ib < 4; ++ib) {
            float Gi[4], Bi[4];
#pragma unroll
            for (int r = 0; r < 4; ++r) { Gi[r] = __shfl(G, ib * 16 + kq * 4 + r); Bi[r] = __shfl(beta, ib * 16 + kq * 4 + r); }
#pragma unroll
            for (int jb = 0; jb <= ib; ++jb) {
                f32x4 acc = (f32x4){0.f, 0.f, 0.f, 0.f};
#pragma unroll
                for (int ks = 0; ks < 4; ++ks) acc = mfma16(kf[ib][ks], kf[jb][ks], acc);
#pragma unroll
                for (int r = 0; r < 4; ++r) { const int i = ib * 16 + kq * 4 + r, j = jb * 16 + l15;
                    Lm[i * 64 + j] = (i > j) ? Bi[r] * acc[r] * __expf(Gi[r] - Gj[jb]) : 0.f; }
            }
        }
        LDS_WAIT(); asm volatile("" ::: "memory");
        float T[64];
#pragma unroll
        for (int i = 0; i < 64; ++i) {
            float a0 = (lane == i) ? 1.f : 0.f, a1 = 0.f;
#pragma unroll
            for (int j4 = 0; j4 * 4 < i; ++j4) {
                const f32x4 lv = *(const LAS f32x4*)(Lm + i * 64 + j4 * 4);
                if (j4 * 4 + 0 < i) a0 -= lv.x * T[j4 * 4 + 0];
                if (j4 * 4 + 1 < i) a1 -= lv.y * T[j4 * 4 + 1];
                if (j4 * 4 + 2 < i) a0 -= lv.z * T[j4 * 4 + 2];
                if (j4 * 4 + 3 < i) a1 -= lv.w * T[j4 * 4 + 3];
            }
            T[i] = a0 + a1;
        }
        asm volatile("" ::: "memory");
        { const float sb = beta, sg = beta * __expf(G);
#pragma unroll
          for (int i = 0; i < 64; ++i) { Tb[i * TLD + lane] = (bf16_t)f2bf(T[i] * sb); Tg[i * TLD + lane] = (bf16_t)f2bf(T[i] * sg); } }
        LDS_WAIT(); asm volatile("" ::: "memory");
        const bf16_t* vt = VT + (size_t)u * 128 * 64; const bf16_t* kt = KT + ((((size_t)b * 16 + hk) * 32 + ch) * 128) * 64;
        bf16_t* uo = U + (size_t)u * 64 * 128; bf16_t* wo = W + (size_t)u * 64 * 128;
#pragma unroll 1
        for (int pass = 0; pass < 2; ++pass) {
            const bf16_t* src = pass ? kt : vt; const LAS bf16_t* Tm = pass ? Tg : Tb; bf16_t* dst = pass ? wo : uo;
            bf16x8 tf[4][2];
#pragma unroll
            for (int ib = 0; ib < 4; ++ib)
#pragma unroll
                for (int ks = 0; ks < 2; ++ks) tf[ib][ks] = *(const LAS bf16x8*)(Tm + (ib * 16 + l15) * TLD + ks * 32 + kq * 8);
#pragma unroll 2
            for (int eb = 0; eb < 8; ++eb) {
                const bf16x8 a0 = *(const bf16x8*)(src + (size_t)(eb * 16 + l15) * 64 + kq * 8), a1 = *(const bf16x8*)(src + (size_t)(eb * 16 + l15) * 64 + 32 + kq * 8);
#pragma unroll
                for (int ib = 0; ib < 4; ++ib) {
                    f32x4 acc = mfma16(a0, tf[ib][0], (f32x4){0.f, 0.f, 0.f, 0.f});
                    if (ib >= 2) acc = mfma16(a1, tf[ib][1], acc);
                    *(u32x2*)(dst + (size_t)(ib * 16 + l15) * 128 + eb * 16 + kq * 4) = (u32x2){pk2(acc[0], acc[1]), pk2(acc[2], acc[3])};
                }
            }
        }
        LDS_WAIT(); asm volatile("" ::: "memory");
    }
}

__device__ __forceinline__ void phase_gdn_scan(const P& p, int ic, LAS unsigned char* lds) {
    const int tid = threadIdx.x, lane = tid & 63, wave = tid >> 6, l15 = lane & 15, kq = lane >> 4;
    const bf16_t* QN = (const bf16_t*)(p.ws + WS_MIX + MX_QN); const bf16_t* KN = (const bf16_t*)(p.ws + WS_MIX + MX_KN); const bf16_t* KT = (const bf16_t*)(p.ws + WS_MIX + MX_KT);
    const float* GL = (const float*)(p.ws + WS_MIX + MX_GL);
    const bf16_t* U = (const bf16_t*)(p.ws + WS_MIX + MX_U); const bf16_t* W = (const bf16_t*)(p.ws + WS_MIX + MX_W);
    float* O = (float*)(p.ws + WS_MIX + MX_O);
    constexpr int LD1 = 136, LD2 = 72;
    LAS bf16_t* QS = (LAS bf16_t*)lds;
    LAS bf16_t* KS = QS + 64 * LD1;
    LAS bf16_t* WS = KS + 64 * LD1;
    LAS bf16_t* ST0 = WS + 64 * LD1;
    LAS bf16_t* ST1 = ST0 + 64 * LD1;
    LAS bf16_t* KTS = ST1 + 64 * LD1;
    LAS bf16_t* VNT = KTS + 128 * LD2;
    LAS bf16_t* VNS = VNT + 64 * LD2;
    LAS bf16_t* QK = VNS + 64 * LD2;
    for (int u = blockIdx.x; u < 256; u += gridDim.x) {
        const int b = u >> 6, hv = (u >> 1) & 31, eh = u & 1, hk = hv >> 1;
        f32x4 S[4];
#pragma unroll
        for (int eb = 0; eb < 4; ++eb) S[eb] = (f32x4){0.f, 0.f, 0.f, 0.f};
        __syncthreads();
        for (int i = tid; i < 64 * LD1 / 2; i += NT) ((LAS unsigned*)ST0)[i] = 0u;
#pragma unroll 1
        for (int ch = 0; ch < 32; ++ch) {
            const int R0 = b * SEQ + ch * 64; const size_t cu = ((size_t)(b * 32 + hv) * 32 + ch);
            LAS bf16_t* STc = (ch & 1) ? ST1 : ST0; LAS bf16_t* STn = (ch & 1) ? ST0 : ST1;
            __syncthreads();
            for (int i = tid; i < 1024; i += NT) { const int r = i >> 4, c = (i & 15) * 8;
                *(LAS u32x4*)(QS + r * LD1 + c) = *(const u32x4*)(QN + (size_t)(R0 + r) * D + hk * 128 + c);
                *(LAS u32x4*)(KS + r * LD1 + c) = *(const u32x4*)(KN + (size_t)(R0 + r) * D + hk * 128 + c);
                *(LAS u32x4*)(WS + r * LD1 + c) = *(const u32x4*)(W + cu * 8192 + r * 128 + c); }
            for (int i = tid; i < 1024; i += NT) { const int r = i >> 3, c = (i & 7) * 8;
                *(LAS u32x4*)(KTS + r * LD2 + c) = *(const u32x4*)(KT + ((((size_t)b * 16 + hk) * 32 + ch) * 128 + r) * 64 + c); }
            float G = GL[(size_t)(R0 + lane) * 32 + hv];
#pragma unroll
            for (int o = 1; o < 64; o <<= 1) { const float t = __shfl_up(G, o); if (lane >= o) G += t; }
            const float Glast = __shfl(G, 63);
            __syncthreads();
#pragma unroll
            for (int tt = 0; tt < 2; ++tt) {
                const int t = wave * 2 + tt, jb = t >> 2, ib = t & 3;
                f32x4 acc = (f32x4){0.f, 0.f, 0.f, 0.f};
#pragma unroll
                for (int ks = 0; ks < 4; ++ks) acc = mfma16(*(const LAS bf16x8*)(KS + (jb * 16 + l15) * LD1 + ks * 32 + kq * 8), *(const LAS bf16x8*)(QS + (ib * 16 + l15) * LD1 + ks * 32 + kq * 8), acc);
                const int i = ib * 16 + l15; const float Gi = __shfl(G, i);
                float o4[4];
#pragma unroll
                for (int r = 0; r < 4; ++r) { const int j = jb * 16 + kq * 4 + r; const float Gj = __shfl(G, j); o4[r] = (i >= j) ? acc[r] * __expf(Gi - Gj) : 0.f; }
                *(LAS u32x2*)(QK + i * LD2 + jb * 16 + kq * 4) = (u32x2){pk2(o4[0], o4[1]), pk2(o4[2], o4[3])};
            }
#pragma unroll
            for (int tt = 0; tt < 2; ++tt) {
                const int t = wave * 2 + tt, eb = t >> 2, tb = t & 3;
                f32x4 acc = (f32x4){0.f, 0.f, 0.f, 0.f};
#pragma unroll
                for (int ks = 0; ks < 4; ++ks) acc = mfma16(*(const LAS bf16x8*)(STc + (eb * 16 + l15) * LD1 + ks * 32 + kq * 8), *(const LAS bf16x8*)(WS + (tb * 16 + l15) * LD1 + ks * 32 + kq * 8), acc);
                const int tok = tb * 16 + l15, e0 = eb * 16 + kq * 4;
                const u32x2 uu = *(const u32x2*)(U + cu * 8192 + (size_t)tok * 128 + eh * 64 + e0);
                const float sc = __expf(Glast - __shfl(G, tok));
                const float vn[4] = {bf2f(uu.x & 0xffffu) - acc[0], bf2f(uu.x >> 16) - acc[1], bf2f(uu.y & 0xffffu) - acc[2], bf2f(uu.y >> 16) - acc[3]};
#pragma unroll
                for (int r = 0; r < 4; ++r) { VNT[(e0 + r) * LD2 + tok] = (bf16_t)f2bf(vn[r]); VNS[(e0 + r) * LD2 + tok] = (bf16_t)f2bf(vn[r] * sc); }
            }
            __syncthreads();
#pragma unroll
            for (int tt = 0; tt < 2; ++tt) {
                const int t = wave * 2 + tt, eb = t >> 2, tb = t & 3;
                f32x4 a1 = (f32x4){0.f, 0.f, 0.f, 0.f}, a2 = a1;
#pragma unroll
                for (int ks = 0; ks < 4; ++ks) a1 = mfma16(*(const LAS bf16x8*)(STc + (eb * 16 + l15) * LD1 + ks * 32 + kq * 8), *(const LAS bf16x8*)(QS + (tb * 16 + l15) * LD1 + ks * 32 + kq * 8), a1);
#pragma unroll
                for (int ks = 0; ks < 2; ++ks) a2 = mfma16(*(const LAS bf16x8*)(VNT + (eb * 16 + l15) * LD2 + ks * 32 + kq * 8), *(const LAS bf16x8*)(QK + (tb * 16 + l15) * LD2 + ks * 32 + kq * 8), a2);
                const int tok = tb * 16 + l15, e0 = eb * 16 + kq * 4; const float eg = __expf(__shfl(G, tok));
                *(f32x4*)(O + (size_t)(R0 + tok) * 4096 + hv * 128 + eh * 64 + e0) = a1 * eg + a2;
            }
            { const float ge = __expf(Glast);
              const bf16x8 k0 = *(const LAS bf16x8*)(KTS + (wave * 16 + l15) * LD2 + kq * 8), k1 = *(const LAS bf16x8*)(KTS + (wave * 16 + l15) * LD2 + 32 + kq * 8);
#pragma unroll
              for (int eb = 0; eb < 4; ++eb) {
                  f32x4 s = S[eb] * ge;
                  s = mfma16(k0, *(const LAS bf16x8*)(VNS + (eb * 16 + l15) * LD2 + kq * 8), s);
                  s = mfma16(k1, *(const LAS bf16x8*)(VNS + (eb * 16 + l15) * LD2 + 32 + kq * 8), s);
                  S[eb] = s;
                  *(LAS u32x2*)(STn + (eb * 16 + l15) * LD1 + wave * 16 + kq * 4) = (u32x2){pk2(s[0], s[1]), pk2(s[2], s[3])};
              } }
        }
        float* so = p.out + O_PGDN + (((size_t)ic * NBP + b) * 32 + hv) * 16384;
#pragma unroll
        for (int eb = 0; eb < 4; ++eb)
#pragma unroll
            for (int r = 0; r < 4; ++r) so[(size_t)(wave * 16 + kq * 4 + r) * 128 + eh * 64 + eb * 16 + l15] = S[eb][r];
    }
}

__device__ __forceinline__ void phase_gdn_step(const P& p, int ic, LAS unsigned char* lds) {
    const int tid = threadIdx.x, e = tid & 127, dq = tid >> 7;
    const bf16_t* QN = (const bf16_t*)(p.ws + WS_MIX + MX_QN); const bf16_t* KN = (const bf16_t*)(p.ws + WS_MIX + MX_KN);
    const float* VNAT = (const float*)(p.ws + WS_MIX + MX_VNAT); const float* BETA = (const float*)(p.ws + WS_MIX + MX_BETA); const float* GL = (const float*)(p.ws + WS_MIX + MX_GL);
    float* O = (float*)(p.ws + WS_MIX + MX_O);
    LAS float* qs = (LAS float*)lds; LAS float* ks = qs + 128; LAS float* red = ks + 128;
    for (int u = blockIdx.x; u < NBS * 32; u += gridDim.x) {
        const int b = u >> 5, hv = u & 31, hk = hv >> 1, R = MP + b;
        __syncthreads();
        if (tid < 128) qs[tid] = bf2f(QN[(size_t)R * D + hk * 128 + tid]); else if (tid < 256) ks[tid - 128] = bf2f(KN[(size_t)R * D + hk * 128 + tid - 128]);
        const float eg = __expf(GL[(size_t)R * 32 + hv]), beta = BETA[(size_t)R * 32 + hv];
        const float* sp = p.in[I_SGDN] + (((size_t)ic * NBS + b) * 32 + hv) * 16384; float* so = p.out + O_SGDN + (((size_t)ic * NBS + b) * 32 + hv) * 16384;
        float s[32];
#pragma unroll
        for (int i = 0; i < 32; ++i) s[i] = sp[(size_t)(dq * 32 + i) * 128 + e];
        __syncthreads();
        float sk = 0.f;
#pragma unroll
        for (int i = 0; i < 32; ++i) sk += s[i] * ks[dq * 32 + i];
        red[dq * 128 + e] = sk;
        __syncthreads();
        sk = red[e] + red[128 + e] + red[256 + e] + red[384 + e];
        const float vn = beta * (VNAT[(size_t)b * 4096 + hv * 128 + e] - eg * sk);
        float oo = 0.f;
#pragma unroll
        for (int i = 0; i < 32; ++i) { const float sn = eg * s[i] + ks[dq * 32 + i] * vn; so[(size_t)(dq * 32 + i) * 128 + e] = sn; oo += sn * qs[dq * 32 + i]; }
        __syncthreads();
        red[dq * 128 + e] = oo;
        __syncthreads();
        if (dq == 0) O[(size_t)R * 4096 + hv * 128 + e] = red[e] + red[128 + e] + red[256 + e] + red[384 + e];
    }
}

__device__ __forceinline__ void phase_gdn_post(const P& p, int ic) {
    const int lane = threadIdx.x & 63, wave = threadIdx.x >> 6;
    const float* proj = (const float*)(p.ws + WS_PROJ); const float* O = (const float*)(p.ws + WS_MIX + MX_O); bf16_t* YO = (bf16_t*)(p.ws + WS_YO);
    const f32x2 nw = *(const f32x2*)(p.in[I_GNORM] + (size_t)ic * 128 + lane * 2);
    for (int task = blockIdx.x * 8 + wave; task < MV * 32; task += gridDim.x * 8) {
        const int R = task >> 5, hv = task & 31;
        const f32x2 o = *(const f32x2*)(O + (size_t)R * 4096 + hv * 128 + lane * 2);
        const float rs = rsqrtf(wave_sum(o.x * o.x + o.y * o.y) * (1.f / 128.f) + 1e-6f);
        const f32x2 z = *(const f32x2*)(proj + (size_t)R * PLD_O + Z_OFF + hv * 128 + lane * 2);
        *(unsigned*)(YO + (size_t)R * 4096 + hv * 128 + lane * 2) = pk2(o.x * rs * nw.x * silu_(z.x), o.y * rs * nw.y * silu_(z.y));
    }
}

#define PG8_ALIGN true
#define PG8_SP2 true
template <class Epi> __device__ __forceinline__ void run_gemm(LAS unsigned char* lds, const bf16_t* A, const bf16_t* Bt, int M, int N, int K, const Epi& E) {
    pg8::Gemm g{A, Bt, M, N, K}; pg8::StaticOrder S; S.init(M, N, (int)gridDim.x, (int)blockIdx.x);
    pg8::gemm_phase<Epi, pg8::StaticOrder, PG8_ALIGN, PG8_SP2>(lds, g, S, E);
}
__device__ __forceinline__ void phase_gemm_mod(const P& p, LAS unsigned char* lds) {
    pg8::EpiF32 E{(float*)(p.ws + WS_MOD), MODLD, p.in[I_BMOD]};
    run_gemm(lds, (const bf16_t*)(p.ws + WS_SC), (const bf16_t*)(p.ws + WS_WMOD), 256, MODLD, D, E);
}
__device__ __forceinline__ void phase_gemm_inab(const P& p, int il, LAS unsigned char* lds) {
    pg8::EpiF32 E{(float*)(p.ws + WS_PROJ), PAB_PAD, nullptr};
    run_gemm(lds, (const bf16_t*)(p.ws + WS_H), (const bf16_t*)(p.ws + WS_WINAB) + (size_t)il * PAB_PAD * D, MPAD, PAB_PAD, D, E);
}
__device__ __forceinline__ void phase_gemm_outab(const P& p, int layer, LAS unsigned char* lds) {
    pg8::EpiResid E{(float*)(p.ws + WS_X), (const float*)(p.ws + WS_MOD) + (size_t)layer * 12288 + 2 * D};
    run_gemm(lds, (const bf16_t*)(p.ws + WS_YE), (const bf16_t*)(p.ws + WS_WOUTAB) + (size_t)(layer >> 1) * D * D, MPAD, D, D, E);
}
__device__ __forceinline__ void phase_gemm_inc(const P& p, int ic, LAS unsigned char* lds) {
    pg8::EpiF32 E{(float*)(p.ws + WS_PROJ), PC_PAD, nullptr};
    run_gemm(lds, (const bf16_t*)(p.ws + WS_H), (const bf16_t*)(p.ws + WS_WINC) + (size_t)ic * PC_PAD * D, MPAD, PC_PAD, D, E);
}
__device__ __forceinline__ void phase_gemm_outc(const P& p, int layer, LAS unsigned char* lds) {
    pg8::EpiResid E{(float*)(p.ws + WS_X), (const float*)(p.ws + WS_MOD) + (size_t)layer * 12288 + 2 * D};
    run_gemm(lds, (const bf16_t*)(p.ws + WS_YO), (const bf16_t*)(p.ws + WS_WOUTC) + (size_t)(layer >> 1) * D * 4096, MPAD, D, 4096, E);
}
__device__ __forceinline__ void phase_gemm_gate(const P& p, int layer, LAS unsigned char* lds) {
    pg8::EpiF32 E{(float*)(p.ws + WS_GBUF), DFF, nullptr};
    run_gemm(lds, (const bf16_t*)(p.ws + WS_H), (const bf16_t*)(p.ws + WS_WGATE) + (size_t)layer * DFF * D, MPAD, DFF, D, E);
}
__device__ __forceinline__ void phase_gemm_up(const P& p, int layer, LAS unsigned char* lds) {
    pg8::EpiFfnUp E{(bf16_t*)(p.ws + WS_ACT), (const float*)(p.ws + WS_GBUF), p.in[I_FCW] + (size_t)layer * 3 * DFF, p.in[I_FCB] + (size_t)layer * DFF, p.in[I_SFFNC] + (size_t)layer * NBS * 2 * DFF};
    run_gemm(lds, (const bf16_t*)(p.ws + WS_H), (const bf16_t*)(p.ws + WS_WUP) + (size_t)layer * DFF * D, MPAD, DFF, D, E);
}
__device__ __forceinline__ void phase_gemm_down(const P& p, int layer, LAS unsigned char* lds) {
    pg8::EpiResid E{(float*)(p.ws + WS_X), (const float*)(p.ws + WS_MOD) + (size_t)layer * 12288 + 5 * D};
    run_gemm(lds, (const bf16_t*)(p.ws + WS_ACT), (const bf16_t*)(p.ws + WS_WDOWN) + (size_t)layer * D * DFF, MPAD, D, DFF, E);
}

enum { PH_INIT = 0, PH_CONVERT, PH_GEMM_MOD, PH_NORM_MIX, PH_NORM_FFN, PH_GEMM_INAB, PH_RWKV_PREP, PH_RWKV_SCAN, PH_RWKV_POST, PH_LRU_GATES, PH_LRU_LOCAL, PH_LRU_CARRY,
       PH_LRU_APPLY, PH_STATES_EVEN, PH_GEMM_OUTAB, PH_GEMM_INC, PH_GDN_PREP, PH_GDN_WY, PH_GDN_SCAN, PH_GDN_STEP, PH_GDN_POST, PH_STATES_ODD, PH_GEMM_OUTC,
       PH_GEMM_GATE, PH_GEMM_UP, PH_STATES_FFN, PH_GEMM_DOWN, PH_FINAL, PH_COUNT };

template <int PH> __global__ void __launch_bounds__(NT, 2) k_phase(P p, int layer) {
    extern __shared__ __attribute__((aligned(16))) unsigned char smem[];
    LAS unsigned char* lds = (LAS unsigned char*)smem;
    const int il = layer >> 1;
    if constexpr (PH == PH_INIT) phase_init(p);
    if constexpr (PH == PH_CONVERT) phase_convert(p, lds);
    if constexpr (PH == PH_GEMM_MOD) phase_gemm_mod(p, lds);
    if constexpr (PH == PH_NORM_MIX) phase_norm(p, layer, 0);
    if constexpr (PH == PH_NORM_FFN) phase_norm(p, layer, 1);
    if constexpr (PH == PH_GEMM_INAB) phase_gemm_inab(p, il, lds);
    if constexpr (PH == PH_RWKV_PREP) phase_rwkv_prep(p, il, lds);
    if constexpr (PH == PH_RWKV_SCAN) phase_rwkv_scan(p, il, lds);
    if constexpr (PH == PH_RWKV_POST) phase_rwkv_post(p, il);
    if constexpr (PH == PH_LRU_GATES) phase_lru_gates(p, il, lds);
    if constexpr (PH == PH_LRU_LOCAL) phase_lru_local(p);
    if constexpr (PH == PH_LRU_CARRY) phase_lru_carry(p, il);
    if constexpr (PH == PH_LRU_APPLY) phase_lru_apply(p, il);
    if constexpr (PH == PH_STATES_EVEN) phase_states_even(p, il);
    if constexpr (PH == PH_GEMM_OUTAB) phase_gemm_outab(p, layer, lds);
    if constexpr (PH == PH_GEMM_INC) phase_gemm_inc(p, il, lds);
    if constexpr (PH == PH_GDN_PREP) phase_gdn_prep(p, il, lds);
    if constexpr (PH == PH_GDN_WY) phase_gdn_wy(p, lds);
    if constexpr (PH == PH_GDN_SCAN) phase_gdn_scan(p, il, lds);
    if constexpr (PH == PH_GDN_STEP) phase_gdn_step(p, il, lds);
    if constexpr (PH == PH_GDN_POST) phase_gdn_post(p, il);
    if constexpr (PH == PH_STATES_ODD) phase_states_odd(p, il);
    if constexpr (PH == PH_GEMM_OUTC) phase_gemm_outc(p, layer, lds);
    if constexpr (PH == PH_GEMM_GATE) phase_gemm_gate(p, layer, lds);
    if constexpr (PH == PH_GEMM_UP) phase_gemm_up(p, layer, lds);
    if constexpr (PH == PH_STATES_FFN) phase_states_ffn(p, layer);
    if constexpr (PH == PH_GEMM_DOWN) phase_gemm_down(p, layer, lds);
    if constexpr (PH == PH_FINAL) phase_final_norm(p);
}

template <int PH> static void launch_phase(const P& p, int layer, int grid, hipStream_t stream) {
    static bool attr_done = false;
    if (!attr_done) { (void)hipFuncSetAttribute((const void*)k_phase<PH>, hipFuncAttributeMaxDynamicSharedMemorySize, LDS_BYTES); attr_done = true; }
    hipLaunchKernelGGL(k_phase<PH>, dim3(grid), dim3(NT), LDS_BYTES, stream, p, layer);
}

extern "C" void kernel_launch(void* const* d_in, const int* in_sizes, int n_in, void* d_out, int out_size, void* d_ws, size_t ws_size, hipStream_t stream) {
    if (n_in != N_IN || (size_t)out_size != O_TOTAL || ws_size < WS_END) { fprintf(stderr, "kernel_launch: unexpected shapes (n_in %d, out %d, ws %zu need %zu)\n", n_in, out_size, ws_size, (size_t)WS_END); return; }
    P p{};
    for (int i = 0; i < N_IN; ++i) p.in[i] = (const float*)d_in[i];
    p.out = (float*)d_out; p.ws = (unsigned char*)d_ws;
    const int G = 256;
    launch_phase<PH_INIT>(p, 0, G, stream);
    launch_phase<PH_CONVERT>(p, 0, G, stream);
    launch_phase<PH_GEMM_MOD>(p, 0, G, stream);
    for (int layer = 0; layer < 4; ++layer) {
        launch_phase<PH_NORM_MIX>(p, layer, G, stream);
        if ((layer & 1) == 0) {
            launch_phase<PH_GEMM_INAB>(p, layer, G, stream);
            launch_phase<PH_RWKV_PREP>(p, layer, G, stream);
            launch_phase<PH_RWKV_SCAN>(p, layer, G, stream);
            launch_phase<PH_RWKV_POST>(p, layer, G, stream);
            launch_phase<PH_LRU_GATES>(p, layer, G, stream);
            launch_phase<PH_LRU_LOCAL>(p, layer, G, stream);
            launch_phase<PH_LRU_CARRY>(p, layer, G, stream);
            launch_phase<PH_LRU_APPLY>(p, layer, G, stream);
            launch_phase<PH_STATES_EVEN>(p, layer, G, stream);
            launch_phase<PH_GEMM_OUTAB>(p, layer, G, stream);
        } else {
            launch_phase<PH_GEMM_INC>(p, layer, G, stream);
            launch_phase<PH_GDN_PREP>(p, layer, G, stream);
            launch_phase<PH_GDN_WY>(p, layer, G, stream);
            launch_phase<PH_GDN_SCAN>(p, layer, G, stream);
            launch_phase<PH_GDN_STEP>(p, layer, G, stream);
            launch_phase<PH_GDN_POST>(p, layer, G, stream);
            launch_phase<PH_STATES_ODD>(p, layer, G, stream);
            launch_phase<PH_GEMM_OUTC>(p, layer, G, stream);
        }
        launch_phase<PH_NORM_FFN>(p, layer, G, stream);
        launch_phase<PH_GEMM_GATE>(p, layer, G, stream);
        launch_phase<PH_GEMM_UP>(p, layer, G, stream);
        launch_phase<PH_STATES_FFN>(p, layer, G, stream);
        launch_phase<PH_GEMM_DOWN>(p, layer, G, stream);
    }
    launch_phase<PH_FINAL>(p, 0, G, stream);
}
```

```cpp
#include <hip/hip_runtime.h>
#include <cstdio>
#include <cstdint>

#define GAS __attribute__((address_space(1)))
#define LAS __attribute__((address_space(3)))
typedef unsigned short bf16_t;
typedef short bf16x8 __attribute__((ext_vector_type(8)));
typedef float f32x4 __attribute__((ext_vector_type(4)));
typedef float f32x2 __attribute__((ext_vector_type(2)));
typedef unsigned u32x4 __attribute__((ext_vector_type(4)));
typedef unsigned u32x2 __attribute__((ext_vector_type(2)));

constexpr int D = 2048, SEQ = 2048, NBP = 4, NBS = 128;
constexpr int MP = NBP * SEQ;
constexpr int MV = MP + NBS;
constexpr int MPAD = 8448;
constexpr int NSEQ = NBP + NBS;
constexpr int PA = 3360, PAB = 5408, PAB_PAD = 5632, XB_OFF = 4384, GATE_OFF = 3360;
constexpr int PC = 12352, PC_PAD = 12544, QKV = 8192, Z_OFF = 8192, B_OFF = 12288, A_OFF = 12320;
constexpr int DFF = 5632;
constexpr int MODLD = 4 * 6 * D;

enum { I_XP = 0, I_XS, I_CP, I_CS, I_SWKV, I_SSHIFT, I_SLRUH, I_SLRUC, I_SGDN, I_SGDNC, I_SFFNC, I_WMOD, I_BMOD, I_NMIX, I_NFFN, I_NOUT,
       I_WINAB, I_WOUTAB, I_MU, I_W0, I_W2, I_A0, I_A2, I_G2, I_KK, I_KA, I_RK, I_GNW, I_GNB, I_LCW, I_LCB, I_LWA, I_LBA, I_LWX, I_LBX, I_LLAM,
       I_WINC, I_WOUTC, I_GCW, I_GALOG, I_GDTB, I_GNORM, I_FWG, I_FWU, I_FCW, I_FCB, I_FWD, N_IN };

constexpr size_t O_YP = 0, O_YS = 16777216, O_PWKV = 17039360, O_PSHIFT = 17563648, O_PLRUH = 17590528, O_PLRUC = 17598720, O_PGDN = 17623296,
                 O_PGDNC = 21817600, O_PFFNC = 22014208, O_SWKV = 22194432, O_SSHIFT = 38971648, O_SLRUH = 39831808, O_SLRUC = 40093952,
                 O_SGDN = 40880384, O_SGDNC = 175098112, O_SFFNC = 181389568, O_TOTAL = 187156736;

constexpr size_t al256(size_t x) { return (x + 255) & ~(size_t)255; }
constexpr size_t WS_CTL = 0, CTL_BYTES = 1 << 20;
constexpr size_t WS_WINAB = WS_CTL + CTL_BYTES;
constexpr size_t WS_WOUTAB = WS_WINAB + (size_t)2 * PAB_PAD * D * 2;
constexpr size_t WS_WINC = WS_WOUTAB + (size_t)2 * D * D * 2;
constexpr size_t WS_WOUTC = WS_WINC + (size_t)2 * PC_PAD * D * 2;
constexpr size_t WS_WGATE = WS_WOUTC + (size_t)2 * D * 4096 * 2;
constexpr size_t WS_WUP = WS_WGATE + (size_t)4 * DFF * D * 2;
constexpr size_t WS_WDOWN = WS_WUP + (size_t)4 * DFF * D * 2;
constexpr size_t WS_W2T = WS_WDOWN + (size_t)4 * D * DFF * 2;
constexpr size_t WS_A2T = WS_W2T + (size_t)2 * 1024 * 64 * 2;
constexpr size_t WS_G2T = WS_A2T + (size_t)2 * 1024 * 64 * 2;
constexpr size_t WS_WAT = WS_G2T + (size_t)2 * 1024 * 160 * 2;
constexpr size_t WS_WXT = WS_WAT + (size_t)2 * 16 * 64 * 64 * 2;
constexpr size_t WS_SC = WS_WXT + (size_t)2 * 16 * 64 * 64 * 2;
constexpr size_t WS_MOD = WS_SC + (size_t)256 * D * 2;
constexpr size_t WS_X = WS_MOD + (size_t)256 * MODLD * 4;
constexpr size_t WS_H = WS_X + (size_t)MPAD * D * 4;
constexpr size_t WS_PROJ = WS_H + (size_t)MPAD * D * 2;
constexpr size_t WS_YE = WS_PROJ + (size_t)MPAD * PC_PAD * 4;
constexpr size_t WS_YO = WS_YE + (size_t)MPAD * D * 2;
constexpr size_t WS_GBUF = WS_YO + (size_t)MPAD * 4096 * 2;
constexpr size_t WS_ACT = WS_GBUF + (size_t)MPAD * DFF * 4;
constexpr size_t WS_MIX = WS_ACT + (size_t)MPAD * DFF * 2;
constexpr size_t MX_SCB = 0;
constexpr size_t MX_GG = MX_SCB + (size_t)16 * MV * 384 * 4;
constexpr size_t MX_C123 = MX_GG + (size_t)MV * 1024 * 4;
constexpr size_t MX_YRAW = MX_C123 + (size_t)MV * 64 * 4;
constexpr size_t MX_LA = MX_YRAW + (size_t)MV * 1024 * 4;
constexpr size_t MX_LB = MX_LA + (size_t)MV * 1024 * 4;
constexpr size_t MX_HL = MX_LB + (size_t)MV * 1024 * 4;
constexpr size_t MX_PP = MX_HL + (size_t)MV * 1024 * 4;
constexpr size_t MX_HEND = MX_PP + (size_t)MV * 1024 * 4;
constexpr size_t MX_PEND = MX_HEND + (size_t)128 * 1024 * 4;
constexpr size_t MX_CARRY = MX_PEND + (size_t)128 * 1024 * 4;
constexpr size_t MX_EVEN_END = MX_CARRY + (size_t)128 * 1024 * 4;
constexpr size_t MX_QN = 0;
constexpr size_t MX_KN = MX_QN + (size_t)MPAD * D * 2;
constexpr size_t MX_KT = MX_KN + (size_t)MPAD * D * 2;
constexpr size_t MX_VT = MX_KT + (size_t)4 * 16 * 32 * 128 * 64 * 2;
constexpr size_t MX_VNAT = MX_VT + (size_t)4 * 32 * 32 * 128 * 64 * 2;
constexpr size_t MX_BETA = MX_VNAT + (size_t)128 * 4096 * 4;
constexpr size_t MX_GL = MX_BETA + (size_t)MV * 32 * 4;
constexpr size_t MX_U = MX_GL + (size_t)MV * 32 * 4;
constexpr size_t MX_W = MX_U + (size_t)4096 * 64 * 128 * 2;
constexpr size_t MX_O = MX_W + (size_t)4096 * 64 * 128 * 2;
constexpr size_t MX_ODD_END = MX_O + (size_t)MV * 4096 * 4;
constexpr size_t MX_SIZE = (MX_EVEN_END > MX_ODD_END ? MX_EVEN_END : MX_ODD_END);
constexpr size_t WS_SLAB = WS_MIX + MX_SIZE;
constexpr size_t WS_WMOD = WS_SLAB + (size_t)22 * 128 * 2048 * 4;
constexpr size_t WS_END = WS_WMOD + (size_t)MODLD * D * 2;
static_assert(WS_END <= (size_t)2147483648u, "workspace map exceeds 2 GiB");

constexpr int LDS_BYTES = 152 * 1024;
constexpr int NT = 512;

struct P { const float* in[N_IN]; float* out; unsigned char* ws; };

__device__ __forceinline__ float fexp_(float x) { return __builtin_amdgcn_exp2f(x * 1.4426950408889634f); }
__device__ __forceinline__ float flog_(float x) { return __builtin_amdgcn_logf(x) * 0.6931471805599453f; }
__device__ __forceinline__ float one_minus_exp_(float x) { const float s = -x * (1.f + x * (0.5f + x * (0.16666667f + x * (0.041666668f + x * 0.008333334f)))); return x > -0.25f ? s : 1.f - fexp_(x); }
__device__ __forceinline__ float bf2f(unsigned b) { return __uint_as_float(b << 16); }
typedef __bf16 bf16n2 __attribute__((ext_vector_type(2)));
__device__ __forceinline__ unsigned pk2(float lo, float hi) { const bf16n2 v = __builtin_convertvector((f32x2){lo, hi}, bf16n2); return __builtin_bit_cast(unsigned, v); }
__device__ __forceinline__ unsigned f2bf(float f) { return pk2(f, 0.f) & 0xffffu; }
__device__ __forceinline__ float sigmoid_(float x) { return __builtin_amdgcn_rcpf(1.f + fexp_(-x)); }
__device__ __forceinline__ float softplus_(float x) { return x > 15.f ? x : flog_(1.f + fexp_(x)); }
__device__ __forceinline__ float silu_(float x) { return x * sigmoid_(x); }
__device__ __forceinline__ float gelu_tanh_(float x) { const float u = 0.7978845608028654f * (x + 0.044715f * x * x * x); return x * sigmoid_(2.f * u); }
__device__ __forceinline__ float tanh_(float x) { return 1.f - 2.f * __builtin_amdgcn_rcpf(1.f + fexp_(2.f * x)); }
__device__ __forceinline__ float wave_sum(float v) {
#pragma unroll
    for (int o = 1; o < 64; o <<= 1) v += __shfl_xor(v, o);
    return v;
}
template <int CTRL> __device__ __forceinline__ float dpp_add(float v) {
    const int t = __builtin_amdgcn_update_dpp(0, __float_as_int(v), CTRL, 0xF, 0xF, true);
    return v + __int_as_float(t);
}
__device__ __forceinline__ float allreduce4(float v) { v = dpp_add<0xB1>(v); v = dpp_add<0x4E>(v); return v; }
__device__ __forceinline__ float allreduce8(float v) { v = allreduce4(v); v = dpp_add<0x141>(v); return v; }
__device__ __forceinline__ float allreduce16(float v) { v = allreduce8(v); v = dpp_add<0x140>(v); return v; }
__device__ __forceinline__ f32x4 mfma16(bf16x8 a, bf16x8 b, f32x4 c) { return __builtin_amdgcn_mfma_f32_16x16x32_bf16(a, b, c, 0, 0, 0); }
__device__ __forceinline__ int bidx_of(int r) { const int s = 4 + r - MP; return r < MP ? (r >> 11) : (s < 255 ? s : 255); }
__device__ __forceinline__ int tid_() { int t = threadIdx.x; asm volatile("" : "+v"(t)); return t; }
#define TIDX tid_()
__device__ __forceinline__ int zero_() { int z = 0; asm volatile("" : "+s"(z)); return z; }
__device__ __forceinline__ float ldb1(const bf16_t* q) { return bf2f(*q); }
__device__ __forceinline__ f32x2 ldb2(const bf16_t* q) { const unsigned u = *(const unsigned*)q; return (f32x2){__uint_as_float(u << 16), __uint_as_float(u & 0xffff0000u)}; }
__device__ __forceinline__ f32x4 ldb4(const bf16_t* q) { const u32x2 u = *(const u32x2*)q; return (f32x4){__uint_as_float(u.x << 16), __uint_as_float(u.x & 0xffff0000u), __uint_as_float(u.y << 16), __uint_as_float(u.y & 0xffff0000u)}; }
#define LDS_BARRIER() do { asm volatile("s_waitcnt lgkmcnt(0)" ::: "memory"); __builtin_amdgcn_s_barrier(); asm volatile("" ::: "memory"); } while (0)
__device__ __forceinline__ u32x4 zero4_() { unsigned z = 0u; asm volatile("" : "+v"(z)); return (u32x4){z, z, z, z}; }
namespace pg8 {
#define PG8_LAS __attribute__((address_space(3)))
typedef unsigned short bf16_t;
typedef short bf16x8 __attribute__((ext_vector_type(8)));
typedef float f32x4 __attribute__((ext_vector_type(4)));
typedef unsigned u32x4 __attribute__((ext_vector_type(4)));
constexpr int BM = 256, BK = 64, HALF = 128, HTB = HALF * BK * 2  , STAGE_BYTES = 8 * HTB, NXCD = 8, WGM = 8;

__host__ __device__ __forceinline__ int lds_byte(int r, int c) { const int st = (r >> 4) * 2 + (c >> 5), rr = r & 15, cc = c & 31, ob = rr * 64 + cc * 2; return st * 1024 + (ob ^ (((ob >> 9) & 1) << 5)); }
__host__ __device__ __forceinline__ void stage_rc(int b, int& R, int& C) { const int st = b / 1024, sb = b % 1024, swz = sb ^ (((sb >> 9) & 1) << 5); R = (st >> 1) * 16 + swz / 64; C = (st & 1) * 32 + (swz % 64) / 2; }
__host__ __device__ __forceinline__ int perm32(int rho) { const int n = rho >> 4, i = rho & 15; return 8 * (i >> 2) + 4 * n + (i & 3); }

struct Unit { int pm, pn, k0; };
struct Gemm { const bf16_t* A; const bf16_t* Bt; int M, N, K, ld; };

struct StaticOrder {
    int nM, nN, nwg, G, c;
    __host__ __device__ void init(int M, int N, int G_, int c_) { nM = M / BM; nN = N / BM; nwg = nM * nN; G = G_; c = c_; }
    __host__ __device__ bool next(int i, Unit& u) const {
        const long L = (long)i * G + c; if (L >= nwg) return false;
        int wgid = (int)L; { const int q = nwg / NXCD, r = nwg % NXCD, xcd = wgid % NXCD, off = wgid / NXCD; wgid = (xcd < r ? xcd * (q + 1) : r * (q + 1) + (xcd - r) * q) + off; }
        const int nig = WGM * nN, gid = wgid / nig, fm = gid * WGM, gsz = (nM - fm) < WGM ? (nM - fm) : WGM;
        u.pm = fm + ((wgid % nig) % gsz); u.pn = (wgid % nig) / gsz; u.k0 = 0; return true;
    }
    __device__ __forceinline__ void a_ready(const Unit&) const {}
    __device__ __forceinline__ void done(const Unit&) const {}
};

struct SplitOrder {
    int pm, nN, nsplit, ksplit, G, c;
    __host__ __device__ void init(int pm_, int nN_, int nsplit_, int ksplit_, int G_, int c_) { pm = pm_; nN = nN_; nsplit = nsplit_; ksplit = ksplit_; G = G_; c = c_; }
    __host__ __device__ bool next(int i, Unit& u) const { const int L = i * G + c; if (L >= nN * nsplit) return false; u.pm = pm; u.pn = L % nN; u.k0 = (L / nN) * ksplit; return true; }
    __device__ __forceinline__ void a_ready(const Unit&) const {}
    __device__ __forceinline__ void done(const Unit&) const {}
};

__device__ __forceinline__ unsigned cvt_pk_bf16(float lo, float hi) { unsigned r; asm volatile("v_cvt_pk_bf16_f32 %0, %1, %2" : "=v"(r) : "v"(lo), "v"(hi)); return r; }

struct EpiF32 {
    static constexpr bool PERM = false, AFTER_DRAIN = false;
    float* C; int ldc; const float* bias;
    __device__ __forceinline__ void operator()(const f32x4 (&acc)[2][2][4][2], const Unit& u, int wr, int wc, int fr, int fq) const {
        const int row0 = u.pm * BM + wr * 64 + fr, col0 = u.pn * BM + wc * 32 + 4 * fq;
        f32x4 bv[2][2];
#pragma unroll
        for (int bj = 0; bj < 2; ++bj)
#pragma unroll
            for (int n = 0; n < 2; ++n) bv[bj][n] = bias ? *(const f32x4*)(bias + col0 + bj * HALF + n * 16) : (f32x4){0.f, 0.f, 0.f, 0.f};
#pragma unroll
        for (int ai = 0; ai < 2; ++ai)
#pragma unroll
            for (int m = 0; m < 4; ++m) { float* rowp = C + (size_t)(row0 + ai * HALF + m * 16) * ldc + col0;
#pragma unroll
                for (int bj = 0; bj < 2; ++bj)
#pragma unroll
                    for (int n = 0; n < 2; ++n) *(f32x4*)(rowp + bj * HALF + n * 16) = acc[ai][bj][m][n] + bv[bj][n]; }
    }
};

struct EpiResid {
    static constexpr bool PERM = false, AFTER_DRAIN = false;
    float* X; const float* gate; const float* Xin;
    __device__ __forceinline__ void ld_row(int it, int row0, int col0, f32x4 (&g)[4], f32x4 (&x)[4]) const {
        const int r = row0 + (it >> 2) * HALF + (it & 3) * 16; const int s = 4 + r - 8192; const int bi = r < 8192 ? (r >> 11) : (s < 255 ? s : 255);
        const float* xi = Xin + (size_t)r * 2048 + col0; const float* gp = gate + (size_t)bi * 49152 + col0;
#pragma unroll
        for (int q = 0; q < 4; ++q) { const int o = (q >> 1) * HALF + (q & 1) * 16; g[q] = *(const f32x4*)(gp + o); x[q] = *(const f32x4*)(xi + o); }
    }
    __device__ __forceinline__ void operator()(const f32x4 (&acc)[2][2][4][2], const Unit& u, int wr, int wc, int fr, int fq) const {
        const int row0 = u.pm * BM + wr * 64 + fr, col0 = u.pn * BM + wc * 32 + 4 * fq;
        f32x4 g[4], x[4], gn[4], xn[4];
        ld_row(0, row0, col0, g, x);
#pragma unroll
        for (int it = 0; it < 8; ++it) {
            if (it < 7) ld_row(it + 1, row0, col0, gn, xn);
            const int ai = it >> 2, m = it & 3; float* xp = X + (size_t)(row0 + ai * HALF + m * 16) * 2048 + col0;
#pragma unroll
            for (int q = 0; q < 4; ++q) { const int bj = q >> 1, n = q & 1; *(f32x4*)(xp + bj * HALF + n * 16) = x[q] + g[q] * acc[ai][bj][m][n]; }
#pragma unroll
            for (int q = 0; q < 4; ++q) { g[q] = gn[q]; x[q] = xn[q]; }
        }
    }
};

struct EpiResidNorm {
    static constexpr bool PERM = true, AFTER_DRAIN = false;
    float* X; const float* gate; const float* Xin; bf16_t* H; const float* gain; const float* modn; float* stats; unsigned* cnt; bool fuse;
    __device__ __forceinline__ void ld_x(int it, int row0, int col0, f32x4 (&x)[4]) const {
        const int r = row0 + (it >> 2) * HALF + (it & 3) * 16; const float* xi = Xin + (size_t)r * 2048 + col0;
#pragma unroll
        for (int q = 0; q < 4; ++q) x[q] = *(const f32x4*)(xi + (q >> 1) * HALF + (q & 1) * 4);
    }
    __device__ __forceinline__ void operator()(const f32x4 (&acc_)[2][2][4][2], const Unit& u, int wr, int wc, int fr, int fq) const {
        f32x4 (&acc)[2][2][4][2] = const_cast<f32x4 (&)[2][2][4][2]>(acc_);
        const int row0 = u.pm * BM + wr * 64 + fr, col0 = u.pn * BM + wc * 32 + 8 * fq;
        f32x4 g[4], x[4], xn[4]; float dummy = 0.f, ssq[8];
        { const float* gp = gate + (size_t)(row0 >> 11) * 49152 + col0;
#pragma unroll
          for (int q = 0; q < 4; ++q) g[q] = *(const f32x4*)(gp + (q >> 1) * HALF + (q & 1) * 4); }
        ld_x(0, row0, col0, x);
#pragma unroll
        for (int it = 0; it < 8; ++it) {
            if (it < 7) ld_x(it + 1, row0, col0, xn);
            const int ai = it >> 2, m = it & 3, r = row0 + ai * HALF + m * 16; float* xp = X + (size_t)r * 2048 + col0;
            float ss = 0.f;
#pragma unroll
            for (int q = 0; q < 4; ++q) { const int bj = q >> 1, n = q & 1; const f32x4 v = x[q] + g[q] * acc[ai][bj][m][n]; *(f32x4*)(xp + bj * HALF + n * 4) = v; acc[ai][bj][m][n] = v;
                ss += v.x * v.x + v.y * v.y + v.z * v.z + v.w * v.w; }
            ssq[it] = ss;
#pragma unroll
            for (int q = 0; q < 4; ++q) x[q] = xn[q];
        }
        if (!fuse) return;
#pragma unroll
        for (int it = 0; it < 8; ++it) { float ss = ssq[it]; ss += __shfl_xor(ss, 16); ss += __shfl_xor(ss, 32); ssq[it] = ss; }
        if (fq == 0) {
#pragma unroll
            for (int it = 0; it < 8; ++it) ssq[it] = unsafeAtomicAdd(stats + row0 + (it >> 2) * HALF + (it & 3) * 16, ssq[it]);
#pragma unroll
            for (int it = 0; it < 8; ++it) dummy += ssq[it];
        }
        asm volatile("s_waitcnt vmcnt(0)" :: "v"(dummy) : "memory");
        unsigned* cp = cnt + (u.pm * 2 + wr) * 32;
        if (fr == 0 && fq == 0) (void)atomicAdd(cp, 1u);
        { unsigned v; do { v = __hip_atomic_load(cp, __ATOMIC_RELAXED, __HIP_MEMORY_SCOPE_AGENT); if (v < 32u) __builtin_amdgcn_s_sleep(8); } while (v < 32u); }
        asm volatile("" ::: "memory");
        float rstd[8];
#pragma unroll
        for (int it = 0; it < 8; ++it) rstd[it] = rsqrtf(__hip_atomic_load(stats + row0 + (it >> 2) * HALF + (it & 3) * 16, __ATOMIC_RELAXED, __HIP_MEMORY_SCOPE_AGENT) * (1.f / 2048.f) + 1e-6f);
        const float* mrow = modn + (size_t)(row0 >> 11) * 49152 + col0; const float* gp = gain + col0;
#pragma unroll
        for (int bj = 0; bj < 2; ++bj) {
            f32x4 m0 = *(const f32x4*)(gp + bj * HALF) * (*(const f32x4*)(mrow + 2048 + bj * HALF) + 1.f), m1 = *(const f32x4*)(gp + bj * HALF + 4) * (*(const f32x4*)(mrow + 2048 + bj * HALF + 4) + 1.f);
            const f32x4 s0 = *(const f32x4*)(mrow + bj * HALF), s1 = *(const f32x4*)(mrow + bj * HALF + 4);
#pragma unroll
            for (int it = 0; it < 8; ++it) {
                const int ai = it >> 2, m = it & 3, r = row0 + ai * HALF + m * 16;
                const f32x4 o0 = acc[ai][bj][m][0] * rstd[it] * m0 + s0, o1 = acc[ai][bj][m][1] * rstd[it] * m1 + s1;
                u32x4 w; w.x = cvt_pk_bf16(o0[0], o0[1]); w.y = cvt_pk_bf16(o0[2], o0[3]); w.z = cvt_pk_bf16(o1[0], o1[1]); w.w = cvt_pk_bf16(o1[2], o1[3]);
                *(u32x4*)(H + (size_t)r * 2048 + col0 + bj * HALF) = w;
            }
        }
    }
};

struct EpiFfnUp {
    static constexpr bool PERM = true, AFTER_DRAIN = false;
    bf16_t* O; const bf16_t* G; const float* cw; const float* cb; const float* sbuf;
    static __device__ __forceinline__ void unpack8(const u32x4 q, f32x4& lo, f32x4& hi) {
        lo = (f32x4){__uint_as_float(q.x << 16), __uint_as_float(q.x & 0xffff0000u), __uint_as_float(q.y << 16), __uint_as_float(q.y & 0xffff0000u)};
        hi = (f32x4){__uint_as_float(q.z << 16), __uint_as_float(q.z & 0xffff0000u), __uint_as_float(q.w << 16), __uint_as_float(q.w & 0xffff0000u)}; }
    static __device__ __forceinline__ f32x4 act4(const f32x4 uu, const f32x4 a) {
        f32x4 o;
#pragma unroll
        for (int j = 0; j < 4; ++j) { const float x = uu[j]; const float z = x * (0.7978845608028654f + 0.035677408136300125f * x * x);
            o[j] = x * __builtin_amdgcn_rcpf(1.f + __builtin_amdgcn_exp2f(-2.885390081777927f * z)) * a[j]; }
        return o; }
    __device__ __forceinline__ void operator()(const f32x4 (&acc)[2][2][4][2], const Unit& u, int wr, int wc, int fr, int fq) const {
        const int row0 = u.pm * BM + wr * 64 + fr, col0 = u.pn * BM + wc * 32 + 8 * fq;
        const bool prompt = u.pm < 32;
#pragma unroll
        for (int bj = 0; bj < 2; ++bj) {
            const int c = col0 + bj * HALF;
            f32x4 w0[2], w1[2], w2[2], bb[2];
#pragma unroll
            for (int n = 0; n < 2; ++n) { w0[n] = *(const f32x4*)(cw + c + 4 * n); w1[n] = *(const f32x4*)(cw + 5632 + c + 4 * n); w2[n] = *(const f32x4*)(cw + 2 * 5632 + c + 4 * n); bb[n] = *(const f32x4*)(cb + c + 4 * n); }
            if (prompt) {
#pragma unroll
                for (int ai = 0; ai < 2; ++ai)
#pragma unroll
                    for (int m = 0; m < 4; ++m) {
                        const int r = row0 + ai * HALF + m * 16, t = r & 2047;
                        const bf16_t* g0p = G + (size_t)r * 5632 + c;
                        const u32x4 q0 = *(const u32x4*)g0p, q1 = *(const u32x4*)(g0p - (t >= 1 ? 5632 : 0)), q2 = *(const u32x4*)(g0p - (t >= 2 ? 2 * 5632 : 0));
                        f32x4 g0[2], g1[2], g2[2]; unpack8(q0, g0[0], g0[1]); unpack8(q1, g1[0], g1[1]); unpack8(q2, g2[0], g2[1]);
                        const float h1 = t >= 1 ? 1.f : 0.f, h2 = t >= 2 ? 1.f : 0.f;
                        const f32x4 o0 = act4(w0[0] * (g2[0] * h2) + w1[0] * (g1[0] * h1) + w2[0] * g0[0] + bb[0], acc[ai][bj][m][0]);
                        const f32x4 o1 = act4(w0[1] * (g2[1] * h2) + w1[1] * (g1[1] * h1) + w2[1] * g0[1] + bb[1], acc[ai][bj][m][1]);
                        u32x4 w; w.x = cvt_pk_bf16(o0[0], o0[1]); w.y = cvt_pk_bf16(o0[2], o0[3]); w.z = cvt_pk_bf16(o1[0], o1[1]); w.w = cvt_pk_bf16(o1[2], o1[3]);
                        *(u32x4*)(O + (size_t)r * 5632 + c) = w;
                    }
            } else {
#pragma unroll
                for (int ai = 0; ai < 2; ++ai)
#pragma unroll
                    for (int m = 0; m < 4; ++m) {
                        const int r = row0 + ai * HALF + m * 16, b = r - 8192; const bool hv = b < 128; const int bb_ = hv ? b : 0;
                        f32x4 g0[2]; unpack8(*(const u32x4*)(G + (size_t)r * 5632 + c), g0[0], g0[1]);
                        const float* s1 = sbuf + ((size_t)bb_ * 2 + 1) * 5632 + c; const float* s2 = sbuf + ((size_t)bb_ * 2 + 0) * 5632 + c;
                        const float hs = hv ? 1.f : 0.f;
                        const f32x4 o0 = act4(w0[0] * (*(const f32x4*)(s2) * hs) + w1[0] * (*(const f32x4*)(s1) * hs) + w2[0] * g0[0] + bb[0], acc[ai][bj][m][0]);
                        const f32x4 o1 = act4(w0[1] * (*(const f32x4*)(s2 + 4) * hs) + w1[1] * (*(const f32x4*)(s1 + 4) * hs) + w2[1] * g0[1] + bb[1], acc[ai][bj][m][1]);
                        u32x4 w; w.x = cvt_pk_bf16(o0[0], o0[1]); w.y = cvt_pk_bf16(o0[2], o0[3]); w.z = cvt_pk_bf16(o1[0], o1[1]); w.w = cvt_pk_bf16(o1[2], o1[3]);
                        *(u32x4*)(O + (size_t)r * 5632 + c) = w;
                    }
            }
        }
    }
};

struct EpiSlab {
    static constexpr bool PERM = false, AFTER_DRAIN = false;
    float* slab; int ksplit;
    __device__ __forceinline__ void operator()(const f32x4 (&acc)[2][2][4][2], const Unit& u, int wr, int wc, int fr, int fq) const {
        const int row0 = wr * 64 + fr, col0 = u.pn * BM + wc * 32 + 4 * fq;
        float* base = slab + (size_t)(u.k0 / ksplit) * (128 * 2048);
#pragma unroll
        for (int m = 0; m < 4; ++m) { float* rowp = base + (size_t)(row0 + m * 16) * 2048 + col0;
#pragma unroll
            for (int bj = 0; bj < 2; ++bj)
#pragma unroll
                for (int n = 0; n < 2; ++n) *(f32x4*)(rowp + bj * HALF + n * 16) = acc[0][bj][m][n]; }
    }
};

struct EpiBf16Store {
    static constexpr bool PERM = true, AFTER_DRAIN = false;
    bf16_t* O; int ldc;
    __device__ __forceinline__ void operator()(const f32x4 (&acc)[2][2][4][2], const Unit& u, int wr, int wc, int fr, int fq) const {
        const int row0 = u.pm * BM + wr * 64 + fr, col0 = u.pn * BM + wc * 32 + 8 * fq;
#pragma unroll
        for (int ai = 0; ai < 2; ++ai)
#pragma unroll
            for (int m = 0; m < 4; ++m) { bf16_t* rowp = O + (size_t)(row0 + ai * HALF + m * 16) * ldc + col0;
#pragma unroll
                for (int bj = 0; bj < 2; ++bj) { const f32x4 v0 = acc[ai][bj][m][0], v1 = acc[ai][bj][m][1];
                    u32x4 w; w.x = cvt_pk_bf16(v0[0], v0[1]); w.y = cvt_pk_bf16(v0[2], v0[3]); w.z = cvt_pk_bf16(v1[0], v1[1]); w.w = cvt_pk_bf16(v1[2], v1[3]);
                    *(u32x4*)(rowp + bj * HALF) = w; } }
    }
};
template <class Epi, class Sched, bool ALIGN_EPI = false, bool SP2 = false>
__device__ __forceinline__ void gemm_phase(PG8_LAS unsigned char* lds, const Gemm g, const Sched& S, const Epi& E) {
    const int tid = TIDX, wid = __builtin_amdgcn_readfirstlane(tid >> 6), lane = tid & 63, wr = wid >> 2, wc = wid & 3, fr = lane & 15, fq = lane >> 4;
    const int K = g.K, nt = K / BK;
    unsigned voffA[2], voffB[2];
#pragma unroll
    for (int i = 0; i < 2; ++i) { int R, C; stage_rc(tid * 16 + i * 8192, R, C); const int Rb = Epi::PERM ? ((R & ~31) + perm32(R & 31)) : R;
        voffA[i] = (unsigned)(R * g.ld + C) * 2u; voffB[i] = (unsigned)(Rb * g.ld + C) * 2u; }
    const size_t kstep = (size_t)(BK * 2);
    const size_t hstep = (size_t)HALF * g.ld * 2;
    const size_t tstep = 2 * hstep;
    const unsigned ldsw = (unsigned)wid * 1024u;
    const int aoff = lds_byte(wr * 64 + fr, fq * 8), boff = lds_byte(wc * 32 + fr, fq * 8);
#define PG8_SA(b, h) (((b) * 2 + (h)) * HTB)
#define PG8_SB(b, h) ((4 + (b) * 2 + (h)) * HTB)
#define PG8_STAGE(bufoff, gbase, voff) do { _Pragma("unroll") for (int _i = 0; _i < 2; ++_i) \
        __builtin_amdgcn_global_load_lds((const unsigned*)((const char*)(gbase) + (voff)[_i]), (PG8_LAS unsigned*)(lds + (bufoff) + ldsw + _i * 8192), 16, 0, 0); } while (0)
#define PG8_LDA(dst, b, h) do { _Pragma("unroll") for (int m = 0; m < 4; ++m) _Pragma("unroll") for (int k = 0; k < 2; ++k) dst[m][k] = *(const PG8_LAS bf16x8*)(lds + PG8_SA(b, h) + aoff + m * 2048 + k * 1024); } while (0)
#define PG8_LDB(dst, b, h) do { _Pragma("unroll") for (int n = 0; n < 2; ++n) _Pragma("unroll") for (int k = 0; k < 2; ++k) dst[n][k] = *(const PG8_LAS bf16x8*)(lds + PG8_SB(b, h) + boff + n * 2048 + k * 1024); } while (0)
#define PG8_MMA(ai, bj, At, Bt) do { __builtin_amdgcn_s_setprio(1); _Pragma("unroll") for (int m = 0; m < 4; ++m) _Pragma("unroll") for (int n = 0; n < 2; ++n) _Pragma("unroll") for (int k = 0; k < 2; ++k) \
        acc[ai][bj][m][n] = __builtin_amdgcn_mfma_f32_16x16x32_bf16(Bt[n][k], At[m][k], acc[ai][bj][m][n], 0, 0, 0); __builtin_amdgcn_s_setprio(0); } while (0)
#define PG8_WAIT_V(n) asm volatile("s_waitcnt vmcnt(" #n ")" ::: "memory")
#define PG8_WAIT_L(n) asm volatile("s_waitcnt lgkmcnt(" #n ")" ::: "memory")
#define PG8_BAR __builtin_amdgcn_s_barrier()
#define PG8_SCHED __builtin_amdgcn_sched_barrier(0)
    Unit cur, nxt; int ui = 0;
    if (!S.next(0, cur)) return;
    f32x4 acc[2][2][4][2];
#pragma unroll
    for (int a = 0; a < 2; ++a)
#pragma unroll
        for (int b = 0; b < 2; ++b)
#pragma unroll
            for (int m = 0; m < 4; ++m)
#pragma unroll
                for (int n = 0; n < 2; ++n) acc[a][b][m][n] = (f32x4){0.f, 0.f, 0.f, 0.f};
    bf16x8 At[4][2], B0[2][2], B1[2][2];
    const char* cA = (const char*)g.A + (size_t)cur.pm * tstep + (size_t)cur.k0 * 2; const char* cB = (const char*)g.Bt + (size_t)cur.pn * tstep + (size_t)cur.k0 * 2;
    S.a_ready(cur);
    if constexpr (SP2) {
        PG8_STAGE(PG8_SB(0, 0), cB, voffB); PG8_STAGE(PG8_SB(0, 1), cB + hstep, voffB); PG8_STAGE(PG8_SA(0, 0), cA, voffA); PG8_STAGE(PG8_SA(0, 1), cA + hstep, voffA);
        if (wr == 1) PG8_BAR;
        PG8_WAIT_V(2); PG8_BAR;
        PG8_STAGE(PG8_SB(1, 0), cB + kstep, voffB); PG8_STAGE(PG8_SA(1, 0), cA + kstep, voffA); PG8_STAGE(PG8_SB(1, 1), cB + hstep + kstep, voffB);
        PG8_WAIT_V(6); PG8_BAR;
    } else {
        PG8_STAGE(PG8_SB(0, 0), cB, voffB); PG8_STAGE(PG8_SA(0, 0), cA, voffA); PG8_STAGE(PG8_SB(0, 1), cB + hstep, voffB); PG8_STAGE(PG8_SA(0, 1), cA + hstep, voffA);
        if (wr == 1) PG8_BAR;
        PG8_WAIT_V(4); PG8_BAR;
        PG8_STAGE(PG8_SB(1, 0), cB + kstep, voffB); PG8_STAGE(PG8_SA(1, 0), cA + kstep, voffA); PG8_STAGE(PG8_SB(1, 1), cB + hstep + kstep, voffB);
        PG8_WAIT_V(6); PG8_BAR;
    }
    for (;;) {
        const bool has_next = S.next(ui + 1, nxt);
        const char* nA = has_next ? (const char*)g.A + (size_t)nxt.pm * tstep + (size_t)nxt.k0 * 2 : cA; const char* nB = has_next ? (const char*)g.Bt + (size_t)nxt.pn * tstep + (size_t)nxt.k0 * 2 : cB;
        for (int t = 0; t < nt; t += 2) {
            const bool last = (t == nt - 2);
            const char* a1 = cA + (size_t)(t + 1) * kstep;
            const char* a2 = last ? nA : cA + (size_t)(t + 2) * kstep; const char* b2 = last ? nB : cB + (size_t)(t + 2) * kstep;
            const char* a3 = a2 + kstep; const char* b3 = b2 + kstep;
            if (last && has_next) S.a_ready(nxt);
            if constexpr (SP2) {
            PG8_LDB(B0, 0, 0); PG8_LDB(B1, 0, 1); PG8_SCHED; PG8_LDA(At, 0, 0); PG8_STAGE(PG8_SA(1, 1), a1 + hstep, voffA);
            PG8_WAIT_V(8); PG8_WAIT_L(0); PG8_BAR; PG8_MMA(0, 0, At, B0); PG8_MMA(0, 1, At, B1); PG8_BAR; PG8_SCHED;
            PG8_LDA(At, 0, 1); PG8_STAGE(PG8_SB(0, 0), b2, voffB); PG8_STAGE(PG8_SB(0, 1), b2 + hstep, voffB); PG8_STAGE(PG8_SA(0, 0), a2, voffA);
            PG8_WAIT_V(8); PG8_WAIT_L(0); PG8_BAR; PG8_MMA(1, 0, At, B0); PG8_MMA(1, 1, At, B1); PG8_BAR; PG8_SCHED;
            PG8_LDB(B0, 1, 0); PG8_LDB(B1, 1, 1); PG8_SCHED; PG8_LDA(At, 1, 0); PG8_STAGE(PG8_SA(0, 1), a2 + hstep, voffA);
            PG8_WAIT_V(8); PG8_WAIT_L(0); PG8_BAR; PG8_MMA(0, 0, At, B0); PG8_MMA(0, 1, At, B1); PG8_BAR; PG8_SCHED;
            PG8_LDA(At, 1, 1); PG8_STAGE(PG8_SB(1, 0), b3, voffB); PG8_STAGE(PG8_SB(1, 1), b3 + hstep, voffB); PG8_STAGE(PG8_SA(1, 0), a3, voffA);
            PG8_WAIT_V(8); PG8_WAIT_L(0); PG8_BAR; PG8_MMA(1, 0, At, B0); PG8_MMA(1, 1, At, B1); PG8_BAR; PG8_SCHED;
            } else {
            PG8_LDB(B0, 0, 0); PG8_SCHED; PG8_LDA(At, 0, 0); PG8_STAGE(PG8_SA(1, 1), a1 + hstep, voffA);
            PG8_WAIT_L(8); PG8_BAR; PG8_WAIT_L(0); PG8_MMA(0, 0, At, B0); PG8_BAR; PG8_SCHED;
            PG8_LDB(B1, 0, 1); PG8_STAGE(PG8_SB(0, 0), b2, voffB);
            PG8_BAR; PG8_WAIT_L(0); PG8_MMA(0, 1, At, B1); PG8_BAR;
            PG8_LDA(At, 0, 1); PG8_STAGE(PG8_SA(0, 0), a2, voffA);
            PG8_BAR; PG8_WAIT_L(0); PG8_MMA(1, 0, At, B0); PG8_BAR; PG8_SCHED;
            PG8_STAGE(PG8_SB(0, 1), b2 + hstep, voffB);
            PG8_WAIT_V(6); PG8_BAR; PG8_MMA(1, 1, At, B1); PG8_BAR;
            PG8_LDB(B0, 1, 0); PG8_SCHED; PG8_LDA(At, 1, 0); PG8_STAGE(PG8_SA(0, 1), a2 + hstep, voffA);
            PG8_WAIT_L(8); PG8_BAR; PG8_WAIT_L(0); PG8_MMA(0, 0, At, B0); PG8_BAR; PG8_SCHED;
            PG8_LDB(B1, 1, 1); PG8_STAGE(PG8_SB(1, 0), b3, voffB);
            PG8_BAR; PG8_WAIT_L(0); PG8_MMA(0, 1, At, B1); PG8_BAR;
            PG8_LDA(At, 1, 1); PG8_STAGE(PG8_SA(1, 0), a3, voffA);
            PG8_BAR; PG8_WAIT_L(0); PG8_MMA(1, 0, At, B0); PG8_BAR; PG8_SCHED;
            PG8_STAGE(PG8_SB(1, 1), b3 + hstep, voffB);
            PG8_WAIT_V(6); PG8_BAR; PG8_MMA(1, 1, At, B1); PG8_BAR;
            }
        }
        if constexpr (ALIGN_EPI) { if (wr == 0) PG8_BAR; }
        if constexpr (!Epi::AFTER_DRAIN) { E(acc, cur, wr, wc, fr, fq); S.done(cur); }
        if (!has_next) break;
#pragma unroll
        for (int a = 0; a < 2; ++a)
#pragma unroll
            for (int b = 0; b < 2; ++b)
#pragma unroll
                for (int m = 0; m < 4; ++m)
#pragma unroll
                    for (int n = 0; n < 2; ++n) acc[a][b][m][n] = (f32x4){0.f, 0.f, 0.f, 0.f};
        cur = nxt; cA = nA; cB = nB; ++ui;
        if constexpr (ALIGN_EPI) { if (wr == 1) PG8_BAR; }
    }
    PG8_WAIT_V(0);
    if constexpr (!ALIGN_EPI) { if (wr == 0) PG8_BAR; }
    PG8_BAR;
    if constexpr (Epi::AFTER_DRAIN) { E.fused(acc, cur, wr, wc, fr, fq, lds, wid, lane); S.done(cur); }
#undef PG8_SA
#undef PG8_SB
#undef PG8_STAGE
#undef PG8_LDA
#undef PG8_LDB
#undef PG8_MMA
#undef PG8_WAIT_V
#undef PG8_WAIT_L
#undef PG8_BAR
#undef PG8_SCHED
}
}

#define LDS_WAIT() asm volatile("s_waitcnt lgkmcnt(0)" ::: "memory")

__device__ __forceinline__ void transpose_item(const float* __restrict__ W, int K, int N, bf16_t* __restrict__ WT, LAS float* scr, int item, int lane) {
    const int nblk = (N + 63) / 64, kb = item / nblk, nb = item % nblk, k0 = 64 * kb, n0 = 64 * nb;
    const int nq = (lane & 15) * 4, kr = lane >> 4;
    const bool ok = n0 + nq < N;
    f32x4 v[16];
#pragma unroll
    for (int i = 0; i < 16; ++i) v[i] = ok ? *(const f32x4*)(W + (size_t)(k0 + 4 * i + kr) * N + n0 + nq) : (f32x4){0.f, 0.f, 0.f, 0.f};
#pragma unroll
    for (int i = 0; i < 16; ++i) { const int k = 4 * i + kr;
        scr[(nq + 0) * 65 + k] = v[i].x; scr[(nq + 1) * 65 + k] = v[i].y; scr[(nq + 2) * 65 + k] = v[i].z; scr[(nq + 3) * 65 + k] = v[i].w; }
    LDS_WAIT(); asm volatile("" ::: "memory");
    const int kc = (lane & 7) * 8;
#pragma unroll
    for (int j = 0; j < 8; ++j) { const int n = (lane >> 3) + 8 * j; const LAS float* s = scr + n * 65 + kc;
        const u32x4 o = (u32x4){pk2(s[0], s[1]), pk2(s[2], s[3]), pk2(s[4], s[5]), pk2(s[6], s[7])};
        if (n0 + n < N) *(u32x4*)(WT + (size_t)(n0 + n) * K + k0 + kc) = o; }
    LDS_WAIT(); asm volatile("" ::: "memory");
}

struct CvtMat { int in_idx, K, N, Npad; size_t src_off, dst; };
#define CVT_E(idx, K, N, NP, mi, base, stride) {idx, K, N, NP, (size_t)(mi) * (K) * (N), (base) + (size_t)(mi) * (stride)}
__constant__ CvtMat c_mats[24] = {
    CVT_E(I_WMOD, 2048, 12288, 12288, 0, WS_WMOD, (size_t)12288 * 2048 * 2), CVT_E(I_WINAB, 2048, PAB, PAB_PAD, 0, WS_WINAB, (size_t)PAB_PAD * 2048 * 2), CVT_E(I_WOUTAB, 2048, 2048, 2048, 0, WS_WOUTAB, (size_t)2048 * 2048 * 2),
    CVT_E(I_FWG, 2048, DFF, DFF, 0, WS_WGATE, (size_t)DFF * 2048 * 2), CVT_E(I_FWU, 2048, DFF, DFF, 0, WS_WUP, (size_t)DFF * 2048 * 2), CVT_E(I_FWD, DFF, 2048, 2048, 0, WS_WDOWN, (size_t)DFF * 2048 * 2),
    CVT_E(I_WINC, 2048, PC, PC_PAD, 0, WS_WINC, (size_t)PC_PAD * 2048 * 2), CVT_E(I_WOUTC, 4096, 2048, 2048, 0, WS_WOUTC, (size_t)2048 * 4096 * 2),
    CVT_E(I_FWG, 2048, DFF, DFF, 1, WS_WGATE, (size_t)DFF * 2048 * 2), CVT_E(I_FWU, 2048, DFF, DFF, 1, WS_WUP, (size_t)DFF * 2048 * 2), CVT_E(I_FWD, DFF, 2048, 2048, 1, WS_WDOWN, (size_t)DFF * 2048 * 2),
    CVT_E(I_WMOD, 2048, 12288, 12288, 1, WS_WMOD, (size_t)12288 * 2048 * 2), CVT_E(I_WMOD, 2048, 12288, 12288, 2, WS_WMOD, (size_t)12288 * 2048 * 2), CVT_E(I_WMOD, 2048, 12288, 12288, 3, WS_WMOD, (size_t)12288 * 2048 * 2),
    CVT_E(I_WINAB, 2048, PAB, PAB_PAD, 1, WS_WINAB, (size_t)PAB_PAD * 2048 * 2), CVT_E(I_WOUTAB, 2048, 2048, 2048, 1, WS_WOUTAB, (size_t)2048 * 2048 * 2),
    CVT_E(I_FWG, 2048, DFF, DFF, 2, WS_WGATE, (size_t)DFF * 2048 * 2), CVT_E(I_FWU, 2048, DFF, DFF, 2, WS_WUP, (size_t)DFF * 2048 * 2), CVT_E(I_FWD, DFF, 2048, 2048, 2, WS_WDOWN, (size_t)DFF * 2048 * 2),
    CVT_E(I_WINC, 2048, PC, PC_PAD, 1, WS_WINC, (size_t)PC_PAD * 2048 * 2), CVT_E(I_WOUTC, 4096, 2048, 2048, 1, WS_WOUTC, (size_t)2048 * 4096 * 2),
    CVT_E(I_FWG, 2048, DFF, DFF, 3, WS_WGATE, (size_t)DFF * 2048 * 2), CVT_E(I_FWU, 2048, DFF, DFF, 3, WS_WUP, (size_t)DFF * 2048 * 2), CVT_E(I_FWD, DFF, 2048, 2048, 3, WS_WDOWN, (size_t)DFF * 2048 * 2) };
__device__ __forceinline__ void phase_convert(const P& p, LAS unsigned char* lds, int m_lo, int m_hi, int wg_lo, int nwg) {
    const int Z = zero_();
    const int tid = TIDX, lane = tid & 63, wave = tid >> 6;
    const int wg = (int)blockIdx.x - wg_lo;
    if (wg < 0 || wg >= nwg) return;
    const int gw = wg * 8 + wave, NGW = nwg * 8;
    LAS float* scr = (LAS float*)(lds + wave * 16640);
    const CvtMat* mats = c_mats;
#pragma unroll 1
    for (int f = m_lo; f < m_hi; ++f) {
        const int K = mats[f].K, N = mats[f].N, Npad = mats[f].Npad, total = (K / 64) * ((N + 63) / 64);
        const float* src = p.in[Z + mats[f].in_idx] + mats[f].src_off; bf16_t* dstm = (bf16_t*)((p.ws + Z) + mats[f].dst);
        for (int it = gw; it < total; it += NGW) transpose_item(src, K, N, dstm, scr, it, lane);
        if (Npad > N) {
            const size_t nvec = (size_t)(Npad - N) * K / 8; u32x4* dst = (u32x4*)(dstm + (size_t)N * K);
            for (size_t i = (size_t)wg * NT + tid; i < nvec; i += (size_t)nwg * NT) dst[i] = zero4_();
        }
    }
}
__device__ __forceinline__ void phase_convert_small(const P& p) {
    const int Z = zero_();
    const int tid = TIDX;
    const size_t gt = (size_t)blockIdx.x * NT + tid, GT = (size_t)gridDim.x * NT;
    { bf16_t* w2t = (bf16_t*)((p.ws + Z) + WS_W2T); bf16_t* a2t = (bf16_t*)((p.ws + Z) + WS_A2T);
      for (size_t i = gt; i < (size_t)2 * 1024 * 64; i += GT) { const int k = i & 63, n = (i >> 6) & 1023, l = i >> 16;
          w2t[i] = (bf16_t)f2bf(p.in[Z + I_W2][((size_t)l * 64 + k) * 1024 + n]); a2t[i] = (bf16_t)f2bf(p.in[Z + I_A2][((size_t)l * 64 + k) * 1024 + n]); } }
    { bf16_t* g2t = (bf16_t*)((p.ws + Z) + WS_G2T);
      for (size_t i = gt; i < (size_t)2 * 1024 * 160; i += GT) { const int k = i % 160, n = (i / 160) & 1023, l = i / (160 * 1024);
          g2t[i] = (bf16_t)f2bf(p.in[Z + I_G2][((size_t)l * 160 + k) * 1024 + n]); } }
    { bf16_t* wat = (bf16_t*)((p.ws + Z) + WS_WAT); bf16_t* wxt = (bf16_t*)((p.ws + Z) + WS_WXT);
      for (size_t i = gt; i < (size_t)2 * 16 * 64 * 64; i += GT) { const int k = i & 63, n = (i >> 6) & 63, lh = i >> 12;
          wat[i] = (bf16_t)f2bf(p.in[Z + I_LWA][((size_t)lh * 64 + k) * 64 + n]); wxt[i] = (bf16_t)f2bf(p.in[Z + I_LWX][((size_t)lh * 64 + k) * 64 + n]); } }
}

__device__ __forceinline__ void phase_init(const P& p) {
    const int Z = zero_();
    const size_t gt = (size_t)blockIdx.x * NT + TIDX, GT = (size_t)gridDim.x * NT;
    bf16_t* sc = (bf16_t*)((p.ws + Z) + WS_SC);
    for (size_t i = gt; i < (size_t)256 * D; i += GT) {
        const int r = i / D, c = i % D; float v = 0.f;
        if (r < NBP) v = silu_(p.in[Z + I_CP][(size_t)r * D + c]); else if (r < NSEQ) v = silu_(p.in[Z + I_CS][(size_t)(r - NBP) * D + c]);
        sc[i] = (bf16_t)f2bf(v);
    }
    { u32x4* ye = (u32x4*)((bf16_t*)((p.ws + Z) + WS_YE) + (size_t)MV * D); for (size_t i = gt; i < (size_t)(MPAD - MV) * D / 8; i += GT) ye[i] = zero4_(); }
    { u32x4* yo = (u32x4*)((bf16_t*)((p.ws + Z) + WS_YO) + (size_t)MV * 4096); for (size_t i = gt; i < (size_t)(MPAD - MV) * 4096 / 8; i += GT) yo[i] = zero4_(); }
}

__device__ __forceinline__ void phase_norm(const P& p, int layer, int which  , int nsplit, int player, int pslot, bool from_inputs, LAS unsigned char* lds, bool skip_prompt = false) {
    const int Z = zero_();
    const int tid = TIDX, lane = tid & 63, wave = tid >> 6;
    float* X = (float*)((p.ws + Z) + WS_X); bf16_t* H = (bf16_t*)((p.ws + Z) + WS_H); const float* MOD = (const float*)((p.ws + Z) + WS_MOD);
    const float* gain = p.in[Z + (which ? I_NFFN : I_NMIX)] + (size_t)layer * D;
    for (int r = skip_prompt ? MP : blockIdx.x * 8 + wave; r < MP; r += gridDim.x * 8) {
        u32x2* hr = (u32x2*)(H + (size_t)r * D);
        const f32x4* xr = (from_inputs && which == 0) ? (const f32x4*)(p.in[Z + I_XP] + (size_t)r * D) : (const f32x4*)(X + (size_t)r * D);
        f32x4 v[8]; float s = 0.f;
#pragma unroll
        for (int j = 0; j < 8; ++j) { v[j] = xr[lane + 64 * j]; s += v[j].x * v[j].x + v[j].y * v[j].y + v[j].z * v[j].z + v[j].w * v[j].w; }
        const float* mrow = MOD + (size_t)(r >> 11) * MODLD + (size_t)layer * 12288 + (which ? 3 * D : 0);
        f32x4 gv[8], shv[8], scv[8];
#pragma unroll
        for (int j = 0; j < 8; ++j) { const int c = (lane + 64 * j) * 4; gv[j] = *(const f32x4*)(gain + c); shv[j] = *(const f32x4*)(mrow + c); scv[j] = *(const f32x4*)(mrow + D + c); }
        float st = allreduce16(s); st += __shfl_xor(st, 16); st += __shfl_xor(st, 32);
        const float rstd = rsqrtf(st * (1.f / D) + 1e-6f);
#pragma unroll
        for (int j = 0; j < 8; ++j) {
            const f32x4 o = v[j] * rstd * gv[j] * (scv[j] + 1.f) + shv[j];
            hr[lane + 64 * j] = (u32x2){pk2(o.x, o.y), pk2(o.z, o.w)};
        }
    }
    LAS float* red = (LAS float*)lds;
    for (int b = ((int)blockIdx.x + 128) % (int)gridDim.x; b < NBS; b += gridDim.x) {
        const int r = MP + b, c = wave * 256 + lane * 4;
        f32x4 v = from_inputs ? *(const f32x4*)(p.in[Z + I_XS] + (size_t)b * D + c) : *(const f32x4*)(X + (size_t)r * D + c);
        const float* mrow = MOD + (size_t)(4 + b) * MODLD + (size_t)layer * 12288 + (which ? 3 * D : 0);
        const f32x4 g = *(const f32x4*)(gain + c), sh = *(const f32x4*)(mrow + c), sc = *(const f32x4*)(mrow + D + c);
        if (nsplit > 0) {
            const float* sl = (const float*)((p.ws + Z) + WS_SLAB) + (size_t)b * D + c;
            f32x4 t[11];
#pragma unroll
            for (int s = 0; s < 11; ++s) if (s < nsplit) t[s] = *(const f32x4*)(sl + (size_t)s * 128 * D);
            __builtin_amdgcn_sched_barrier(0);
            f32x4 a = (f32x4){0.f, 0.f, 0.f, 0.f};
#pragma unroll
            for (int s = 0; s < 11; ++s) if (s < nsplit) a = a + t[s];
            v = v + *(const f32x4*)(MOD + (size_t)(4 + b) * MODLD + (size_t)player * 12288 + (size_t)pslot * D + c) * a;
            *(f32x4*)(X + (size_t)r * D + c) = v;
        } else if (from_inputs && which == 1) *(f32x4*)(X + (size_t)r * D + c) = v;
        float s = v.x * v.x + v.y * v.y + v.z * v.z + v.w * v.w;
        s = allreduce16(s); s += __shfl_xor(s, 16); s += __shfl_xor(s, 32);
        __syncthreads();
        if (lane == 0) red[wave] = s;
        __syncthreads();
        const float rstd = rsqrtf((red[0] + red[1] + red[2] + red[3] + red[4] + red[5] + red[6] + red[7]) * (1.f / D) + 1e-6f);
        const f32x4 o = v * rstd * g * (sc + 1.f) + sh;
        *(u32x2*)(H + (size_t)r * D + c) = (u32x2){pk2(o.x, o.y), pk2(o.z, o.w)};
    }
    for (int i = blockIdx.x * NT + tid; i < (MPAD - MV) * D / 8; i += gridDim.x * NT) ((u32x4*)(H + (size_t)MV * D))[i] = zero4_();
}

__device__ __forceinline__ void phase_final_norm(const P& p, LAS unsigned char* lds) {
    const int Z = zero_();
    const int tid = TIDX, lane = tid & 63, wave = tid >> 6;
    const float* X = (const float*)((p.ws + Z) + WS_X); const float* gain = p.in[Z + I_NOUT]; const float* MOD = (const float*)((p.ws + Z) + WS_MOD);
    for (int r = blockIdx.x * 8 + wave; r < MP; r += gridDim.x * 8) {
        const f32x4* xr = (const f32x4*)(X + (size_t)r * D); f32x4* yr = (f32x4*)((p.out + Z) + (size_t)r * D);
        f32x4 v[8]; float s = 0.f;
#pragma unroll
        for (int j = 0; j < 8; ++j) { v[j] = xr[lane + 64 * j]; s += v[j].x * v[j].x + v[j].y * v[j].y + v[j].z * v[j].z + v[j].w * v[j].w; }
        f32x4 gv[8];
#pragma unroll
        for (int j = 0; j < 8; ++j) gv[j] = *(const f32x4*)(gain + (lane + 64 * j) * 4);
        float st = allreduce16(s); st += __shfl_xor(st, 16); st += __shfl_xor(st, 32);
        const float rstd = rsqrtf(st * (1.f / D) + 1e-6f);
#pragma unroll
        for (int j = 0; j < 8; ++j) yr[lane + 64 * j] = v[j] * rstd * gv[j];
    }
    LAS float* red = (LAS float*)lds;
    for (int b = ((int)blockIdx.x + 128) % (int)gridDim.x; b < NBS; b += gridDim.x) {
        const int r = MP + b, c = wave * 256 + lane * 4;
        f32x4 v = *(const f32x4*)(X + (size_t)r * D + c);
        const float* sl = (const float*)((p.ws + Z) + WS_SLAB) + (size_t)b * D + c;
        f32x4 t[11];
#pragma unroll
        for (int s = 0; s < 11; ++s) t[s] = *(const f32x4*)(sl + (size_t)s * 128 * D);
        __builtin_amdgcn_sched_barrier(0);
        f32x4 a = (f32x4){0.f, 0.f, 0.f, 0.f};
#pragma unroll
        for (int s = 0; s < 11; ++s) a = a + t[s];
        v = v + *(const f32x4*)(MOD + (size_t)(4 + b) * MODLD + (size_t)3 * 12288 + (size_t)5 * D + c) * a;
        float s = v.x * v.x + v.y * v.y + v.z * v.z + v.w * v.w;
        s = allreduce16(s); s += __shfl_xor(s, 16); s += __shfl_xor(s, 32);
        __syncthreads();
        if (lane == 0) red[wave] = s;
        __syncthreads();
        const float rstd = rsqrtf((red[0] + red[1] + red[2] + red[3] + red[4] + red[5] + red[6] + red[7]) * (1.f / D) + 1e-6f);
        *(f32x4*)((p.out + Z) + (size_t)r * D + c) = v * rstd * *(const f32x4*)(gain + c);
    }
}

constexpr int PLD_E = PAB_PAD;

template <bool SAMPLE> __device__ __forceinline__ f32x4 rw_prev4(const bf16_t* prow  , const float* srow  , bool has_prev, int col) {
    if (SAMPLE) return *(const f32x4*)(srow + col);
    const f32x4 v = ldb4(prow + col);
    return has_prev ? v : (f32x4){0.f, 0.f, 0.f, 0.f};
}
template <bool SAMPLE> __device__ __forceinline__ void rwkv_prep_unit(const P& p, int Z, int il, int u, LAS bf16_t* XS, bool alt = false, int hh_lo = 0, int hh_hi = 2) {
    constexpr int XLD = 296;
    const int tid = TIDX, lane = tid & 63, wave = tid >> 6, l15 = lane & 15, kq = lane >> 4;
    const bf16_t* proj = (const bf16_t*)((p.ws + Z) + WS_PROJ);
    float* SCB = (float*)((p.ws + Z) + (alt ? WS_GBUF : WS_MIX + MX_SCB)); float* GG = (float*)((p.ws + Z) + (alt ? WS_GBUF + (size_t)16 * MV * 384 * 4 : WS_MIX + MX_GG)); float* C123 = (float*)((p.ws + Z) + WS_MIX + MX_C123);
    const bf16_t* w2t = (const bf16_t*)((p.ws + Z) + WS_W2T) + (size_t)il * 1024 * 64;
    const bf16_t* a2t = (const bf16_t*)((p.ws + Z) + WS_A2T) + (size_t)il * 1024 * 64;
    const bf16_t* g2t = (const bf16_t*)((p.ws + Z) + WS_G2T) + (size_t)il * 1024 * 160;
    const float* mu = p.in[Z + I_MU] + (size_t)il * PA;
    const float* w0 = p.in[Z + I_W0] + (size_t)il * 1024; const float* a0 = p.in[Z + I_A0] + (size_t)il * 1024;
    const float* k_k = p.in[Z + I_KK] + (size_t)il * 1024; const float* k_a = p.in[Z + I_KA] + (size_t)il * 1024; const float* r_k = p.in[Z + I_RK] + (size_t)il * 1024;
    const float* sst = p.in[Z + I_SSHIFT] + (size_t)il * NBS * PA;
    const int R0 = u * 16;
    __syncthreads();
    {
        f32x4 cur[3], prev[3], mv[3];
#pragma unroll
        for (int q = 0; q < 3; ++q) { const int idx = tid + q * NT;
            if (idx < 16 * 72) { const int r = idx / 72, c = (idx % 72) * 4, col = 3072 + c, R = R0 + r;
                const bool hp = SAMPLE || (R & (SEQ - 1)) != 0;
                cur[q] = ldb4(proj + (size_t)R * PLD_E + col);
                prev[q] = rw_prev4<SAMPLE>(proj + (size_t)(hp ? R - 1 : R) * PLD_E, sst + (size_t)(SAMPLE ? R - MP : 0) * PA, hp, col);
                mv[q] = *(const f32x4*)(mu + col); } }
        __builtin_amdgcn_sched_barrier(0);
#pragma unroll
        for (int q = 0; q < 3; ++q) { const int idx = tid + q * NT;
            if (idx < 16 * 72) { const int r = idx / 72, c = (idx % 72) * 4;
                f32x4 x = cur[q] + (prev[q] - cur[q]) * mv[q];
                if (c < 64) { x.x = tanh_(x.x); x.y = tanh_(x.y); x.z = tanh_(x.z); x.w = tanh_(x.w); }
                else if (c >= 128) { x.x = sigmoid_(x.x); x.y = sigmoid_(x.y); x.z = sigmoid_(x.z); x.w = sigmoid_(x.w); }
                *(LAS u32x2*)(XS + r * XLD + c) = (u32x2){pk2(x.x, x.y), pk2(x.z, x.w)}; } }
    }
    __syncthreads();
    const int R = R0 + l15;
    const bool hp = SAMPLE || (R & (SEQ - 1)) != 0;
    const bf16_t* prow = proj + (size_t)(hp ? R - 1 : R) * PLD_E; const bf16_t* crow = proj + (size_t)R * PLD_E;
    const float* srow = sst + (size_t)(SAMPLE ? R - MP : 0) * PA;
#pragma unroll 1
    for (int hh = hh_lo; hh < hh_hi; ++hh) {
        const int h = wave * 2 + hh;
        f32x4 accw[4], acca[4], accg[4];
#pragma unroll
        for (int nb = 0; nb < 4; ++nb) { accw[nb] = (f32x4){0.f, 0.f, 0.f, 0.f}; acca[nb] = accw[nb]; accg[nb] = accw[nb]; }
        {
            bf16x8 fw[2][4], fa[2][4], fg[5][4];
#pragma unroll
            for (int nb = 0; nb < 4; ++nb) { const int n = h * 64 + nb * 16 + l15;
#pragma unroll
                for (int ks = 0; ks < 2; ++ks) { fw[ks][nb] = *(const bf16x8*)(w2t + (size_t)n * 64 + ks * 32 + kq * 8); fa[ks][nb] = *(const bf16x8*)(a2t + (size_t)n * 64 + ks * 32 + kq * 8); }
#pragma unroll
                for (int ks = 0; ks < 5; ++ks) fg[ks][nb] = *(const bf16x8*)(g2t + (size_t)n * 160 + ks * 32 + kq * 8); }
            __builtin_amdgcn_sched_barrier(0);
#pragma unroll
            for (int ks = 0; ks < 2; ++ks) {
                const bf16x8 bw = *(const LAS bf16x8*)(XS + l15 * XLD + ks * 32 + kq * 8);
                const bf16x8 ba = *(const LAS bf16x8*)(XS + l15 * XLD + 64 + ks * 32 + kq * 8);
#pragma unroll
                for (int nb = 0; nb < 4; ++nb) { accw[nb] = mfma16(fw[ks][nb], bw, accw[nb]); acca[nb] = mfma16(fa[ks][nb], ba, acca[nb]); }
            }
#pragma unroll
            for (int ks = 0; ks < 5; ++ks) {
                const bf16x8 bg = *(const LAS bf16x8*)(XS + l15 * XLD + 128 + ks * 32 + kq * 8);
#pragma unroll
                for (int nb = 0; nb < 4; ++nb) accg[nb] = mfma16(fg[ks][nb], bg, accg[nb]);
            }
        }
        if (!SAMPLE) {
            float* sb = SCB + ((size_t)h * MV + R) * 384;
#pragma unroll
            for (int nb = 0; nb < 4; ++nb) {
                const int cl = nb * 16 + kq * 4, c = h * 64 + cl;
                const f32x4 w0v = *(const f32x4*)(w0 + c), a0v = *(const f32x4*)(a0 + c);
                f32x4 lw, av;
#pragma unroll
                for (int j = 0; j < 4; ++j) { lw[j] = -fexp_(-softplus_(-(w0v[j] + accw[nb][j])) - 0.5f); av[j] = sigmoid_(a0v[j] + acca[nb][j]); }
                *(f32x4*)(sb + 1 * 64 + cl) = lw; *(f32x4*)(sb + 2 * 64 + cl) = av; *(f32x4*)(GG + (size_t)R * 1024 + c) = accg[nb];
            }
            continue;
        }
        f32x4 rr[4], kv[4], vv[4];
        float ss = 0.f;
#pragma unroll
        for (int nb = 0; nb < 4; ++nb) {
            const int c = h * 64 + nb * 16 + kq * 4;
            const f32x4 rc = ldb4(crow + c), kc = ldb4(crow + 1024 + c), vc = ldb4(crow + 2048 + c);
            const f32x4 rp = rw_prev4<SAMPLE>(prow, srow, hp, c), kp_ = rw_prev4<SAMPLE>(prow, srow, hp, c + 1024), vp = rw_prev4<SAMPLE>(prow, srow, hp, c + 2048);
            rr[nb] = rc + (rp - rc) * *(const f32x4*)(mu + c); kv[nb] = kc + (kp_ - kc) * *(const f32x4*)(mu + 1024 + c); vv[nb] = vc + (vp - vc) * *(const f32x4*)(mu + 2048 + c);
            const f32x4 kx = kv[nb] * *(const f32x4*)(k_k + c);
            ss += kx.x * kx.x + kx.y * kx.y + kx.z * kx.z + kx.w * kx.w;
        }
        ss += __shfl_xor(ss, 16); ss += __shfl_xor(ss, 32);
        const float rn = rsqrtf(ss + 1e-12f);
        float c1 = 0.f, c2 = 0.f, c3 = 0.f;
        float* sb = SCB + ((size_t)h * MV + R) * 384;
        f32x4 w0s[4], a0s[4], kks[4], kas[4], rks[4];
#pragma unroll
        for (int nb = 0; nb < 4; ++nb) { const int c = h * 64 + nb * 16 + kq * 4;
            w0s[nb] = *(const f32x4*)(w0 + c); a0s[nb] = *(const f32x4*)(a0 + c); kks[nb] = *(const f32x4*)(k_k + c); kas[nb] = *(const f32x4*)(k_a + c); rks[nb] = *(const f32x4*)(r_k + c); }
#pragma unroll
        for (int nb = 0; nb < 4; ++nb) {
            const int cl = nb * 16 + kq * 4, c = h * 64 + cl;
            const f32x4 r = rr[nb], k = kv[nb];
            const f32x4 w0v = w0s[nb], a0v = a0s[nb], kkv = kks[nb], kav = kas[nb], rkv = rks[nb];
            f32x4 kk, kka, wr, ww, kp;
#pragma unroll
            for (int j = 0; j < 4; ++j) {
                const float wl = -softplus_(-(w0v[j] + accw[nb][j])) - 0.5f;
                ww[j] = -fexp_(wl);
                const float a = sigmoid_(a0v[j] + acca[nb][j]);
                kk[j] = k[j] * kkv[j] * rn; kka[j] = kk[j] * a;
                kp[j] = k[j] * (1.f + (a - 1.f) * kav[j]);
                wr[j] = r[j];
                c1 += kka[j] * r[j]; c2 += kp[j] * r[j]; c3 += r[j] * kp[j] * rkv[j];
            }
            *(f32x4*)(sb + 0 * 64 + cl) = kk; *(f32x4*)(sb + 1 * 64 + cl) = ww; *(f32x4*)(sb + 2 * 64 + cl) = kka;
            *(f32x4*)(sb + 3 * 64 + cl) = kp; *(f32x4*)(sb + 4 * 64 + cl) = wr; *(f32x4*)(sb + 5 * 64 + cl) = vv[nb];
            *(f32x4*)(GG + (size_t)R * 1024 + c) = accg[nb];
        }
        c1 += __shfl_xor(c1, 16); c1 += __shfl_xor(c1, 32);
        c2 += __shfl_xor(c2, 16); c2 += __shfl_xor(c2, 32);
        c3 += __shfl_xor(c3, 16); c3 += __shfl_xor(c3, 32);
        if (kq == 0) *(f32x4*)(C123 + ((size_t)R * 16 + h) * 4) = (f32x4){c1, c2, c3, 0.f};
    }
}
__device__ __forceinline__ void phase_rwkv_prep(const P& p, int il, LAS unsigned char* lds, bool alt = false) {
    const int Z = zero_();
    LAS bf16_t* XS = (LAS bf16_t*)lds;
    for (int u = blockIdx.x; u < MP / 16 + 2 * (NBS / 16); u += gridDim.x) {
        if (u < MP / 16) rwkv_prep_unit<false>(p, Z, il, u, XS, alt);
        else { const int su = u - MP / 16; rwkv_prep_unit<true>(p, Z, il, MP / 16 + (su >> 1), XS, alt, su & 1, (su & 1) + 1); }
    }
    __syncthreads();
}

__device__ __forceinline__ void phase_rwkv_scan(const P& p, int il, LAS unsigned char* lds) {
    const int Z = zero_();
    const int tid = TIDX, il_ = tid >> 4, jq = tid & 15;
    const float* SCB = (const float*)((p.ws + Z) + WS_MIX + MX_SCB); const float* C123 = (const float*)((p.ws + Z) + WS_MIX + MX_C123);
    float* YRAW = (float*)((p.ws + Z) + WS_MIX + MX_YRAW);
    constexpr int TC = 32;
    LAS float* buf = (LAS float*)lds;
    LAS float* scal = (LAS float*)(lds + 2 * TC * 384 * 4);
    LAS float* ybuf = scal + 2 * TC * 4;
    const int NU = NSEQ * 32;
    for (int u = blockIdx.x; u < NU; u += gridDim.x) {
        const int s = u >> 5, h = (u >> 1) & 15, half = u & 1;
        const int T = s < NBP ? SEQ : 1, Rb = s < NBP ? s * SEQ : MP + (s - NBP);
        const int irow = half * 32 + il_;
        float S[4];
        if (s < NBP) { S[0] = S[1] = S[2] = S[3] = 0.f; }
        else { const f32x4 s0 = *(const f32x4*)(p.in[Z + I_SWKV] + (((size_t)il * NBS + (s - NBP)) * 16 + h) * 4096 + irow * 64 + jq * 4); S[0] = s0.x; S[1] = s0.y; S[2] = s0.z; S[3] = s0.w; }
        const float* src = SCB + ((size_t)h * MV + Rb) * 384;
        __syncthreads();
        { const int n = (T < TC ? T : TC) * 96;
          for (int i = tid; i < n; i += NT) *(LAS f32x4*)(buf + i * 4) = *(const f32x4*)(src + (size_t)i * 4);
          if (tid < (T < TC ? T : TC)) *(LAS f32x4*)(scal + tid * 4) = *(const f32x4*)(C123 + ((size_t)(Rb + tid) * 16 + h) * 4); }
        __syncthreads();
        asm volatile("" : "+v"(S[0]), "+v"(S[1]), "+v"(S[2]), "+v"(S[3]));
#define RW_STEP(tt, YOUT) do { const LAS float* st = cbuf + (tt) * 384; \
            const f32x4 kk = *(const LAS f32x4*)(st + jq * 4), w = *(const LAS f32x4*)(st + 64 + jq * 4), kka = *(const LAS f32x4*)(st + 128 + jq * 4); \
            const f32x4 kp = *(const LAS f32x4*)(st + 192 + jq * 4), wr = *(const LAS f32x4*)(st + 256 + jq * 4); \
            const float vi = st[320 + irow]; const f32x2 cc = *(const LAS f32x2*)(csc + (tt) * 4); \
            float sa = S[0] * kk.x + S[1] * kk.y + S[2] * kk.z + S[3] * kk.w; \
            float sr = S[0] * wr.x + S[1] * wr.y + S[2] * wr.z + S[3] * wr.w; \
            sa = allreduce16(sa); sr = allreduce16(sr); \
            S[0] = S[0] * w.x - sa * kka.x + vi * kp.x; S[1] = S[1] * w.y - sa * kka.y + vi * kp.y; \
            S[2] = S[2] * w.z - sa * kka.z + vi * kp.z; S[3] = S[3] * w.w - sa * kka.w + vi * kp.w; \
            YOUT = sr - sa * cc.x + vi * cc.y; } while (0)
        for (int t0 = 0, cb = 0; t0 < T; t0 += TC, cb ^= 1) {
            const int ns = (T - t0) < TC ? (T - t0) : TC;
            const int t1 = t0 + TC; const int nn = t1 < T ? ((T - t1) < TC ? (T - t1) : TC) : 0;
            f32x4 pre[6]; f32x4 pres;
            { const float* nsrc = src + (size_t)(nn == TC ? t1 : 0) * 384;
#pragma unroll
              for (int k = 0; k < 6; ++k) { const int i = tid + k * NT; pre[k] = *(const f32x4*)(nsrc + (size_t)(T >= TC ? i : (i % 96)) * 4); }
              pres = *(const f32x4*)(C123 + ((size_t)(Rb + (nn == TC ? t1 : 0) + (T >= TC ? (tid & 31) : 0)) * 16 + h) * 4); }
            const LAS float* cbuf = buf + cb * TC * 384; const LAS float* csc = scal + cb * TC * 4;
            if (ns == TC) {
#pragma unroll 1
                for (int tt = 0; tt < TC; tt += 16) {
                    float yk = 0.f;
#pragma unroll
                    for (int k = 0; k < 16; ++k) { float y; RW_STEP(tt + k, y); yk = (jq == k) ? y : yk; }
                    ybuf[(tt + jq) * 32 + il_] = yk;
                }
            } else {
                for (int t = 0; t < ns; ++t) { float y; RW_STEP(t, y); if (jq == 0) ybuf[t * 32 + il_] = y; }
            }
            __syncthreads();
            for (int i = tid; i < ns * 32; i += NT) { const int t = i >> 5, r = i & 31; YRAW[(size_t)(Rb + t0 + t) * 1024 + h * 64 + half * 32 + r] = ybuf[i]; }
            if (nn == TC) { LAS float* nb_ = buf + (cb ^ 1) * TC * 384;
#pragma unroll
              for (int k = 0; k < 6; ++k) { const int i = tid + k * NT; *(LAS f32x4*)(nb_ + i * 4) = pre[k]; }
              if (tid < TC) *(LAS f32x4*)(scal + (cb ^ 1) * TC * 4 + tid * 4) = pres; }
            __syncthreads();
        }
#undef RW_STEP
        float* so = (p.out + Z) + (s < NBP ? O_PWKV + (((size_t)il * NBP + s) * 16 + h) * 4096 : O_SWKV + (((size_t)il * NBS + (s - NBP)) * 16 + h) * 4096);
        *(f32x4*)(so + irow * 64 + jq * 4) = (f32x4){S[0], S[1], S[2], S[3]};
    }
}

__device__ __forceinline__ void rwkv_post_task(const float* __restrict__ SCB, const float* __restrict__ GG, const float* __restrict__ C123, const float* __restrict__ YRAW, bf16_t* __restrict__ YE,
                                               const float* __restrict__ gnw, const float* __restrict__ gnb, int R, int h0, int lane) {
    float y[4], v[4], c3[4], g[4], m[4], d[4], var[4];
#pragma unroll
    for (int k = 0; k < 4; ++k) { const int h = h0 + k, c = h * 64 + lane; y[k] = YRAW[(size_t)R * 1024 + c]; v[k] = SCB[((size_t)h * MV + R) * 384 + 320 + lane];
        c3[k] = C123[((size_t)R * 16 + h) * 4 + 2]; g[k] = GG[(size_t)R * 1024 + c]; }
#pragma unroll
    for (int k = 0; k < 4; ++k) m[k] = allreduce16(y[k]);
#pragma unroll
    for (int k = 0; k < 4; ++k) m[k] += __shfl_xor(m[k], 16);
#pragma unroll
    for (int k = 0; k < 4; ++k) { m[k] += __shfl_xor(m[k], 32); d[k] = y[k] - m[k] * (1.f / 64.f); var[k] = allreduce16(d[k] * d[k]); }
#pragma unroll
    for (int k = 0; k < 4; ++k) var[k] += __shfl_xor(var[k], 16);
#pragma unroll
    for (int k = 0; k < 4; ++k) var[k] += __shfl_xor(var[k], 32);
#pragma unroll
    for (int k = 0; k < 4; ++k) { const int c = (h0 + k) * 64 + lane;
        const float o = (d[k] * rsqrtf(var[k] * (1.f / 64.f) + 64e-5f) * gnw[c] + gnb[c] + c3[k] * v[k]) * g[k];
        YE[(size_t)R * D + c] = (bf16_t)f2bf(o); }
}
__device__ __forceinline__ void phase_rwkv_post(const P& p, int il) {
    const int Z = zero_();
    const int lane = TIDX & 63, wave = TIDX >> 6;
    const float* SCB = (const float*)((p.ws + Z) + WS_MIX + MX_SCB); const float* GG = (const float*)((p.ws + Z) + WS_MIX + MX_GG); const float* C123 = (const float*)((p.ws + Z) + WS_MIX + MX_C123);
    const float* YRAW = (const float*)((p.ws + Z) + WS_MIX + MX_YRAW); bf16_t* YE = (bf16_t*)((p.ws + Z) + WS_YE);
    const float* gnw = p.in[Z + I_GNW] + (size_t)il * 1024; const float* gnb = p.in[Z + I_GNB] + (size_t)il * 1024;
    for (int task = blockIdx.x * 8 + wave; task < MV * 4; task += gridDim.x * 8) rwkv_post_task(SCB, GG, C123, YRAW, YE, gnw, gnb, task >> 2, (task & 3) * 4, lane);
}

__device__ __forceinline__ f32x4 lru_conv4(const P& p, int Z, const bf16_t* proj, int il, int R, int c) {
    const float* cw = p.in[Z + I_LCW] + (size_t)il * 4 * 1024; const float* cbias = p.in[Z + I_LCB] + (size_t)il * 1024;
    f32x4 acc = *(const f32x4*)(cbias + c);
    if (R < MP) {
        const int t = R & (SEQ - 1);
#pragma unroll
        for (int j = 0; j < 4; ++j) { if (t - (3 - j) >= 0) acc = acc + *(const f32x4*)(cw + j * 1024 + c) * ldb4(proj + (size_t)(R - (3 - j)) * PLD_E + XB_OFF + c); }
    } else {
        const float* st = p.in[Z + I_SLRUC] + ((size_t)il * NBS + (R - MP)) * 3 * 1024;
#pragma unroll
        for (int j = 0; j < 3; ++j) acc = acc + *(const f32x4*)(cw + j * 1024 + c) * *(const f32x4*)(st + j * 1024 + c);
        acc = acc + *(const f32x4*)(cw + 3 * 1024 + c) * ldb4(proj + (size_t)R * PLD_E + XB_OFF + c);
    }
    return acc;
}

__device__ __forceinline__ void phase_lru_gates(const P& p, int il, LAS unsigned char* lds, int wg_lo) {
    const int Z = zero_();
    const int tid = TIDX, lane = tid & 63, wave = tid >> 6, l15 = lane & 15, kq = lane >> 4;
    const int wgi = (int)blockIdx.x - wg_lo;
    if (wgi < 0) return;
    const bf16_t* proj = (const bf16_t*)((p.ws + Z) + WS_PROJ);
    float* LA = (float*)((p.ws + Z) + WS_MIX + MX_LA); float* LB = (float*)((p.ws + Z) + WS_MIX + MX_LB);
    const bf16_t* wat = (const bf16_t*)((p.ws + Z) + WS_WAT) + (size_t)il * 16 * 4096; const bf16_t* wxt = (const bf16_t*)((p.ws + Z) + WS_WXT) + (size_t)il * 16 * 4096;
    const float* ba = p.in[Z + I_LBA] + (size_t)il * 1024; const float* bx = p.in[Z + I_LBX] + (size_t)il * 1024; const float* lam = p.in[Z + I_LLAM] + (size_t)il * 1024;
    const float* cw = p.in[Z + I_LCW] + (size_t)il * 4 * 1024; const float* cbias = p.in[Z + I_LCB] + (size_t)il * 1024;
    constexpr int XLD = 72;
    LAS bf16_t* XC = (LAS bf16_t*)(lds + wave * (16 * XLD * 2));
    for (int item = wgi * 8 + wave; item < (MV / 16) * 16; item += ((int)gridDim.x - wg_lo) * 8) {
        const int rb = item >> 4, hb = item & 15, R0 = rb * 16;
        bf16x8 fa_[2][4], fx_[2][4]; f32x4 bav_[4], bxv_[4], lv_[4];
#pragma unroll
        for (int nb = 0; nb < 4; ++nb) {
#pragma unroll
            for (int ks = 0; ks < 2; ++ks) { const size_t o = ((size_t)hb * 64 + nb * 16 + l15) * 64 + ks * 32 + kq * 8; fa_[ks][nb] = *(const bf16x8*)(wat + o); fx_[ks][nb] = *(const bf16x8*)(wxt + o); }
            const int c = hb * 64 + nb * 16 + kq * 4; bav_[nb] = *(const f32x4*)(ba + c); bxv_[nb] = *(const f32x4*)(bx + c); lv_[nb] = *(const f32x4*)(lam + c); }
        {
            const int ch = hb * 64 + l15 * 4, r0 = R0 + kq * 4;
            const f32x4 w0 = *(const f32x4*)(cw + ch), w1 = *(const f32x4*)(cw + 1024 + ch), w2 = *(const f32x4*)(cw + 2048 + ch), w3 = *(const f32x4*)(cw + 3072 + ch), cb = *(const f32x4*)(cbias + ch);
            if (R0 < MP) {
                const bool hp = (r0 & (SEQ - 1)) != 0;
                f32x4 x3 = ldb4(proj + (size_t)(hp ? r0 - 3 : r0) * PLD_E + XB_OFF + ch), x2 = ldb4(proj + (size_t)(hp ? r0 - 2 : r0) * PLD_E + XB_OFF + ch), x1 = ldb4(proj + (size_t)(hp ? r0 - 1 : r0) * PLD_E + XB_OFF + ch);
                if (!hp) { x3 = (f32x4){0.f, 0.f, 0.f, 0.f}; x2 = x3; x1 = x3; }
                f32x4 xin[4];
#pragma unroll
                for (int k = 0; k < 4; ++k) xin[k] = ldb4(proj + (size_t)(r0 + k) * PLD_E + XB_OFF + ch);
#pragma unroll
                for (int k = 0; k < 4; ++k) { const f32x4 xc = cb + w0 * x3 + w1 * x2 + w2 * x1 + w3 * xin[k]; x3 = x2; x2 = x1; x1 = xin[k];
                    *(LAS u32x2*)(XC + (kq * 4 + k) * XLD + l15 * 4) = (u32x2){pk2(xc.x, xc.y), pk2(xc.z, xc.w)}; }
            } else {
#pragma unroll
                for (int k = 0; k < 4; ++k) { const int R = r0 + k; const float* st = p.in[Z + I_SLRUC] + ((size_t)il * NBS + (R - MP)) * 3 * 1024 + ch;
                    const f32x4 xc = cb + w0 * *(const f32x4*)(st) + w1 * *(const f32x4*)(st + 1024) + w2 * *(const f32x4*)(st + 2048) + w3 * ldb4(proj + (size_t)R * PLD_E + XB_OFF + ch);
                    *(LAS u32x2*)(XC + (kq * 4 + k) * XLD + l15 * 4) = (u32x2){pk2(xc.x, xc.y), pk2(xc.z, xc.w)}; }
            }
        }
        LDS_WAIT(); asm volatile("" ::: "memory");
        f32x4 ar[4], ai[4];
#pragma unroll
        for (int nb = 0; nb < 4; ++nb) { ar[nb] = (f32x4){0.f, 0.f, 0.f, 0.f}; ai[nb] = ar[nb]; }
        __builtin_amdgcn_sched_barrier(0);
#pragma unroll
        for (int ks = 0; ks < 2; ++ks) { const bf16x8 bx_ = *(const LAS bf16x8*)(XC + l15 * XLD + ks * 32 + kq * 8);
#pragma unroll
            for (int nb = 0; nb < 4; ++nb) { ar[nb] = mfma16(fa_[ks][nb], bx_, ar[nb]); ai[nb] = mfma16(fx_[ks][nb], bx_, ai[nb]); } }
        const int R = R0 + l15;
#pragma unroll
        for (int nb = 0; nb < 4; ++nb) {
            const int c = hb * 64 + nb * 16 + kq * 4;
            const u32x2 xq = *(const LAS u32x2*)(XC + l15 * XLD + nb * 16 + kq * 4);
            const f32x4 xc = (f32x4){__uint_as_float(xq.x << 16), __uint_as_float(xq.x & 0xffff0000u), __uint_as_float(xq.y << 16), __uint_as_float(xq.y & 0xffff0000u)};
            const f32x4 bav = bav_[nb], bxv = bxv_[nb], lv = lv_[nb];
            f32x4 av, bv;
#pragma unroll
            for (int j = 0; j < 4; ++j) {
                const float rg = sigmoid_(ar[nb][j] + bav[j]), ig = sigmoid_(ai[nb][j] + bxv[j]);
                const float la = -8.f * rg * softplus_(-lv[j]);
                av[j] = fexp_(la); bv[j] = __builtin_amdgcn_sqrtf(one_minus_exp_(2.f * la)) * (ig * xc[j]);
            }
            *(f32x4*)(LA + (size_t)R * 1024 + c) = av; *(f32x4*)(LB + (size_t)R * 1024 + c) = bv;
        }
        LDS_WAIT(); asm volatile("" ::: "memory");
    }
}

__device__ __forceinline__ void lru_local_chunk(const float* __restrict__ LA, const float* __restrict__ LB, float* __restrict__ HL, float* __restrict__ PP, float* __restrict__ HEND, float* __restrict__ PEND, size_t base, size_t eoff) {
    float h = 0.f, pr = 1.f;
#pragma unroll
    for (int t0 = 0; t0 < 64; t0 += 16) {
        float a[16], b[16];
#pragma unroll
        for (int t = 0; t < 16; ++t) { a[t] = LA[base + (size_t)(t0 + t) * 1024]; b[t] = LB[base + (size_t)(t0 + t) * 1024]; }
#pragma unroll
        for (int t = 0; t < 16; ++t) { h = a[t] * h + b[t]; pr = pr * a[t]; }
    }
    HEND[eoff] = h; PEND[eoff] = pr;
}
__device__ __forceinline__ void phase_lru_local(const P& p, int rot = 0) {
    const int Z = zero_();
    const int tid = TIDX;
    const float* LA = (const float*)((p.ws + Z) + WS_MIX + MX_LA); const float* LB = (const float*)((p.ws + Z) + WS_MIX + MX_LB);
    float* HL = (float*)((p.ws + Z) + WS_MIX + MX_HL); float* PP = (float*)((p.ws + Z) + WS_MIX + MX_PP);
    float* HEND = (float*)((p.ws + Z) + WS_MIX + MX_HEND); float* PEND = (float*)((p.ws + Z) + WS_MIX + MX_PEND);
    for (int u = (blockIdx.x + rot) % gridDim.x; u < 256; u += gridDim.x) {
        const int ch = u >> 1, c = (u & 1) * 512 + tid;
        lru_local_chunk(LA, LB, HL, PP, HEND, PEND, (size_t)ch * 64 * 1024 + c, (size_t)ch * 1024 + c);
    }
}
__device__ __forceinline__ void phase_lru_carry(const P& p, int il) {
    const int Z = zero_();
    const float* HEND = (const float*)((p.ws + Z) + WS_MIX + MX_HEND); const float* PEND = (const float*)((p.ws + Z) + WS_MIX + MX_PEND);
    float* CARRY = (float*)((p.ws + Z) + WS_MIX + MX_CARRY);
    for (int i = blockIdx.x * NT + TIDX; i < NBP * 1024; i += gridDim.x * NT) {
        const int b = i >> 10, c = i & 1023; float cr = 0.f;
        for (int n = 0; n < 32; ++n) { const size_t o = (size_t)(b * 32 + n) * 1024 + c; CARRY[o] = cr; cr = HEND[o] + PEND[o] * cr; }
        (p.out + Z)[O_PLRUH + ((size_t)il * NBP + b) * 1024 + c] = cr;
    }
}
__device__ __forceinline__ void phase_lru_apply(const P& p, int il) {
    const int Z = zero_();
    const bf16_t* proj = (const bf16_t*)((p.ws + Z) + WS_PROJ);
    const float* LA = (const float*)((p.ws + Z) + WS_MIX + MX_LA); const float* LB = (const float*)((p.ws + Z) + WS_MIX + MX_LB);
    const float* HL = (const float*)((p.ws + Z) + WS_MIX + MX_HL); const float* PP = (const float*)((p.ws + Z) + WS_MIX + MX_PP); const float* CARRY = (const float*)((p.ws + Z) + WS_MIX + MX_CARRY);
    bf16_t* YE = (bf16_t*)((p.ws + Z) + WS_YE);
    for (size_t i = (size_t)blockIdx.x * NT + TIDX; i < (size_t)MV * 256; i += (size_t)gridDim.x * NT) {
        const int R = (int)(i >> 8), c = (int)(i & 255) * 4;
        f32x4 h;
        if (R < MP) { h = *(const f32x4*)(HL + (size_t)R * 1024 + c) + *(const f32x4*)(PP + (size_t)R * 1024 + c) * *(const f32x4*)(CARRY + (size_t)(R >> 6) * 1024 + c); }
        else { const int b = R - MP; h = *(const f32x4*)(LB + (size_t)R * 1024 + c) + *(const f32x4*)(LA + (size_t)R * 1024 + c) * *(const f32x4*)(p.in[Z + I_SLRUH] + ((size_t)il * NBS + b) * 1024 + c);
               *(f32x4*)((p.out + Z) + O_SLRUH + ((size_t)il * NBS + b) * 1024 + c) = h; }
        const f32x4 g = ldb4(proj + (size_t)R * PLD_E + GATE_OFF + c);
        const f32x4 y = (f32x4){h.x * gelu_tanh_(g.x), h.y * gelu_tanh_(g.y), h.z * gelu_tanh_(g.z), h.w * gelu_tanh_(g.w)};
        *(u32x2*)(YE + (size_t)R * D + 1024 + c) = (u32x2){pk2(y.x, y.y), pk2(y.z, y.w)};
    }
}

__device__ __forceinline__ void copy_row(float* __restrict__ dst, const float* __restrict__ src, int n4, int tid) {
    for (int i = tid; i < n4; i += 4 * NT) {
        f32x4 v[4];
#pragma unroll
        for (int k = 0; k < 4; ++k) if (i + k * NT < n4) v[k] = *(const f32x4*)(src + (size_t)(i + k * NT) * 4);
#pragma unroll
        for (int k = 0; k < 4; ++k) if (i + k * NT < n4) *(f32x4*)(dst + (size_t)(i + k * NT) * 4) = v[k];
    }
}
__device__ __forceinline__ void copy_row_bf16(float* __restrict__ dst, const bf16_t* __restrict__ src, int n8, int tid) {
    for (int i = tid; i < n8; i += 2 * NT) {
        u32x4 v[2];
#pragma unroll
        for (int k = 0; k < 2; ++k) if (i + k * NT < n8) v[k] = *(const u32x4*)(src + (size_t)(i + k * NT) * 8);
#pragma unroll
        for (int k = 0; k < 2; ++k) if (i + k * NT < n8) { float* d = dst + (size_t)(i + k * NT) * 8;
            *(f32x4*)(d) = (f32x4){__uint_as_float(v[k].x << 16), __uint_as_float(v[k].x & 0xffff0000u), __uint_as_float(v[k].y << 16), __uint_as_float(v[k].y & 0xffff0000u)};
            *(f32x4*)(d + 4) = (f32x4){__uint_as_float(v[k].z << 16), __uint_as_float(v[k].z & 0xffff0000u), __uint_as_float(v[k].w << 16), __uint_as_float(v[k].w & 0xffff0000u)}; }
    }
}
__device__ __forceinline__ void phase_states_even(const P& p, int il) {
    const int Z = zero_();
    const int tid = TIDX;
    const bf16_t* proj = (const bf16_t*)((p.ws + Z) + WS_PROJ); float* out = (p.out + Z);
    for (int it = blockIdx.x; it < NSEQ * 4; it += gridDim.x) {
        const int s = it >> 2, j = it & 3;
        const int last = s < NBP ? s * SEQ + SEQ - 1 : MP + (s - NBP);
        if (j == 0) copy_row_bf16(out + (s < NBP ? O_PSHIFT + ((size_t)il * NBP + s) * PA : O_SSHIFT + ((size_t)il * NBS + (s - NBP)) * PA), proj + (size_t)last * PLD_E, PA / 8, tid);
        else { const int jj = j - 1;
            float* dst = out + (s < NBP ? O_PLRUC + (((size_t)il * NBP + s) * 3 + jj) * 1024 : O_SLRUC + (((size_t)il * NBS + (s - NBP)) * 3 + jj) * 1024);
            if (s >= NBP && jj < 2) copy_row(dst, p.in[Z + I_SLRUC] + (((size_t)il * NBS + (s - NBP)) * 3 + jj + 1) * 1024, 256, tid);
            else copy_row_bf16(dst, proj + (size_t)(s < NBP ? s * SEQ + SEQ - 3 + jj : last) * PLD_E + XB_OFF, 128, tid); }
    }
}
__device__ __forceinline__ void phase_states_odd(const P& p, int ic) {
    const int Z = zero_();
    const int tid = TIDX;
    const bf16_t* proj = (const bf16_t*)((p.ws + Z) + WS_PROJ); float* out = (p.out + Z);
    for (int it = blockIdx.x; it < NSEQ * 3; it += gridDim.x) {
        const int s = it / 3, j = it % 3;
        float* dst = out + (s < NBP ? O_PGDNC + (((size_t)ic * NBP + s) * 3 + j) * QKV : O_SGDNC + (((size_t)ic * NBS + (s - NBP)) * 3 + j) * QKV);
        if (s >= NBP && j < 2) copy_row(dst, p.in[Z + I_SGDNC] + (((size_t)ic * NBS + (s - NBP)) * 3 + j + 1) * QKV, QKV / 4, tid);
        else copy_row_bf16(dst, proj + (size_t)(s < NBP ? s * SEQ + SEQ - 3 + j : MP + s - NBP) * PC_PAD, QKV / 8, tid);
    }
}
__device__ __forceinline__ void phase_states_ffn(const P& p, int layer) {
    const int Z = zero_();
    const int tid = TIDX;
    const bf16_t* G = (const bf16_t*)((p.ws + Z) + WS_GBUF); float* out = (p.out + Z);
    for (int it = blockIdx.x; it < NSEQ * 2; it += gridDim.x) {
        const int s = it >> 1, j = it & 1;
        float* dst = out + (s < NBP ? O_PFFNC + (((size_t)layer * NBP + s) * 2 + j) * DFF : O_SFFNC + (((size_t)layer * NBS + (s - NBP)) * 2 + j) * DFF);
        if (s >= NBP && j < 1) copy_row(dst, p.in[Z + I_SFFNC] + (((size_t)layer * NBS + (s - NBP)) * 2 + 1) * DFF, DFF / 4, tid);
        else copy_row_bf16(dst, G + (size_t)(s < NBP ? s * SEQ + SEQ - 2 + j : MP + s - NBP) * DFF, DFF / 8, tid);
    }
}

constexpr int PLD_O = PC_PAD;

__device__ __forceinline__ float wave_sum_dpp(float v) { v = allreduce16(v); v += __shfl_xor(v, 16); v += __shfl_xor(v, 32); return v; }
__device__ __forceinline__ void phase_gdn_prep(const P& p, int ic, LAS unsigned char* lds) {
    const int Z = zero_();
    const int tid = TIDX, lane = tid & 63, wave = tid >> 6;
    const bf16_t* proj = (const bf16_t*)((p.ws + Z) + WS_PROJ);
    bf16_t* QN = (bf16_t*)((p.ws + Z) + WS_MIX + MX_QN); bf16_t* KN = (bf16_t*)((p.ws + Z) + WS_MIX + MX_KN);
    bf16_t* KT = (bf16_t*)((p.ws + Z) + WS_MIX + MX_KT); bf16_t* VT = (bf16_t*)((p.ws + Z) + WS_MIX + MX_VT);
    float* VNAT = (float*)((p.ws + Z) + WS_MIX + MX_VNAT); float* BETA = (float*)((p.ws + Z) + WS_MIX + MX_BETA); float* GL = (float*)((p.ws + Z) + WS_MIX + MX_GL);
    const float* cw = p.in[Z + I_GCW] + (size_t)ic * 4 * QKV;
    for (int i = blockIdx.x * NT + tid; i < MV * 32; i += gridDim.x * NT) { const int r = i >> 5, hv = i & 31;
        const float bv = ldb1(proj + (size_t)r * PLD_O + B_OFF + hv), av = ldb1(proj + (size_t)r * PLD_O + A_OFF + hv);
        BETA[i] = sigmoid_(bv); GL[i] = -fexp_(p.in[Z + I_GALOG][ic * 32 + hv]) * softplus_(av + p.in[Z + I_GDTB][ic * 32 + hv]); }
    for (int it2 = blockIdx.x * 8 + wave; it2 < (MP / 64) * 64 + 512; it2 += gridDim.x * 8) {
        const bool sample = it2 >= (MP / 64) * 64;
        const int item = sample ? (MP / 64) * 64 + ((it2 - (MP / 64) * 64) >> 2) : it2, piece = sample ? (it2 & 3) : 0;
        const int tile = item >> 6, slot = item & 63, R0 = tile * 64, ch = slot * 128 + lane * 2;
        const f32x2 w0 = *(const f32x2*)(cw + ch), w1 = *(const f32x2*)(cw + QKV + ch), w2 = *(const f32x2*)(cw + 2 * QKV + ch), w3 = *(const f32x2*)(cw + 3 * QKV + ch);
        f32x2 x3 = (f32x2){0.f, 0.f}, x2 = x3, x1 = x3;
        if (!sample && (R0 & (SEQ - 1)) != 0) { x3 = ldb2(proj + (size_t)(R0 - 3) * PLD_O + ch); x2 = ldb2(proj + (size_t)(R0 - 2) * PLD_O + ch); x1 = ldb2(proj + (size_t)(R0 - 1) * PLD_O + ch); }
        unsigned tr[64];
        if (!sample) {
            f32x2 xin[16], xnx[16];
#pragma unroll
            for (int k = 0; k < 16; ++k) xin[k] = ldb2(proj + (size_t)(R0 + k) * PLD_O + ch);
#pragma unroll
            for (int tb = 0; tb < 64; tb += 16) {
                if (tb + 16 < 64) {
#pragma unroll
                    for (int k = 0; k < 16; ++k) xnx[k] = ldb2(proj + (size_t)(R0 + tb + 16 + k) * PLD_O + ch);
                }
#pragma unroll
                for (int k = 0; k < 16; ++k) {
                    const f32x2 a = w0 * x3 + w1 * x2 + w2 * x1 + w3 * xin[k];
                    x3 = x2; x2 = x1; x1 = xin[k];
                    f32x2 y = (f32x2){silu_(a.x), silu_(a.y)};
                    const int R = R0 + tb + k;
                    if (slot < 32) {
                        const float ss = wave_sum_dpp(y.x * y.x + y.y * y.y);
                        const float sc = rsqrtf(ss + 1e-6f) * (slot < 16 ? 0.08838834764831845f : 1.f);
                        y = y * sc;
                        *(unsigned*)((slot < 16 ? QN : KN) + (size_t)R * D + (slot & 15) * 128 + lane * 2) = pk2(y.x, y.y);
                    }
                    tr[tb + k] = pk2(y.x, y.y);
                }
                if (tb + 16 < 64) {
#pragma unroll
                    for (int k = 0; k < 16; ++k) xin[k] = xnx[k];
                }
            }
        } else {
#pragma unroll 1
            for (int k8 = 0; k8 < 16; k8 += 8) {
            f32x2 s0[8], s1[8], s2[8], xq[8];
#pragma unroll
            for (int k = 0; k < 8; ++k) { const int R = R0 + piece * 16 + k8 + k; const float* st = p.in[Z + I_SGDNC] + ((size_t)ic * NBS + (R - MP)) * 3 * QKV + ch;
                s0[k] = *(const f32x2*)(st); s1[k] = *(const f32x2*)(st + QKV); s2[k] = *(const f32x2*)(st + 2 * QKV); xq[k] = ldb2(proj + (size_t)R * PLD_O + ch); }
            __builtin_amdgcn_sched_barrier(0);
#pragma unroll
            for (int k = 0; k < 8; ++k) {
                const int R = R0 + piece * 16 + k8 + k;
                const f32x2 a = w0 * s0[k] + w1 * s1[k] + w2 * s2[k] + w3 * xq[k];
                f32x2 y = (f32x2){silu_(a.x), silu_(a.y)};
                if (slot < 32) {
                    const float ss = wave_sum_dpp(y.x * y.x + y.y * y.y);
                    const float sc = rsqrtf(ss + 1e-6f) * (slot < 16 ? 0.08838834764831845f : 1.f);
                    y = y * sc;
                    *(unsigned*)((slot < 16 ? QN : KN) + (size_t)R * D + (slot & 15) * 128 + lane * 2) = pk2(y.x, y.y);
                } else {
                    *(f32x2*)(VNAT + (size_t)(R - MP) * 4096 + (slot - 32) * 128 + lane * 2) = y;
                }
            }
            }
        }
        if (slot >= 16 && !sample) {
            const int b = tile >> 5, chunk = tile & 31;
            bf16_t* dst = slot < 32 ? KT + ((((size_t)b * 16 + (slot - 16)) * 32 + chunk) * 128 + lane * 2) * 64
                                    : VT + ((((size_t)b * 32 + (slot - 32)) * 32 + chunk) * 128 + lane * 2) * 64;
#pragma unroll
            for (int q = 0; q < 8; ++q) {
                u32x4 lo, hi;
#pragma unroll
                for (int j = 0; j < 4; ++j) { const unsigned a = tr[q * 8 + 2 * j], c = tr[q * 8 + 2 * j + 1]; lo[j] = (a & 0xffffu) | (c << 16); hi[j] = (a >> 16) | (c & 0xffff0000u); }
                *(u32x4*)(dst + q * 8) = lo; *(u32x4*)(dst + 64 + q * 8) = hi;
            }
        }
    }
}

__device__ __forceinline__ void phase_gdn_wy(const P& p, LAS unsigned char* lds) {
    const int Z = zero_();
    const int tid = TIDX, lane = tid & 63, wave = tid >> 6, l15 = lane & 15, kq = lane >> 4;
    const bf16_t* KN = (const bf16_t*)((p.ws + Z) + WS_MIX + MX_KN); const bf16_t* KT = (const bf16_t*)((p.ws + Z) + WS_MIX + MX_KT); const bf16_t* VT = (const bf16_t*)((p.ws + Z) + WS_MIX + MX_VT);
    const float* BETA = (const float*)((p.ws + Z) + WS_MIX + MX_BETA); const float* GL = (const float*)((p.ws + Z) + WS_MIX + MX_GL);
    bf16_t* U = (bf16_t*)((p.ws + Z) + WS_MIX + MX_U); bf16_t* W = (bf16_t*)((p.ws + Z) + WS_MIX + MX_W);
    constexpr int TLD = 72;
    LAS unsigned char* wl = lds + wave * 18432;
    LAS float* Lm = (LAS float*)wl;
    LAS bf16_t* Tb = (LAS bf16_t*)wl;
    LAS bf16_t* Tg = (LAS bf16_t*)(wl + 64 * TLD * 2);
    for (int u = blockIdx.x * 8 + wave; u < 4096; u += gridDim.x * 8) {
        const int b = u >> 10, hv = (u >> 5) & 31, ch = u & 31, hk = hv >> 1, R0 = b * SEQ + ch * 64;
        const float beta = BETA[(size_t)(R0 + lane) * 32 + hv];
        float G = GL[(size_t)(R0 + lane) * 32 + hv];
#pragma unroll
        for (int o = 1; o < 64; o <<= 1) { const float t = __shfl_up(G, o); if (lane >= o) G += t; }
        bf16x8 kf[4][4];
#pragma unroll
        for (int ib = 0; ib < 4; ++ib)
#pragma unroll
            for (int ks = 0; ks < 4; ++ks) kf[ib][ks] = *(const bf16x8*)(KN + (size_t)(R0 + ib * 16 + l15) * D + hk * 128 + ks * 32 + kq * 8);
        const float Gj[4] = {__shfl(G, l15), __shfl(G, 16 + l15), __shfl(G, 32 + l15), __shfl(G, 48 + l15)};
#pragma unroll
        for (int ib = 0; ib < 4; ++ib) {
            float Gi[4], Bi[4];
#pragma unroll
            for (int r = 0; r < 4; ++r) { Gi[r] = __shfl(G, ib * 16 + kq * 4 + r); Bi[r] = __shfl(beta, ib * 16 + kq * 4 + r); }
#pragma unroll
            for (int jb = 0; jb <= ib; ++jb) {
                f32x4 acc = (f32x4){0.f, 0.f, 0.f, 0.f};
#pragma unroll
                for (int ks = 0; ks < 4; ++ks) acc = mfma16(kf[ib][ks], kf[jb][ks], acc);
#pragma unroll
                for (int r = 0; r < 4; ++r) { const int i = ib * 16 + kq * 4 + r, j = jb * 16 + l15;
                    Lm[i * 64 + j] = (i > j) ? Bi[r] * acc[r] * fexp_(Gi[r] - Gj[jb]) : 0.f; }
            }
        }
        LDS_WAIT(); asm volatile("" ::: "memory");
        float T[64];
#pragma unroll
        for (int i = 0; i < 64; ++i) {
            float a0 = 0.f, a1 = 0.f;
#pragma unroll
            for (int j4 = 0; j4 * 4 < i; ++j4) {
                const f32x4 lv = *(const LAS f32x4*)(Lm + i * 64 + j4 * 4);
                if (j4 * 4 + 0 < i) a0 -= lv.x * T[j4 * 4 + 0];
                if (j4 * 4 + 1 < i) a1 -= lv.y * T[j4 * 4 + 1];
                if (j4 * 4 + 2 < i) a0 -= lv.z * T[j4 * 4 + 2];
                if (j4 * 4 + 3 < i) a1 -= lv.w * T[j4 * 4 + 3];
            }
            { const float sum = a0 + a1; T[i] = (lane == i) ? sum + 1.f : sum; }
        }
        asm volatile("" ::: "memory");
        { const float sb = beta, sg = beta * fexp_(G);
#pragma unroll
          for (int i = 0; i < 64; ++i) { Tb[i * TLD + lane] = (bf16_t)f2bf(T[i] * sb); Tg[i * TLD + lane] = (bf16_t)f2bf(T[i] * sg); } }
        LDS_WAIT(); asm volatile("" ::: "memory");
        const bf16_t* vt = VT + (size_t)u * 128 * 64; const bf16_t* kt = KT + ((((size_t)b * 16 + hk) * 32 + ch) * 128) * 64;
        bf16_t* uo = U + (size_t)u * 64 * 128; bf16_t* wo = W + (size_t)u * 64 * 128;
#pragma unroll 1
        for (int pass = 0; pass < 2; ++pass) {
            const bf16_t* src = pass ? kt : vt; const LAS bf16_t* Tm = pass ? Tg : Tb; bf16_t* dst = pass ? wo : uo;
            bf16x8 tf[4][2];
#pragma unroll
            for (int ib = 0; ib < 4; ++ib)
#pragma unroll
                for (int ks = 0; ks < 2; ++ks) tf[ib][ks] = *(const LAS bf16x8*)(Tm + (ib * 16 + l15) * TLD + ks * 32 + kq * 8);
#pragma unroll 2
            for (int eb = 0; eb < 8; ++eb) {
                const bf16x8 a0 = *(const bf16x8*)(src + (size_t)(eb * 16 + l15) * 64 + kq * 8), a1 = *(const bf16x8*)(src + (size_t)(eb * 16 + l15) * 64 + 32 + kq * 8);
#pragma unroll
                for (int ib = 0; ib < 4; ++ib) {
                    f32x4 acc = mfma16(a0, tf[ib][0], (f32x4){0.f, 0.f, 0.f, 0.f});
                    if (ib >= 2) acc = mfma16(a1, tf[ib][1], acc);
                    *(u32x2*)(dst + (size_t)(ib * 16 + l15) * 128 + eb * 16 + kq * 4) = (u32x2){pk2(acc[0], acc[1]), pk2(acc[2], acc[3])};
                }
            }
        }
        LDS_WAIT(); asm volatile("" ::: "memory");
    }
}

__device__ __forceinline__ void phase_gdn_scan(const P& p, int ic, LAS unsigned char* lds) {
    const int Z = zero_();
    const int tid = TIDX, lane = tid & 63, wave = tid >> 6, l15 = lane & 15, kq = lane >> 4;
    const bf16_t* QN = (const bf16_t*)((p.ws + Z) + WS_MIX + MX_QN); const bf16_t* KN = (const bf16_t*)((p.ws + Z) + WS_MIX + MX_KN); const bf16_t* KT = (const bf16_t*)((p.ws + Z) + WS_MIX + MX_KT);
    const float* GL = (const float*)((p.ws + Z) + WS_MIX + MX_GL);
    const bf16_t* U = (const bf16_t*)((p.ws + Z) + WS_MIX + MX_U); const bf16_t* W = (const bf16_t*)((p.ws + Z) + WS_MIX + MX_W);
    bf16_t* O = (bf16_t*)((p.ws + Z) + WS_MIX + MX_O);
    constexpr int LD1 = 136, LD2 = 72;
    LAS bf16_t* QS = (LAS bf16_t*)lds;
    LAS bf16_t* KS = QS + 64 * LD1;
    LAS bf16_t* WS = KS + 64 * LD1;
    LAS bf16_t* ST0 = WS + 64 * LD1;
    LAS bf16_t* ST1 = ST0 + 64 * LD1;
    LAS bf16_t* KTS = ST1 + 64 * LD1;
    LAS bf16_t* VNT = KTS + 128 * LD2;
    LAS bf16_t* VNS = VNT + 64 * LD2;
    LAS bf16_t* QK = VNS + 64 * LD2;
    for (int u = blockIdx.x; u < 256; u += gridDim.x) {
        const int b = u >> 6, hv = (u >> 1) & 31, eh = u & 1, hk = hv >> 1;
        f32x4 S[4];
#pragma unroll
        for (int eb = 0; eb < 4; ++eb) S[eb] = (f32x4){0.f, 0.f, 0.f, 0.f};
        LDS_BARRIER();
        for (int i = tid; i < 64 * LD1 / 2; i += NT) ((LAS unsigned*)ST0)[i] = 0u;
        u32x4 pq[2], pk[2], pw[2], pt[2]; u32x2 pu[2]; float pg;
#define GDN_PREFETCH(CH) do { const int R0n = b * SEQ + (CH) * 64; const size_t cun = ((size_t)(b * 32 + hv) * 32 + (CH)); const int tz = TIDX; \
            _Pragma("unroll") for (int k = 0; k < 2; ++k) { const int i = tz + k * NT, r = i >> 4, c = (i & 15) * 8; \
                pq[k] = *(const u32x4*)(QN + (size_t)(R0n + r) * D + hk * 128 + c); pk[k] = *(const u32x4*)(KN + (size_t)(R0n + r) * D + hk * 128 + c); \
                pw[k] = *(const u32x4*)(W + cun * 8192 + r * 128 + c); const int r2 = i >> 3, c2 = (i & 7) * 8; \
                pt[k] = *(const u32x4*)(KT + ((((size_t)b * 16 + hk) * 32 + (CH)) * 128 + r2) * 64 + c2); } \
            pg = GL[(size_t)(R0n + (tz & 63)) * 32 + hv]; \
            _Pragma("unroll") for (int tt = 0; tt < 2; ++tt) { const int t = (tz >> 6) * 2 + tt, eb = t >> 2, tb = t & 3; \
                pu[tt] = *(const u32x2*)(U + cun * 8192 + (size_t)(tb * 16 + (tz & 15)) * 128 + eh * 64 + eb * 16 + ((tz >> 4) & 3) * 4); } } while (0)
        GDN_PREFETCH(0);
#pragma unroll 1
        for (int ch = 0; ch < 32; ++ch) {
            const int R0 = b * SEQ + ch * 64;
            LAS bf16_t* STc = (ch & 1) ? ST1 : ST0; LAS bf16_t* STn = (ch & 1) ? ST0 : ST1;
            LDS_BARRIER();
            { const int tz = TIDX;
#pragma unroll
            for (int k = 0; k < 2; ++k) { const int i = tz + k * NT, r = i >> 4, c = (i & 15) * 8;
                *(LAS u32x4*)(QS + r * LD1 + c) = pq[k]; *(LAS u32x4*)(KS + r * LD1 + c) = pk[k]; *(LAS u32x4*)(WS + r * LD1 + c) = pw[k];
                const int r2 = i >> 3, c2 = (i & 7) * 8; *(LAS u32x4*)(KTS + r2 * LD2 + c2) = pt[k]; } }
            float G = pg;
            const u32x2 ucur[2] = {pu[0], pu[1]};
            if (ch + 1 < 32) GDN_PREFETCH(ch + 1);
#pragma unroll
            for (int o = 1; o < 64; o <<= 1) { const float t = __shfl_up(G, o); if (lane >= o) G += t; }
            const float Glast = __shfl(G, 63);
            LDS_BARRIER();
#pragma unroll
            for (int tt = 0; tt < 2; ++tt) {
                const int t = wave * 2 + tt, jb = t >> 2, ib = t & 3;
                f32x4 acc = (f32x4){0.f, 0.f, 0.f, 0.f};
#pragma unroll
                for (int ks = 0; ks < 4; ++ks) acc = mfma16(*(const LAS bf16x8*)(KS + (jb * 16 + l15) * LD1 + ks * 32 + kq * 8), *(const LAS bf16x8*)(QS + (ib * 16 + l15) * LD1 + ks * 32 + kq * 8), acc);
                const int i = ib * 16 + l15; const float Gi = __shfl(G, i);
                float o4[4];
#pragma unroll
                for (int r = 0; r < 4; ++r) { const int j = jb * 16 + kq * 4 + r; const float Gj = __shfl(G, j); o4[r] = (i >= j) ? acc[r] * fexp_(Gi - Gj) : 0.f; }
                *(LAS u32x2*)(QK + i * LD2 + jb * 16 + kq * 4) = (u32x2){pk2(o4[0], o4[1]), pk2(o4[2], o4[3])};
            }
#pragma unroll
            for (int tt = 0; tt < 2; ++tt) {
                const int t = wave * 2 + tt, eb = t >> 2, tb = t & 3;
                f32x4 acc = (f32x4){0.f, 0.f, 0.f, 0.f};
#pragma unroll
                for (int ks = 0; ks < 4; ++ks) acc = mfma16(*(const LAS bf16x8*)(STc + (eb * 16 + l15) * LD1 + ks * 32 + kq * 8), *(const LAS bf16x8*)(WS + (tb * 16 + l15) * LD1 + ks * 32 + kq * 8), acc);
                const int tok = tb * 16 + l15, e0 = eb * 16 + kq * 4;
                const u32x2 uu = ucur[tt];
                const float sc = fexp_(Glast - __shfl(G, tok));
                const float vn[4] = {bf2f(uu.x & 0xffffu) - acc[0], bf2f(uu.x >> 16) - acc[1], bf2f(uu.y & 0xffffu) - acc[2], bf2f(uu.y >> 16) - acc[3]};
#pragma unroll
                for (int r = 0; r < 4; ++r) { VNT[(e0 + r) * LD2 + tok] = (bf16_t)f2bf(vn[r]); VNS[(e0 + r) * LD2 + tok] = (bf16_t)f2bf(vn[r] * sc); }
            }
            LDS_BARRIER();
#pragma unroll
            for (int tt = 0; tt < 2; ++tt) {
                const int t = wave * 2 + tt, eb = t >> 2, tb = t & 3;
                f32x4 a1 = (f32x4){0.f, 0.f, 0.f, 0.f}, a2 = a1;
#pragma unroll
                for (int ks = 0; ks < 4; ++ks) a1 = mfma16(*(const LAS bf16x8*)(STc + (eb * 16 + l15) * LD1 + ks * 32 + kq * 8), *(const LAS bf16x8*)(QS + (tb * 16 + l15) * LD1 + ks * 32 + kq * 8), a1);
#pragma unroll
                for (int ks = 0; ks < 2; ++ks) a2 = mfma16(*(const LAS bf16x8*)(VNT + (eb * 16 + l15) * LD2 + ks * 32 + kq * 8), *(const LAS bf16x8*)(QK + (tb * 16 + l15) * LD2 + ks * 32 + kq * 8), a2);
                const int tok = tb * 16 + l15, e0 = eb * 16 + kq * 4; const float eg = fexp_(__shfl(G, tok));
                { const f32x4 ov = a1 * eg + a2; *(u32x2*)(O + (size_t)(R0 + tok) * 4096 + hv * 128 + eh * 64 + e0) = (u32x2){pk2(ov[0], ov[1]), pk2(ov[2], ov[3])}; }
            }
            { const float ge = fexp_(Glast);
              const bf16x8 k0 = *(const LAS bf16x8*)(KTS + (wave * 16 + l15) * LD2 + kq * 8), k1 = *(const LAS bf16x8*)(KTS + (wave * 16 + l15) * LD2 + 32 + kq * 8);
#pragma unroll
              for (int eb = 0; eb < 4; ++eb) {
                  f32x4 s = S[eb] * ge;
                  s = mfma16(k0, *(const LAS bf16x8*)(VNS + (eb * 16 + l15) * LD2 + kq * 8), s);
                  s = mfma16(k1, *(const LAS bf16x8*)(VNS + (eb * 16 + l15) * LD2 + 32 + kq * 8), s);
                  S[eb] = s;
                  *(LAS u32x2*)(STn + (eb * 16 + l15) * LD1 + wave * 16 + kq * 4) = (u32x2){pk2(s[0], s[1]), pk2(s[2], s[3])};
              } }
        }
#undef GDN_PREFETCH
        float* so = (p.out + Z) + O_PGDN + (((size_t)ic * NBP + b) * 32 + hv) * 16384;
#pragma unroll
        for (int eb = 0; eb < 4; ++eb)
#pragma unroll
            for (int r = 0; r < 4; ++r) so[(size_t)(wave * 16 + kq * 4 + r) * 128 + eh * 64 + eb * 16 + l15] = S[eb][r];
    }
}

__device__ __forceinline__ void phase_gdn_step(const P& p, int ic, LAS unsigned char* lds) {
    const int Z = zero_();
    const int tid = TIDX, e = tid & 127, dq = tid >> 7;
    const bf16_t* QN = (const bf16_t*)((p.ws + Z) + WS_MIX + MX_QN); const bf16_t* KN = (const bf16_t*)((p.ws + Z) + WS_MIX + MX_KN);
    const float* VNAT = (const float*)((p.ws + Z) + WS_MIX + MX_VNAT); const float* BETA = (const float*)((p.ws + Z) + WS_MIX + MX_BETA); const float* GL = (const float*)((p.ws + Z) + WS_MIX + MX_GL);
    bf16_t* O = (bf16_t*)((p.ws + Z) + WS_MIX + MX_O);
    const float* SIN = p.in[Z + I_SGDN] + (size_t)ic * NBS * 32 * 16384; float* SOUT = (p.out + Z) + O_SGDN + (size_t)ic * NBS * 32 * 16384;
    LAS float* qs = (LAS float*)lds; LAS float* ks = qs + 128; LAS float* red = ks + 128;
    float s[32], sn[32];
    int u = blockIdx.x;
    if (u < NBS * 32) {
#pragma unroll
        for (int i = 0; i < 32; ++i) sn[i] = SIN[(size_t)u * 16384 + (size_t)(dq * 32 + i) * 128 + e];
    }
    for (; u < NBS * 32; u += gridDim.x) {
        const int b = u >> 5, hv = u & 31, hk = hv >> 1, R = MP + b;
#pragma unroll
        for (int i = 0; i < 32; ++i) s[i] = sn[i];
        const int un = u + gridDim.x;
        if (un < NBS * 32) {
#pragma unroll
            for (int i = 0; i < 32; ++i) sn[i] = SIN[(size_t)un * 16384 + (size_t)(dq * 32 + i) * 128 + e];
        }
        LDS_BARRIER();
        if (tid < 128) qs[tid] = bf2f(QN[(size_t)R * D + hk * 128 + tid]); else if (tid < 256) ks[tid - 128] = bf2f(KN[(size_t)R * D + hk * 128 + tid - 128]);
        const float eg = fexp_(GL[(size_t)R * 32 + hv]), beta = BETA[(size_t)R * 32 + hv];
        const float vv = VNAT[(size_t)b * 4096 + hv * 128 + e];
        float* so = SOUT + (size_t)u * 16384;
        LDS_BARRIER();
        float sk = 0.f;
#pragma unroll
        for (int i = 0; i < 32; ++i) sk += s[i] * ks[dq * 32 + i];
        red[dq * 128 + e] = sk;
        LDS_BARRIER();
        sk = red[e] + red[128 + e] + red[256 + e] + red[384 + e];
        const float vn = beta * (vv - eg * sk);
        float oo = 0.f;
#pragma unroll
        for (int i = 0; i < 32; ++i) { const float x = eg * s[i] + ks[dq * 32 + i] * vn; so[(size_t)(dq * 32 + i) * 128 + e] = x; oo += x * qs[dq * 32 + i]; }
        LDS_BARRIER();
        red[dq * 128 + e] = oo;
        LDS_BARRIER();
        if (dq == 0) O[(size_t)R * 4096 + hv * 128 + e] = (bf16_t)f2bf(red[e] + red[128 + e] + red[256 + e] + red[384 + e]);
    }
}

__device__ __forceinline__ void gdn_post_task(const bf16_t* __restrict__ O, const bf16_t* __restrict__ proj, bf16_t* __restrict__ YO, f32x2 nw, int R, int hv0, int lane) {
    f32x2 o[4], z[4];
#pragma unroll
    for (int k = 0; k < 4; ++k) { o[k] = ldb2(O + (size_t)R * 4096 + (hv0 + k) * 128 + lane * 2); z[k] = ldb2(proj + (size_t)R * PLD_O + Z_OFF + (hv0 + k) * 128 + lane * 2); }
    float ss[4];
#pragma unroll
    for (int k = 0; k < 4; ++k) ss[k] = allreduce16(o[k].x * o[k].x + o[k].y * o[k].y);
#pragma unroll
    for (int k = 0; k < 4; ++k) ss[k] += __shfl_xor(ss[k], 16);
#pragma unroll
    for (int k = 0; k < 4; ++k) ss[k] += __shfl_xor(ss[k], 32);
#pragma unroll
    for (int k = 0; k < 4; ++k) { const float rs = rsqrtf(ss[k] * (1.f / 128.f) + 1e-6f);
        *(unsigned*)(YO + (size_t)R * 4096 + (hv0 + k) * 128 + lane * 2) = pk2(o[k].x * rs * nw.x * silu_(z[k].x), o[k].y * rs * nw.y * silu_(z[k].y)); }
}
__device__ __forceinline__ void phase_gdn_post(const P& p, int ic) {
    const int Z = zero_();
    const int lane = TIDX & 63, wave = TIDX >> 6;
    const bf16_t* proj = (const bf16_t*)((p.ws + Z) + WS_PROJ); const bf16_t* O = (const bf16_t*)((p.ws + Z) + WS_MIX + MX_O); bf16_t* YO = (bf16_t*)((p.ws + Z) + WS_YO);
    const f32x2 nw = *(const f32x2*)(p.in[Z + I_GNORM] + (size_t)ic * 128 + lane * 2);
    for (int task = blockIdx.x * 8 + wave; task < MV * 8; task += gridDim.x * 8) gdn_post_task(O, proj, YO, nw, task >> 3, (task & 7) * 4, lane);
}

constexpr size_t WS_CH = WS_GBUF;
constexpr size_t WS_GC = WS_CH + (size_t)2048 * 65536;
static_assert(WS_GC + (size_t)2048 * 256 <= WS_ACT, "chunk operands must fit in the gate buffer region");

__device__ __forceinline__ void phase_rwkv_chunk(const P& p, int il) {
    const int Z = zero_();
    const int tid = TIDX, lane = tid & 63, wave = tid >> 6;
    float* SCB = (float*)((p.ws + Z) + WS_MIX + MX_SCB); float* C123 = (float*)((p.ws + Z) + WS_MIX + MX_C123);
    const bf16_t* proj = (const bf16_t*)((p.ws + Z) + WS_PROJ);
    bf16_t* CH = (bf16_t*)((p.ws + Z) + WS_CH); float* GC = (float*)((p.ws + Z) + WS_GC);
    const float* mu = p.in[Z + I_MU] + (size_t)il * PA;
    for (int item = blockIdx.x * 8 + wave; item < 2048; item += gridDim.x * 8) {
        const int b = item >> 9, h = (item >> 5) & 15, n = item & 31, R0 = b * SEQ + n * 64, c = h * 64 + lane;
        const float mur = mu[c], muk = mu[1024 + c], muv = mu[2048 + c];
        const float kkw = p.in[Z + I_KK][il * 1024 + c], kaw = p.in[Z + I_KA][il * 1024 + c], rkw = p.in[Z + I_RK][il * 1024 + c];
        float* sb = SCB + ((size_t)h * MV + R0) * 384 + lane;
        const bf16_t* pr = proj + (size_t)R0 * PLD_E + c;
        bf16_t* ch = CH + (size_t)item * 32768;
        float rp = 0.f, kp_ = 0.f, vp = 0.f;
        if (n != 0) { rp = ldb1(pr - PLD_E); kp_ = ldb1(pr - PLD_E + 1024); vp = ldb1(pr - PLD_E + 2048); }
        float G = 0.f, eGprev = 1.f;
#pragma unroll 1
        for (int half = 0; half < 2; ++half) {
            unsigned tK[16], tB[16], tP[16], tV[16];
#pragma unroll
            for (int q = 0; q < 4; ++q) {
                float rc[8], kc[8], vc[8], lw[8], aa[8];
#pragma unroll
                for (int k = 0; k < 8; ++k) { const int t = half * 32 + q * 8 + k; const bf16_t* prt = pr + (size_t)t * PLD_E;
                    rc[k] = ldb1(prt); kc[k] = ldb1(prt + 1024); vc[k] = ldb1(prt + 2048); lw[k] = sb[(size_t)t * 384 + 64]; aa[k] = sb[(size_t)t * 384 + 128]; }
#pragma unroll
                for (int k = 0; k < 8; k += 2) {
                    float o[2][5];
#pragma unroll
                    for (int e = 0; e < 2; ++e) {
                        const int t = half * 32 + q * 8 + k + e;
                        const float r = rc[k + e] + (rp - rc[k + e]) * mur, kx = kc[k + e] + (kp_ - kc[k + e]) * muk, v = vc[k + e] + (vp - vc[k + e]) * muv;
                        rp = rc[k + e]; kp_ = kc[k + e]; vp = vc[k + e];
                        const float kkx = kx * kkw, a = aa[k + e];
                        const float rn = rsqrtf(wave_sum_dpp(kkx * kkx) + 1e-12f);
                        const float kk = kkx * rn, kka = kk * a, kpr = kx * (1.f + (a - 1.f) * kaw);
                        const float c3 = wave_sum_dpp(r * kpr * rkw);
                        if (lane == 0) C123[((size_t)(R0 + t) * 16 + h) * 4 + 2] = c3;
                        sb[(size_t)t * 384 + 320] = v;
                        G += lw[k + e]; const float eG = fexp_(G), ei = fexp_(-G);
                        o[e][0] = kk * eGprev; o[e][1] = r * eG; o[e][2] = kka * ei; o[e][3] = kpr * ei; o[e][4] = v; eGprev = eG;
                        ch[0 * 4096 + t * 64 + lane] = (bf16_t)f2bf(o[e][0]); ch[1 * 4096 + t * 64 + lane] = (bf16_t)f2bf(o[e][1]);
                        ch[2 * 4096 + t * 64 + lane] = (bf16_t)f2bf(o[e][2]); ch[3 * 4096 + t * 64 + lane] = (bf16_t)f2bf(o[e][3]); }
                    const int j = q * 4 + k / 2;
                    tK[j] = pk2(o[0][0], o[1][0]); tB[j] = pk2(o[0][2], o[1][2]); tP[j] = pk2(o[0][3], o[1][3]); tV[j] = pk2(o[0][4], o[1][4]);
                }
            }
#pragma unroll
            for (int q = 0; q < 4; ++q) {
                *(u32x4*)(ch + 4 * 4096 + lane * 64 + half * 32 + q * 8) = (u32x4){tK[q * 4], tK[q * 4 + 1], tK[q * 4 + 2], tK[q * 4 + 3]};
                *(u32x4*)(ch + 5 * 4096 + lane * 64 + half * 32 + q * 8) = (u32x4){tB[q * 4], tB[q * 4 + 1], tB[q * 4 + 2], tB[q * 4 + 3]};
                *(u32x4*)(ch + 6 * 4096 + lane * 64 + half * 32 + q * 8) = (u32x4){tP[q * 4], tP[q * 4 + 1], tP[q * 4 + 2], tP[q * 4 + 3]};
                *(u32x4*)(ch + 7 * 4096 + lane * 64 + half * 32 + q * 8) = (u32x4){tV[q * 4], tV[q * 4 + 1], tV[q * 4 + 2], tV[q * 4 + 3]};
            }
        }
        GC[(size_t)item * 64 + lane] = fexp_(G);
    }
}

__device__ __forceinline__ bf16x8 ch_frag(const bf16_t* m, int rb, int ks, int l15, int kq) { return *(const bf16x8*)(m + (size_t)(rb * 16 + l15) * 64 + ks * 32 + kq * 8); }

__device__ __forceinline__ void phase_rwkv_wy(const P& p, LAS unsigned char* lds) {
    const int Z = zero_();
    const int tid = TIDX, lane = tid & 63, wave = tid >> 6, l15 = lane & 15, kq = lane >> 4;
    bf16_t* CH = (bf16_t*)((p.ws + Z) + WS_CH);
    constexpr int TLD = 72;
    LAS unsigned char* wl = lds + wave * 18432;
    LAS float* Lm = (LAS float*)wl;
    LAS bf16_t* R0m = (LAS bf16_t*)wl;
    LAS bf16_t* R1m = (LAS bf16_t*)(wl + 64 * TLD * 2);
    for (int u = blockIdx.x * 8 + wave; u < 2048; u += gridDim.x * 8) {
        bf16_t* ch = CH + (size_t)u * 32768;
        {   bf16x8 kf[4][2], bf[4][2];
#pragma unroll
            for (int rb = 0; rb < 4; ++rb)
#pragma unroll
                for (int ks = 0; ks < 2; ++ks) { kf[rb][ks] = ch_frag(ch, rb, ks, l15, kq); bf[rb][ks] = ch_frag(ch + 2 * 4096, rb, ks, l15, kq); }
#pragma unroll
            for (int tb = 0; tb < 4; ++tb)
#pragma unroll
                for (int sb = 0; sb <= tb; ++sb) {
                    f32x4 acc = mfma16(kf[tb][0], bf[sb][0], (f32x4){0.f, 0.f, 0.f, 0.f}); acc = mfma16(kf[tb][1], bf[sb][1], acc);
#pragma unroll
                    for (int r = 0; r < 4; ++r) { const int t = tb * 16 + kq * 4 + r, s = sb * 16 + l15; Lm[t * 64 + s] = (t > s) ? acc[r] : 0.f; }
                }
        }
        LDS_WAIT(); asm volatile("" ::: "memory");
        float T[64];
#pragma unroll
        for (int i = 0; i < 64; ++i) {
            float a0 = 0.f, a1 = 0.f;
#pragma unroll
            for (int j4 = 0; j4 * 4 < i; ++j4) {
                const f32x4 lv = *(const LAS f32x4*)(Lm + i * 64 + j4 * 4);
                if (j4 * 4 + 0 < i) a0 -= lv.x * T[j4 * 4 + 0];
                if (j4 * 4 + 1 < i) a1 -= lv.y * T[j4 * 4 + 1];
                if (j4 * 4 + 2 < i) a0 -= lv.z * T[j4 * 4 + 2];
                if (j4 * 4 + 3 < i) a1 -= lv.w * T[j4 * 4 + 3];
            }
            { const float sum = a0 + a1; T[i] = (lane == i) ? sum + 1.f : sum; }
        }
        asm volatile("" ::: "memory");
        { unsigned long long cz = (unsigned long long)ch; asm volatile("" : "+v"(cz)); ch = (bf16_t*)cz; }
#pragma unroll
        for (int i = 0; i < 64; ++i) R0m[i * TLD + lane] = (bf16_t)f2bf(T[i]);
#pragma unroll
        for (int q = 0; q < 9; ++q) *(LAS u32x4*)((LAS unsigned char*)R1m + (q * 64 + lane) * 16) = (u32x4){0u, 0u, 0u, 0u};
        LDS_WAIT(); asm volatile("" ::: "memory");
        {   bf16x8 kf[4][2], pf[4][2];
#pragma unroll
            for (int rb = 0; rb < 4; ++rb)
#pragma unroll
                for (int ks = 0; ks < 2; ++ks) { kf[rb][ks] = ch_frag(ch, rb, ks, l15, kq); pf[rb][ks] = ch_frag(ch + 3 * 4096, rb, ks, l15, kq); }
#pragma unroll
            for (int tb = 0; tb < 4; ++tb)
#pragma unroll
                for (int sb = 0; sb <= tb; ++sb) {
                    f32x4 acc = mfma16(kf[tb][0], pf[sb][0], (f32x4){0.f, 0.f, 0.f, 0.f}); acc = mfma16(kf[tb][1], pf[sb][1], acc);
                    const int s = sb * 16 + l15, t0 = tb * 16 + kq * 4;
                    *(LAS u32x2*)(R1m + s * TLD + t0) = (u32x2){pk2(t0 + 0 > s ? acc[0] : 0.f, t0 + 1 > s ? acc[1] : 0.f), pk2(t0 + 2 > s ? acc[2] : 0.f, t0 + 3 > s ? acc[3] : 0.f)};
                }
        }
        LDS_WAIT(); asm volatile("" ::: "memory");
        {   f32x4 tbr[4][4];
#pragma unroll
            for (int sb = 0; sb < 4; ++sb)
#pragma unroll
                for (int tb = 0; tb < 4; ++tb) {
                    f32x4 acc = (f32x4){0.f, 0.f, 0.f, 0.f};
                    if (tb >= sb) {
#pragma unroll
                        for (int ks = 0; ks < 2; ++ks) acc = mfma16(*(const LAS bf16x8*)(R1m + (sb * 16 + l15) * TLD + ks * 32 + kq * 8), *(const LAS bf16x8*)(R0m + (tb * 16 + l15) * TLD + ks * 32 + kq * 8), acc);
                    }
                    tbr[sb][tb] = acc;
                }
            LDS_WAIT(); asm volatile("" ::: "memory");
#pragma unroll
            for (int sb = 0; sb < 4; ++sb)
#pragma unroll
                for (int tb = 0; tb < 4; ++tb) *(LAS u32x2*)(R1m + (tb * 16 + l15) * TLD + sb * 16 + kq * 4) = (u32x2){pk2(tbr[sb][tb][0], tbr[sb][tb][1]), pk2(tbr[sb][tb][2], tbr[sb][tb][3])};
        }
        LDS_WAIT(); asm volatile("" ::: "memory");
        bf16x8 rf[4][2];
#pragma unroll
        for (int rb = 0; rb < 4; ++rb)
#pragma unroll
            for (int ks = 0; ks < 2; ++ks) rf[rb][ks] = ch_frag(ch + 1 * 4096, rb, ks, l15, kq);
#pragma unroll 1
        for (int pass = 0; pass < 4; ++pass) {
            if ((pass & 1) == 0) {
                const bf16_t* src = ch + (pass ? 7 : 4) * 4096; const LAS bf16_t* Tm = pass ? R1m : R0m; bf16_t* dst = ch + (pass ? 2 : 0) * 4096;
                bf16x8 af[4][2];
#pragma unroll
                for (int rb = 0; rb < 4; ++rb)
#pragma unroll
                    for (int ks = 0; ks < 2; ++ks) af[rb][ks] = ch_frag(src, rb, ks, l15, kq);
#pragma unroll
                for (int tb = 0; tb < 4; ++tb) {
                    const bf16x8 t0 = *(const LAS bf16x8*)(Tm + (tb * 16 + l15) * TLD + kq * 8), t1 = *(const LAS bf16x8*)(Tm + (tb * 16 + l15) * TLD + 32 + kq * 8);
#pragma unroll
                    for (int rb = 0; rb < 4; ++rb) {
                        f32x4 acc = mfma16(af[rb][0], t0, (f32x4){0.f, 0.f, 0.f, 0.f});
                        if (tb >= 2) acc = mfma16(af[rb][1], t1, acc);
                        *(u32x2*)(dst + (size_t)(tb * 16 + l15) * 64 + rb * 16 + kq * 4) = (u32x2){pk2(acc[0], acc[1]), pk2(acc[2], acc[3])};
                    }
                }
            } else {
                bf16x8 sf[4][2];
#pragma unroll
                for (int rb = 0; rb < 4; ++rb)
#pragma unroll
                    for (int ks = 0; ks < 2; ++ks) sf[rb][ks] = ch_frag(ch + (pass == 3 ? 3 : 2) * 4096, rb, ks, l15, kq);
#pragma unroll
                for (int sb = 0; sb < 4; ++sb)
#pragma unroll
                    for (int tb = 0; tb < 4; ++tb) {
                        f32x4 acc = (f32x4){0.f, 0.f, 0.f, 0.f};
                        if (tb >= sb) { acc = mfma16(sf[sb][0], rf[tb][0], acc); acc = mfma16(sf[sb][1], rf[tb][1], acc); }
                        const int t = tb * 16 + l15, s0 = sb * 16 + kq * 4;
                        const u32x2 w = (u32x2){pk2(t >= s0 + 0 ? acc[0] : 0.f, t >= s0 + 1 ? acc[1] : 0.f), pk2(t >= s0 + 2 ? acc[2] : 0.f, t >= s0 + 3 ? acc[3] : 0.f)};
                        if (pass == 3) *(LAS u32x2*)(R0m + t * TLD + s0) = w; else *(u32x2*)(ch + 4 * 4096 + (size_t)t * 64 + s0) = w;
                    }
            }
            LDS_WAIT(); asm volatile("" ::: "memory");
        }
        {   bf16x8 vf[4][2];
#pragma unroll
            for (int rb = 0; rb < 4; ++rb)
#pragma unroll
                for (int ks = 0; ks < 2; ++ks) vf[rb][ks] = ch_frag(ch + 7 * 4096, rb, ks, l15, kq);
#pragma unroll
            for (int tb = 0; tb < 4; ++tb) {
                const bf16x8 t0 = *(const LAS bf16x8*)(R0m + (tb * 16 + l15) * TLD + kq * 8), t1 = *(const LAS bf16x8*)(R0m + (tb * 16 + l15) * TLD + 32 + kq * 8);
#pragma unroll
                for (int ib = 0; ib < 4; ++ib) {
                    f32x4 acc = mfma16(vf[ib][0], t0, (f32x4){0.f, 0.f, 0.f, 0.f});
                    if (tb >= 2) acc = mfma16(vf[ib][1], t1, acc);
                    *(u32x2*)(ch + 3 * 4096 + (size_t)(tb * 16 + l15) * 64 + ib * 16 + kq * 4) = (u32x2){pk2(acc[0], acc[1]), pk2(acc[2], acc[3])};
                }
            }
            bf16x8 pT[4][2];
#pragma unroll
            for (int rb = 0; rb < 4; ++rb)
#pragma unroll
                for (int ks = 0; ks < 2; ++ks) pT[rb][ks] = ch_frag(ch + 6 * 4096, rb, ks, l15, kq);
            f32x4 kv[4][4];
#pragma unroll
            for (int cb = 0; cb < 4; ++cb)
#pragma unroll
                for (int ib = 0; ib < 4; ++ib) { f32x4 acc = mfma16(pT[cb][0], vf[ib][0], (f32x4){0.f, 0.f, 0.f, 0.f}); kv[cb][ib] = mfma16(pT[cb][1], vf[ib][1], acc); }
            float* kvt = (float*)(ch + 6 * 4096);
#pragma unroll
            for (int cb = 0; cb < 4; ++cb)
#pragma unroll
                for (int ib = 0; ib < 4; ++ib) *(f32x4*)(kvt + (size_t)(ib * 16 + l15) * 64 + cb * 16 + kq * 4) = kv[cb][ib];
        }
        LDS_WAIT(); asm volatile("" ::: "memory");
    }
}

__device__ __forceinline__ void phase_rwkv_rec(const P& p, int il, LAS unsigned char* lds) {
    const int Z = zero_();
    const int tid = TIDX, lane = tid & 63, wave = tid >> 6, l15 = lane & 15, kq = lane >> 4;
    const bf16_t* CH = (const bf16_t*)((p.ws + Z) + WS_CH); const float* GC = (const float*)((p.ws + Z) + WS_GC);
    float* YRAW = (float*)((p.ws + Z) + WS_MIX + MX_YRAW);
    constexpr int LD = 72;
    LAS bf16_t* WkS = (LAS bf16_t*)lds; LAS bf16_t* RgS = WkS + 64 * LD; LAS bf16_t* ArS = RgS + 64 * LD; LAS bf16_t* BtS = ArS + 64 * LD;
    LAS bf16_t* MT0 = BtS + 64 * LD; LAS bf16_t* MT1 = MT0 + 32 * LD; LAS bf16_t* PT = MT1 + 32 * LD;
    const int ibw = wave >> 2, tbw = wave & 3, cbw = wave & 3;
    for (int u = blockIdx.x; u < 128; u += gridDim.x) {
        const int b = u >> 5, h = (u >> 1) & 15, ih = u & 1; const size_t cu0 = (size_t)(b * 16 + h) * 32;
        f32x4 M = (f32x4){0.f, 0.f, 0.f, 0.f};
        __syncthreads();
        for (int i = tid; i < 32 * LD / 2; i += NT) ((LAS unsigned*)MT0)[i] = 0u;
        u32x4 pw, pr, pa, pb; u32x2 pu, py; f32x4 pk, pg;
#define RW_PREFETCH(N) do { const bf16_t* chn = CH + (cu0 + (N)) * 32768; const int tz = TIDX, row = tz >> 3, c8 = (tz & 7) * 8, l15z = tz & 15, kqz = (tz >> 4) & 3, wz = tz >> 6; \
            pw = *(const u32x4*)(chn + 0 * 4096 + row * 64 + c8); pr = *(const u32x4*)(chn + 1 * 4096 + row * 64 + c8); \
            pa = *(const u32x4*)(chn + 4 * 4096 + row * 64 + c8); pb = *(const u32x4*)(chn + 5 * 4096 + row * 64 + c8); \
            const int tt = (wz & 3) * 16 + l15z, i0 = ih * 32 + (wz >> 2) * 16 + kqz * 4; \
            pu = *(const u32x2*)(chn + 2 * 4096 + tt * 64 + i0); py = *(const u32x2*)(chn + 3 * 4096 + tt * 64 + i0); \
            pk = *(const f32x4*)((const float*)(chn + 6 * 4096) + (size_t)(ih * 32 + (wz >> 2) * 16 + l15z) * 64 + (wz & 3) * 16 + kqz * 4); \
            pg = *(const f32x4*)(GC + (cu0 + (N)) * 64 + (wz & 3) * 16 + kqz * 4); } while (0)
        RW_PREFETCH(0);
#pragma unroll 1
        for (int n = 0; n < 32; ++n) {
            const int R0 = b * SEQ + n * 64;
            LAS bf16_t* MTc = (n & 1) ? MT1 : MT0; LAS bf16_t* MTn = (n & 1) ? MT0 : MT1;
            __syncthreads();
            { const int tz = TIDX, row = tz >> 3, c8 = (tz & 7) * 8;
              *(LAS u32x4*)(WkS + row * LD + c8) = pw; *(LAS u32x4*)(RgS + row * LD + c8) = pr; *(LAS u32x4*)(ArS + row * LD + c8) = pa; *(LAS u32x4*)(BtS + row * LD + c8) = pb; }
            const u32x2 ucur = pu, ycur = py; const f32x4 kvcur = pk, gcur = pg;
            if (n + 1 < 32) RW_PREFETCH(n + 1);
            __syncthreads();
            {   f32x4 acc = mfma16(*(const LAS bf16x8*)(MTc + (ibw * 16 + l15) * LD + kq * 8), *(const LAS bf16x8*)(WkS + (tbw * 16 + l15) * LD + kq * 8), (f32x4){0.f, 0.f, 0.f, 0.f});
                acc = mfma16(*(const LAS bf16x8*)(MTc + (ibw * 16 + l15) * LD + 32 + kq * 8), *(const LAS bf16x8*)(WkS + (tbw * 16 + l15) * LD + 32 + kq * 8), acc);
                const float pv[4] = {acc[0] + bf2f(ucur.x & 0xffffu), acc[1] + bf2f(ucur.x >> 16), acc[2] + bf2f(ucur.y & 0xffffu), acc[3] + bf2f(ucur.y >> 16)};
#pragma unroll
                for (int r = 0; r < 4; ++r) PT[(ibw * 16 + kq * 4 + r) * LD + tbw * 16 + l15] = (bf16_t)f2bf(pv[r]);
            }
            __syncthreads();
            {   f32x4 a1 = (f32x4){0.f, 0.f, 0.f, 0.f}, a2 = a1;
#pragma unroll
                for (int ks = 0; ks < 2; ++ks) {
                    a1 = mfma16(*(const LAS bf16x8*)(MTc + (ibw * 16 + l15) * LD + ks * 32 + kq * 8), *(const LAS bf16x8*)(RgS + (tbw * 16 + l15) * LD + ks * 32 + kq * 8), a1);
                    a2 = mfma16(*(const LAS bf16x8*)(PT + (ibw * 16 + l15) * LD + ks * 32 + kq * 8), *(const LAS bf16x8*)(ArS + (tbw * 16 + l15) * LD + ks * 32 + kq * 8), a2);
                }
                const f32x4 yl = (f32x4){bf2f(ycur.x & 0xffffu), bf2f(ycur.x >> 16), bf2f(ycur.y & 0xffffu), bf2f(ycur.y >> 16)};
                *(f32x4*)(YRAW + (size_t)(R0 + tbw * 16 + l15) * 1024 + h * 64 + ih * 32 + ibw * 16 + kq * 4) = a1 - a2 + yl;
            }
            {   f32x4 a3 = mfma16(*(const LAS bf16x8*)(BtS + (cbw * 16 + l15) * LD + kq * 8), *(const LAS bf16x8*)(PT + (ibw * 16 + l15) * LD + kq * 8), (f32x4){0.f, 0.f, 0.f, 0.f});
                a3 = mfma16(*(const LAS bf16x8*)(BtS + (cbw * 16 + l15) * LD + 32 + kq * 8), *(const LAS bf16x8*)(PT + (ibw * 16 + l15) * LD + 32 + kq * 8), a3);
                M = gcur * (M - a3 + kvcur);
                *(LAS u32x2*)(MTn + (ibw * 16 + l15) * LD + cbw * 16 + kq * 4) = (u32x2){pk2(M[0], M[1]), pk2(M[2], M[3])};
            }
        }
#undef RW_PREFETCH
        *(f32x4*)((p.out + Z) + O_PWKV + (((size_t)il * NBP + b) * 16 + h) * 4096 + (size_t)(ih * 32 + ibw * 16 + l15) * 64 + cbw * 16 + kq * 4) = M;
    }
}

__device__ __forceinline__ void phase_rwkv_step(const P& p, int il, int rot) {
    const int Z = zero_();
    const int tid = TIDX, i = tid >> 3, jq = tid & 7;
    const float* SCB = (const float*)((p.ws + Z) + WS_MIX + MX_SCB); const float* C123 = (const float*)((p.ws + Z) + WS_MIX + MX_C123);
    float* YRAW = (float*)((p.ws + Z) + WS_MIX + MX_YRAW);
    for (int u = (blockIdx.x + rot) % gridDim.x; u < NBS * 16; u += gridDim.x) {
        const int b = u >> 4, h = u & 15, R = MP + b;
        const float* st = SCB + ((size_t)h * MV + R) * 384 + jq * 8;
        const float* s0 = p.in[Z + I_SWKV] + (((size_t)il * NBS + b) * 16 + h) * 4096 + i * 64 + jq * 8;
        float* so = (p.out + Z) + O_SWKV + (((size_t)il * NBS + b) * 16 + h) * 4096 + i * 64 + jq * 8;
        const f32x4 cc = *(const f32x4*)(C123 + ((size_t)R * 16 + h) * 4);
        const float vi = SCB[((size_t)h * MV + R) * 384 + 320 + i];
        float sa = 0.f, sr = 0.f; f32x4 S[2], kk[2], w[2], ka[2], kp[2], r[2];
#pragma unroll
        for (int q = 0; q < 2; ++q) { S[q] = *(const f32x4*)(s0 + q * 4); kk[q] = *(const f32x4*)(st + q * 4); const f32x4 lw = *(const f32x4*)(st + 64 + q * 4);
            w[q] = (f32x4){fexp_(lw.x), fexp_(lw.y), fexp_(lw.z), fexp_(lw.w)}; ka[q] = *(const f32x4*)(st + 128 + q * 4); kp[q] = *(const f32x4*)(st + 192 + q * 4); r[q] = *(const f32x4*)(st + 256 + q * 4);
            sa += S[q].x * kk[q].x + S[q].y * kk[q].y + S[q].z * kk[q].z + S[q].w * kk[q].w;
            sr += S[q].x * w[q].x * r[q].x + S[q].y * w[q].y * r[q].y + S[q].z * w[q].z * r[q].z + S[q].w * w[q].w * r[q].w; }
        sa = allreduce8(sa); sr = allreduce8(sr);
#pragma unroll
        for (int q = 0; q < 2; ++q) *(f32x4*)(so + q * 4) = S[q] * w[q] - ka[q] * sa + kp[q] * vi;
        if (jq == 0) YRAW[(size_t)R * 1024 + h * 64 + i] = sr - sa * cc.x + vi * cc.y;
    }
}

#define PG8_ALIGN true
#define PG8_SP2 true
template <class Epi> __device__ __forceinline__ void run_gemm(LAS unsigned char* lds, const bf16_t* A, const bf16_t* Bt, int M, int N, int K, const Epi& E) {
    pg8::Gemm g{A, Bt, M, N, K, K}; pg8::StaticOrder S; S.init(M, N, (int)gridDim.x, (int)blockIdx.x);
    pg8::gemm_phase<Epi, pg8::StaticOrder, PG8_ALIGN, PG8_SP2>(lds, g, S, E);
}
__device__ __forceinline__ void run_gemm_split(const P& p, int Z, LAS unsigned char* lds, const bf16_t* A, const bf16_t* Bt, int K) {
    pg8::Gemm g{A, Bt, MPAD, D, 512, K}; pg8::SplitOrder S; S.init(32, 8, K / 512, 512, (int)gridDim.x, (int)((blockIdx.x + 96) % gridDim.x));
    pg8::EpiSlab E{(float*)((p.ws + Z) + WS_SLAB), 512};
    pg8::gemm_phase<pg8::EpiSlab, pg8::SplitOrder, PG8_ALIGN, PG8_SP2>(lds, g, S, E);
}
__device__ __forceinline__ void phase_gemm_mod(const P& p, LAS unsigned char* lds, int l_lo, int l_hi) {
    const int Z = zero_();
    pg8::EpiF32 E{(float*)((p.ws + Z) + WS_MOD) + (size_t)l_lo * 12288, MODLD, p.in[Z + I_BMOD] + (size_t)l_lo * 12288};
    run_gemm(lds, (const bf16_t*)((p.ws + Z) + WS_SC), (const bf16_t*)((p.ws + Z) + WS_WMOD) + (size_t)l_lo * 12288 * D, 256, (l_hi - l_lo) * 12288, D, E);
}
__device__ __forceinline__ void phase_mod_direct(const P& p, LAS unsigned char* lds) {
    const int Z = zero_();
    const int tid = TIDX, lane = tid & 63, wave = tid >> 6, i16 = lane & 15, g = lane >> 4;
    const bf16_t* SC = (const bf16_t*)((p.ws + Z) + WS_SC);
    float* MOD = (float*)((p.ws + Z) + WS_MOD);
    LAS bf16_t* As = (LAS bf16_t*)lds;
    constexpr int ALD = 520, NITEM = MODLD / 32;
    const int per_wg = (NITEM + (int)gridDim.x - 1) / (int)gridDim.x;
    const int lo = (int)blockIdx.x * per_wg, hi = lo + per_wg < NITEM ? lo + per_wg : NITEM;
#pragma unroll 1
    for (int base = lo; base < hi; base += 8) {
        const int item = base + wave; const bool act = item < hi;
        const int ng = (act ? item : lo) * 32, l = ng / 12288, nl = ng - l * 12288;
        const float* Wp = p.in[Z + I_WMOD] + (size_t)l * 2048 * 12288 + nl + 2 * i16 + (size_t)(8 * g) * 12288;
        f32x4 acc[9][2];
#pragma unroll
        for (int mt = 0; mt < 9; ++mt) { acc[mt][0] = (f32x4){0.f, 0.f, 0.f, 0.f}; acc[mt][1] = (f32x4){0.f, 0.f, 0.f, 0.f}; }
        f32x2 w0[8], w1[8];
        if (act) {
#pragma unroll
            for (int j = 0; j < 8; ++j) { w0[j] = *(const f32x2*)(Wp + (size_t)j * 12288); w1[j] = *(const f32x2*)(Wp + (size_t)(32 + j) * 12288); }
        }
        auto step = [&](f32x2 (&w)[8], int s, int sl) {
            const u32x4 p0 = (u32x4){pk2(w[0].x, w[1].x), pk2(w[2].x, w[3].x), pk2(w[4].x, w[5].x), pk2(w[6].x, w[7].x)};
            const u32x4 p1 = (u32x4){pk2(w[0].y, w[1].y), pk2(w[2].y, w[3].y), pk2(w[4].y, w[5].y), pk2(w[6].y, w[7].y)};
            const bf16x8 b0 = __builtin_bit_cast(bf16x8, p0), b1 = __builtin_bit_cast(bf16x8, p1);
            if (s + 2 < 64) {
#pragma unroll
                for (int j = 0; j < 8; ++j) w[j] = *(const f32x2*)(Wp + (size_t)((s + 2) * 32 + j) * 12288);
            }
            __builtin_amdgcn_sched_barrier(0);
#pragma unroll
            for (int mt = 0; mt < 9; ++mt) { const bf16x8 a = *(const LAS bf16x8*)(As + (mt * 16 + i16) * ALD + sl * 32 + 8 * g);
                acc[mt][0] = mfma16(a, b0, acc[mt][0]); acc[mt][1] = mfma16(a, b1, acc[mt][1]); }
        };
#pragma unroll 1
        for (int kc = 0; kc < 4; ++kc) {
            LDS_BARRIER();
            for (int q = tid; q < 144 * 64; q += NT) { const int row = q >> 6, c8 = q & 63; *(LAS u32x4*)(As + row * ALD + c8 * 8) = *(const u32x4*)(SC + (size_t)row * D + kc * 512 + c8 * 8); }
            LDS_BARRIER();
            if (act) {
#pragma unroll 1
                for (int s2 = 0; s2 < 16; s2 += 2) { step(w0, kc * 16 + s2, s2); step(w1, kc * 16 + s2 + 1, s2 + 1); }
            }
        }
        if (act) {
            const f32x2 bv = *(const f32x2*)(p.in[Z + I_BMOD] + ng + 2 * i16);
            float* mp = MOD + ng + 2 * i16;
#pragma unroll
            for (int mt = 0; mt < 9; ++mt)
#pragma unroll
                for (int r = 0; r < 4; ++r) *(f32x2*)(mp + (size_t)(mt * 16 + 4 * g + r) * MODLD) = (f32x2){acc[mt][0][r] + bv.x, acc[mt][1][r] + bv.y};
            for (int rr = 144 + g; rr < 256; rr += 4) *(f32x2*)(mp + (size_t)rr * MODLD) = bv;
        }
    }
}
__device__ __forceinline__ void phase_gemm_inab(const P& p, int il, LAS unsigned char* lds) {
    const int Z = zero_();
    pg8::EpiBf16Store E{(bf16_t*)((p.ws + Z) + WS_PROJ), PAB_PAD};
    run_gemm(lds, (const bf16_t*)((p.ws + Z) + WS_H), (const bf16_t*)((p.ws + Z) + WS_WINAB) + (size_t)il * PAB_PAD * D, MPAD, PAB_PAD, D, E);
}
constexpr size_t CTL_STATS = 65536;
__device__ __forceinline__ pg8::EpiResidNorm make_resid_norm(const P& p, int Z, int layer, int slot, const float* xin, int gi, int nl, int nwhich, bool fuse) {
    float* st = (float*)((p.ws + Z) + WS_CTL + CTL_STATS) + (size_t)gi * (8192 + 2048);
    return pg8::EpiResidNorm{(float*)((p.ws + Z) + WS_X), (const float*)((p.ws + Z) + WS_MOD) + (size_t)layer * 12288 + (size_t)slot * D, xin, (bf16_t*)((p.ws + Z) + WS_H),
                             p.in[Z + (nwhich ? I_NFFN : I_NMIX)] + (size_t)nl * D, (const float*)((p.ws + Z) + WS_MOD) + (size_t)nl * 12288 + (nwhich ? 3 * D : 0), st, (unsigned*)(st + 8192), fuse};
}
__device__ __forceinline__ void phase_gemm_outab(const P& p, int layer, LAS unsigned char* lds, bool fuse) {
    const int Z = zero_();
    pg8::EpiResidNorm E = make_resid_norm(p, Z, layer, 2, layer == 0 ? p.in[Z + I_XP] : (const float*)((p.ws + Z) + WS_X), layer * 2, layer, 1, fuse);
    run_gemm_split(p, Z, lds, (const bf16_t*)((p.ws + Z) + WS_YE), (const bf16_t*)((p.ws + Z) + WS_WOUTAB) + (size_t)(layer >> 1) * D * D, D);
    run_gemm(lds, (const bf16_t*)((p.ws + Z) + WS_YE), (const bf16_t*)((p.ws + Z) + WS_WOUTAB) + (size_t)(layer >> 1) * D * D, MP, D, D, E);
}
__device__ __forceinline__ void phase_gemm_inc(const P& p, int ic, LAS unsigned char* lds) {
    const int Z = zero_();
    pg8::EpiBf16Store E{(bf16_t*)((p.ws + Z) + WS_PROJ), PC_PAD};
    run_gemm(lds, (const bf16_t*)((p.ws + Z) + WS_H), (const bf16_t*)((p.ws + Z) + WS_WINC) + (size_t)ic * PC_PAD * D, MPAD, PC_PAD, D, E);
}
__device__ __forceinline__ void phase_gemm_outc(const P& p, int layer, LAS unsigned char* lds, bool fuse) {
    const int Z = zero_();
    pg8::EpiResidNorm E = make_resid_norm(p, Z, layer, 2, (const float*)((p.ws + Z) + WS_X), layer * 2, layer, 1, fuse);
    run_gemm_split(p, Z, lds, (const bf16_t*)((p.ws + Z) + WS_YO), (const bf16_t*)((p.ws + Z) + WS_WOUTC) + (size_t)(layer >> 1) * D * 4096, 4096);
    run_gemm(lds, (const bf16_t*)((p.ws + Z) + WS_YO), (const bf16_t*)((p.ws + Z) + WS_WOUTC) + (size_t)(layer >> 1) * D * 4096, MP, D, 4096, E);
}
__device__ __forceinline__ void phase_gemm_gate(const P& p, int layer, LAS unsigned char* lds) {
    const int Z = zero_();
    pg8::EpiBf16Store E{(bf16_t*)((p.ws + Z) + WS_GBUF), DFF};
    run_gemm(lds, (const bf16_t*)((p.ws + Z) + WS_H), (const bf16_t*)((p.ws + Z) + WS_WGATE) + (size_t)layer * DFF * D, MPAD, DFF, D, E);
}
__device__ __forceinline__ void phase_gemm_up(const P& p, int layer, LAS unsigned char* lds) {
    const int Z = zero_();
    pg8::EpiFfnUp E{(bf16_t*)((p.ws + Z) + WS_ACT), (const bf16_t*)((p.ws + Z) + WS_GBUF), p.in[Z + I_FCW] + (size_t)layer * 3 * DFF, p.in[Z + I_FCB] + (size_t)layer * DFF, p.in[Z + I_SFFNC] + (size_t)layer * NBS * 2 * DFF};
    run_gemm(lds, (const bf16_t*)((p.ws + Z) + WS_H), (const bf16_t*)((p.ws + Z) + WS_WUP) + (size_t)layer * DFF * D, MPAD, DFF, D, E);
}
__device__ __forceinline__ void phase_gemm_down(const P& p, int layer, LAS unsigned char* lds, bool fuse) {
    const int Z = zero_();
    pg8::EpiResidNorm E = make_resid_norm(p, Z, layer, 5, (const float*)((p.ws + Z) + WS_X), layer * 2 + 1, layer < 3 ? layer + 1 : 3, 0, fuse && layer < 3);
    run_gemm_split(p, Z, lds, (const bf16_t*)((p.ws + Z) + WS_ACT), (const bf16_t*)((p.ws + Z) + WS_WDOWN) + (size_t)layer * D * DFF, DFF);
    run_gemm(lds, (const bf16_t*)((p.ws + Z) + WS_ACT), (const bf16_t*)((p.ws + Z) + WS_WDOWN) + (size_t)layer * D * DFF, MP, D, DFF, E);
}

#define XB_TMO      128
#define XB_XCNT(j)  (256  + 64 * (j))
#define XB_XSUB(j)  (1280 + 64 * (j))
#define XB_XGEN(j)  (2304 + 64 * (j))
#define XB_TOP      3328
#define XB_TOPGEN   3392
#define XCD_BAR_WORDS 3456
#define XB_SPIN_CAP (1u << 18)
#define LAS __attribute__((address_space(3)))

__device__ __forceinline__ unsigned xb_ld(unsigned* p)              { return __hip_atomic_load(p, __ATOMIC_RELAXED, __HIP_MEMORY_SCOPE_AGENT); }
__device__ __forceinline__ unsigned xb_add(unsigned* p, unsigned v) { return __hip_atomic_fetch_add(p, v, __ATOMIC_RELAXED, __HIP_MEMORY_SCOPE_AGENT); }
__device__ __forceinline__ unsigned xb_xcc_id() { return (unsigned)__builtin_amdgcn_s_getreg((3 << 11) | 20) & 0xFu; }
#define XB_SPIN(cond, bar) do { unsigned _sp = 0; while (cond) { __builtin_amdgcn_s_sleep(1); \
    if ((++_sp & 255u) == 0u) { if (xb_ld(&(bar)[XB_TMO])) break; if (_sp > XB_SPIN_CAP) { atomicAdd(&(bar)[XB_TMO], 1u); break; } } } } while (0)

struct XcdBarrier {
    unsigned* bar; unsigned x;
    volatile LAS unsigned* st;
};

__device__ __forceinline__ XcdBarrier xcd_barrier_post(unsigned* bar, volatile LAS unsigned* st) {
    XcdBarrier b; b.bar = bar; b.x = xb_xcc_id(); b.st = st;
    if (threadIdx.x == 0) (void)xb_add(&bar[XB_XCNT(b.x)], 1u);
    return b;
}
__device__ __forceinline__ void xcd_barrier_complete(unsigned* bar, unsigned x, unsigned& nloc, unsigned& nx) {
    const unsigned G = gridDim.x * gridDim.y * gridDim.z;
    unsigned sum, cnt, mine, sp = 0u;
    for (;;) {
        sum = 0u; cnt = 0u; mine = 0u;
#pragma unroll
        for (unsigned j = 0; j < 16; ++j) { const unsigned c = xb_ld(&bar[XB_XCNT(j)]); sum += c; cnt += (c > 0u) ? 1u : 0u; mine = (j == x) ? c : mine; }
        if (sum == G) break;
        __builtin_amdgcn_s_sleep(1);
        if ((++sp & 255u) == 0u) { if (xb_ld(&bar[XB_TMO])) break; if (sp > XB_SPIN_CAP) { atomicAdd(&bar[XB_TMO], 1u); break; } }
    }
    nloc = mine > 0u ? mine : 1u; nx = cnt > 0u ? cnt : 1u;
}

__device__ __forceinline__ void xcd_barrier(const XcdBarrier& b) {
    asm volatile("s_waitcnt vmcnt(0)" ::: "memory");
    __syncthreads();
    if (threadIdx.x == 0) {
        unsigned* bar = b.bar;
        __builtin_amdgcn_s_waitcnt(0);
        unsigned nloc = b.st[0], nx = b.st[1];
        if (nloc == 0u) { xcd_barrier_complete(bar, b.x, nloc, nx); b.st[0] = nloc; b.st[1] = nx; }
        const unsigned old = xb_add(&bar[XB_XSUB(b.x)], 1u);
        const unsigned gen = old / nloc;
        if (old + 1u == (gen + 1u) * nloc) {
            __builtin_amdgcn_fence(__ATOMIC_RELEASE, "agent");
            asm volatile("s_waitcnt vmcnt(0)" ::: "memory");
            const unsigned og = xb_add(&bar[XB_TOP], 1u);
            const unsigned tg = og / nx;
            if (og + 1u == (tg + 1u) * nx) xb_add(&bar[XB_TOPGEN], 1u);
            else XB_SPIN(xb_ld(&bar[XB_TOPGEN]) == tg, bar);
            __builtin_amdgcn_fence(__ATOMIC_ACQUIRE, "agent");
            xb_add(&bar[XB_XGEN(b.x)], 1u);
            asm volatile("s_waitcnt vmcnt(0)" ::: "memory");
        } else {
            XB_SPIN(xb_ld(&bar[XB_XGEN(b.x)]) == gen, bar);
            __builtin_amdgcn_fence(__ATOMIC_ACQUIRE, "agent");
            asm volatile("s_waitcnt vmcnt(0)" ::: "memory");
        }
    }
    __syncthreads();
}

__device__ __forceinline__ void phase_lru_apply2(const P& p, int il, int rot) {
    const int Z = zero_();
    const int tid = TIDX;
    const bf16_t* proj = (const bf16_t*)((p.ws + Z) + WS_PROJ);
    const float* LA = (const float*)((p.ws + Z) + WS_MIX + MX_LA); const float* LB = (const float*)((p.ws + Z) + WS_MIX + MX_LB);
    const float* HL = (const float*)((p.ws + Z) + WS_MIX + MX_HL); const float* PP = (const float*)((p.ws + Z) + WS_MIX + MX_PP);
    const float* HEND = (const float*)((p.ws + Z) + WS_MIX + MX_HEND); const float* PEND = (const float*)((p.ws + Z) + WS_MIX + MX_PEND);
    bf16_t* YE = (bf16_t*)((p.ws + Z) + WS_YE);
    for (int u = (blockIdx.x + rot) % gridDim.x; u < 256; u += gridDim.x) {
        const int chn = u >> 1, c = (u & 1) * 512 + tid, b = chn >> 5, n = chn & 31;
        float cr = 0.f;
        for (int m = 0; m < n; ++m) { const size_t o = (size_t)(b * 32 + m) * 1024 + c; cr = HEND[o] + PEND[o] * cr; }
        if (n == 31) { const size_t o = (size_t)(b * 32 + 31) * 1024 + c; (p.out + Z)[O_PLRUH + ((size_t)il * NBP + b) * 1024 + c] = HEND[o] + PEND[o] * cr; }
        float h = cr;
        float a[8], bb[8], gg[8], an[8], bn[8], gn[8];
#pragma unroll
        for (int k = 0; k < 8; ++k) { const size_t R = (size_t)chn * 64 + k; a[k] = LA[R * 1024 + c]; bb[k] = LB[R * 1024 + c]; gg[k] = ldb1(proj + R * PLD_E + GATE_OFF + c); }
#pragma unroll 1
        for (int t0 = 0; t0 < 64; t0 += 8) {
            if (t0 + 8 < 64) {
#pragma unroll
                for (int k = 0; k < 8; ++k) { const size_t R = (size_t)chn * 64 + t0 + 8 + k; an[k] = LA[R * 1024 + c]; bn[k] = LB[R * 1024 + c]; gn[k] = ldb1(proj + R * PLD_E + GATE_OFF + c); }
            }
#pragma unroll
            for (int k = 0; k < 8; ++k) { const size_t R = (size_t)chn * 64 + t0 + k; h = a[k] * h + bb[k]; YE[R * D + 1024 + c] = (bf16_t)f2bf(h * gelu_tanh_(gg[k])); }
#pragma unroll
            for (int k = 0; k < 8; ++k) { a[k] = an[k]; bb[k] = bn[k]; gg[k] = gn[k]; }
        }
    }
    for (int i = blockIdx.x * NT + tid; i < NBS * 256; i += gridDim.x * NT) {
        const int b = i >> 8, c = (i & 255) * 4; const size_t R = (size_t)MP + b;
        const f32x4 h = *(const f32x4*)(LB + R * 1024 + c) + *(const f32x4*)(LA + R * 1024 + c) * *(const f32x4*)(p.in[Z + I_SLRUH] + ((size_t)il * NBS + b) * 1024 + c);
        *(f32x4*)((p.out + Z) + O_SLRUH + ((size_t)il * NBS + b) * 1024 + c) = h;
        const f32x4 g = ldb4(proj + R * PLD_E + GATE_OFF + c);
        *(u32x2*)(YE + R * D + 1024 + c) = (u32x2){pk2(h.x * gelu_tanh_(g.x), h.y * gelu_tanh_(g.y)), pk2(h.z * gelu_tanh_(g.z), h.w * gelu_tanh_(g.w))};
    }
}

constexpr int CW_BAR = 4096;
constexpr int XB_LDS_OFF = LDS_BYTES - 16;

__global__ void __launch_bounds__(NT, 2) fwd_kernel(P p) {
    extern __shared__ __attribute__((aligned(16))) unsigned char smem[];
    LAS unsigned char* lds = (LAS unsigned char*)smem;
    if (threadIdx.x == 0) *(LAS u32x4*)(lds + XB_LDS_OFF) = (u32x4){0u, 0u, 0u, 0u};
    __syncthreads();
    (void)xcd_barrier_post((unsigned*)((p.ws + zero_()) + WS_CTL) + CW_BAR, (volatile LAS unsigned*)(lds + XB_LDS_OFF));
#define GRID_BAR() do { XcdBarrier b2; b2.bar = (unsigned*)((p.ws + zero_()) + WS_CTL) + CW_BAR; unsigned xx = xb_xcc_id(); asm volatile("" : "+s"(xx)); b2.x = xx; b2.st = (volatile LAS unsigned*)(lds + XB_LDS_OFF); xcd_barrier(b2); } while (0)

    const bool fuse = gridDim.x >= 256;
    phase_init(p);
    phase_convert_small(p);
    phase_convert(p, lds, 1, 6, 0, (int)gridDim.x);
    phase_convert(p, lds, 7, 11, 0, (int)gridDim.x);
    phase_convert(p, lds, 14, 19, 0, (int)gridDim.x);
    phase_convert(p, lds, 20, 24, 0, (int)gridDim.x);
    GRID_BAR();
    phase_mod_direct(p, lds);
    GRID_BAR();
#pragma unroll 1
    for (int layer = 0; layer < 4; ++layer) {
        const int il = layer >> 1;
        phase_norm(p, layer, 0, layer > 0 ? 11 : 0, layer - 1, 5, layer == 0, lds, fuse && layer > 0);
        GRID_BAR();
        if ((layer & 1) == 0) {
            phase_gemm_inab(p, il, lds);
            GRID_BAR();
            phase_rwkv_prep(p, il, lds);
            phase_lru_gates(p, il, lds, 16);
            phase_states_even(p, il);
            GRID_BAR();
            phase_rwkv_chunk(p, il);
            GRID_BAR();
            phase_rwkv_wy(p, lds);
            phase_rwkv_step(p, il, 128);
            phase_lru_local(p, 64);
            GRID_BAR();
            phase_rwkv_rec(p, il, lds);
            phase_convert(p, lds, layer == 0 ? 6 : 19, layer == 0 ? 7 : 20, (int)gridDim.x / 2, (int)gridDim.x / 2);
            GRID_BAR();
            phase_rwkv_post(p, il);
            phase_lru_apply2(p, il, 0);
            GRID_BAR();
            phase_gemm_outab(p, layer, lds, fuse);
        } else {
            phase_gemm_inc(p, il, lds);
            GRID_BAR();
            phase_gdn_prep(p, il, lds);
            phase_states_odd(p, il);
            GRID_BAR();
            phase_gdn_wy(p, lds);
            phase_gdn_step(p, il, lds);
            GRID_BAR();
            phase_gdn_scan(p, il, lds);
            GRID_BAR();
            phase_gdn_post(p, il);
            GRID_BAR();
            phase_gemm_outc(p, layer, lds, fuse);
        }
        GRID_BAR();
        phase_norm(p, layer, 1, (layer & 1) ? 8 : 4, layer, 2, layer == 0, lds, fuse);
        GRID_BAR();
        phase_gemm_gate(p, layer, lds);
        GRID_BAR();
        phase_gemm_up(p, layer, lds);
        phase_states_ffn(p, layer);
        GRID_BAR();
        phase_gemm_down(p, layer, lds, fuse);
        GRID_BAR();
    }
    phase_final_norm(p, lds);
}

extern "C" void kernel_launch(void* const* d_in, const int* in_sizes, int n_in, void* d_out, int out_size, void* d_ws, size_t ws_size, hipStream_t stream) {
    static int grid = 0;
    if (grid == 0) {
        if (n_in != N_IN || (size_t)out_size != O_TOTAL || ws_size < WS_END) { fprintf(stderr, "kernel_launch: unexpected shapes (n_in %d, out %d, ws %zu need %zu)\n", n_in, out_size, ws_size, (size_t)WS_END); grid = -1; return; }
        int dev = 0, cus = 0, per_cu = 0;
        if (hipGetDevice(&dev) != hipSuccess || hipDeviceGetAttribute(&cus, hipDeviceAttributeMultiprocessorCount, dev) != hipSuccess) { grid = -1; return; }
        if (hipFuncSetAttribute((const void*)fwd_kernel, hipFuncAttributeMaxDynamicSharedMemorySize, LDS_BYTES) != hipSuccess) { fprintf(stderr, "kernel_launch: hipFuncSetAttribute failed\n"); grid = -1; return; }
        if (hipOccupancyMaxActiveBlocksPerMultiprocessor(&per_cu, (const void*)fwd_kernel, NT, LDS_BYTES) != hipSuccess || per_cu < 1) fprintf(stderr, "kernel_launch: occupancy query reports %d workgroups per CU\n", per_cu);
        (void)hipGetLastError();
        grid = cus;
    }
    if (grid < 0) return;
    (void)hipMemsetAsync((char*)d_ws + WS_CTL, 0, CTL_BYTES, stream);
    P p{};
    for (int i = 0; i < N_IN; ++i) p.in[i] = (const float*)d_in[i];
    p.out = (float*)d_out; p.ws = (unsigned char*)d_ws;
    hipLaunchKernelGGL(fwd_kernel, dim3(grid), dim3(NT), LDS_BYTES, stream, p);
}
```

```cpp
#include <hip/hip_runtime.h>
#include <cstdio>
#include <cstdint>

#define GAS __attribute__((address_space(1)))
#define LAS __attribute__((address_space(3)))
typedef unsigned short bf16_t;
typedef short bf16x8 __attribute__((ext_vector_type(8)));
typedef float f32x4 __attribute__((ext_vector_type(4)));
typedef float f32x2 __attribute__((ext_vector_type(2)));
typedef unsigned u32x4 __attribute__((ext_vector_type(4)));
typedef unsigned u32x2 __attribute__((ext_vector_type(2)));

constexpr int D = 2048, SEQ = 2048, NBP = 4, NBS = 128;
constexpr int MP = NBP * SEQ;
constexpr int MV = MP + NBS;
constexpr int MPAD = 8448;
constexpr int NSEQ = NBP + NBS;
constexpr int PA = 3360, PAB = 5408, PAB_PAD = 5632, XB_OFF = 4384, GATE_OFF = 3360;
constexpr int PC = 12352, PC_PAD = 12544, QKV = 8192, Z_OFF = 8192, B_OFF = 12288, A_OFF = 12320;
constexpr int DFF = 5632;
constexpr int MODLD = 4 * 6 * D;

enum { I_XP = 0, I_XS, I_CP, I_CS, I_SWKV, I_SSHIFT, I_SLRUH, I_SLRUC, I_SGDN, I_SGDNC, I_SFFNC, I_WMOD, I_BMOD, I_NMIX, I_NFFN, I_NOUT,
       I_WINAB, I_WOUTAB, I_MU, I_W0, I_W2, I_A0, I_A2, I_G2, I_KK, I_KA, I_RK, I_GNW, I_GNB, I_LCW, I_LCB, I_LWA, I_LBA, I_LWX, I_LBX, I_LLAM,
       I_WINC, I_WOUTC, I_GCW, I_GALOG, I_GDTB, I_GNORM, I_FWG, I_FWU, I_FCW, I_FCB, I_FWD, N_IN };

constexpr size_t O_YP = 0, O_YS = 16777216, O_PWKV = 17039360, O_PSHIFT = 17563648, O_PLRUH = 17590528, O_PLRUC = 17598720, O_PGDN = 17623296,
                 O_PGDNC = 21817600, O_PFFNC = 22014208, O_SWKV = 22194432, O_SSHIFT = 38971648, O_SLRUH = 39831808, O_SLRUC = 40093952,
                 O_SGDN = 40880384, O_SGDNC = 175098112, O_SFFNC = 181389568, O_TOTAL = 187156736;

constexpr size_t al256(size_t x) { return (x + 255) & ~(size_t)255; }
constexpr size_t WS_CTL = 0, CTL_BYTES = 1 << 20;
constexpr size_t WS_WINAB = WS_CTL + CTL_BYTES;
constexpr size_t WS_WOUTAB = WS_WINAB + (size_t)2 * PAB_PAD * D * 2;
constexpr size_t WS_WINC = WS_WOUTAB + (size_t)2 * D * D * 2;
constexpr size_t WS_WOUTC = WS_WINC + (size_t)2 * PC_PAD * D * 2;
constexpr size_t WS_WGATE = WS_WOUTC + (size_t)2 * D * 4096 * 2;
constexpr size_t WS_WUP = WS_WGATE + (size_t)4 * DFF * D * 2;
constexpr size_t WS_WDOWN = WS_WUP + (size_t)4 * DFF * D * 2;
constexpr size_t WS_W2T = WS_WDOWN + (size_t)4 * D * DFF * 2;
constexpr size_t WS_A2T = WS_W2T + (size_t)2 * 1024 * 64 * 2;
constexpr size_t WS_G2T = WS_A2T + (size_t)2 * 1024 * 64 * 2;
constexpr size_t WS_WAT = WS_G2T + (size_t)2 * 1024 * 160 * 2;
constexpr size_t WS_WXT = WS_WAT + (size_t)2 * 16 * 64 * 64 * 2;
constexpr size_t WS_SC = WS_WXT + (size_t)2 * 16 * 64 * 64 * 2;
constexpr size_t WS_MOD = WS_SC + (size_t)256 * D * 2;
constexpr size_t WS_X = WS_MOD + (size_t)256 * MODLD * 4;
constexpr size_t WS_H = WS_X + (size_t)MPAD * D * 4;
constexpr size_t WS_PROJ = WS_H + (size_t)MPAD * D * 2;
constexpr size_t WS_YE = WS_PROJ + (size_t)MPAD * PC_PAD * 4;
constexpr size_t WS_YO = WS_YE + (size_t)MPAD * D * 2;
constexpr size_t WS_GBUF = WS_YO + (size_t)MPAD * 4096 * 2;
constexpr size_t WS_ACT = WS_GBUF + (size_t)MPAD * DFF * 4;
constexpr size_t WS_MIX = WS_ACT + (size_t)MPAD * DFF * 2;
constexpr size_t MX_SCB = 0;
constexpr size_t MX_GG = MX_SCB + (size_t)16 * MV * 384 * 4;
constexpr size_t MX_C123 = MX_GG + (size_t)MV * 1024 * 4;
constexpr size_t MX_YRAW = MX_C123 + (size_t)MV * 64 * 4;
constexpr size_t MX_LA = MX_YRAW + (size_t)MV * 1024 * 4;
constexpr size_t MX_LB = MX_LA + (size_t)MV * 1024 * 4;
constexpr size_t MX_HL = MX_LB + (size_t)MV * 1024 * 4;
constexpr size_t MX_PP = MX_HL + (size_t)MV * 1024 * 4;
constexpr size_t MX_HEND = MX_PP + (size_t)MV * 1024 * 4;
constexpr size_t MX_PEND = MX_HEND + (size_t)128 * 1024 * 4;
constexpr size_t MX_CARRY = MX_PEND + (size_t)128 * 1024 * 4;
constexpr size_t MX_EVEN_END = MX_CARRY + (size_t)128 * 1024 * 4;
constexpr size_t MX_QN = 0;
constexpr size_t MX_KN = MX_QN + (size_t)MPAD * D * 2;
constexpr size_t MX_KT = MX_KN + (size_t)MPAD * D * 2;
constexpr size_t MX_VT = MX_KT + (size_t)4 * 16 * 32 * 128 * 64 * 2;
constexpr size_t MX_VNAT = MX_VT + (size_t)4 * 32 * 32 * 128 * 64 * 2;
constexpr size_t MX_BETA = MX_VNAT + (size_t)128 * 4096 * 4;
constexpr size_t MX_GL = MX_BETA + (size_t)MV * 32 * 4;
constexpr size_t MX_U = MX_GL + (size_t)MV * 32 * 4;
constexpr size_t MX_W = MX_U + (size_t)4096 * 64 * 128 * 2;
constexpr size_t MX_O = MX_W + (size_t)4096 * 64 * 128 * 2;
constexpr size_t MX_ODD_END = MX_O + (size_t)MV * 4096 * 4;
constexpr size_t MX_SIZE = (MX_EVEN_END > MX_ODD_END ? MX_EVEN_END : MX_ODD_END);
constexpr size_t WS_SLAB = WS_MIX + MX_SIZE;
constexpr size_t WS_WMOD = WS_SLAB + (size_t)22 * 128 * 2048 * 4;
constexpr size_t WS_END = WS_WMOD + (size_t)MODLD * D * 2;
static_assert(WS_END <= (size_t)2147483648u, "workspace map exceeds 2 GiB");

constexpr int LDS_BYTES = 152 * 1024;
constexpr int NT = 512;

struct P { const float* in[N_IN]; float* out; unsigned char* ws; };

__device__ __forceinline__ float fexp_(float x) { return __builtin_amdgcn_exp2f(x * 1.4426950408889634f); }
__device__ __forceinline__ float flog_(float x) { return __builtin_amdgcn_logf(x) * 0.6931471805599453f; }
__device__ __forceinline__ float one_minus_exp_(float x) { const float s = -x * (1.f + x * (0.5f + x * (0.16666667f + x * (0.041666668f + x * 0.008333334f)))); return x > -0.25f ? s : 1.f - fexp_(x); }
__device__ __forceinline__ float bf2f(unsigned b) { return __uint_as_float(b << 16); }
typedef __bf16 bf16n2 __attribute__((ext_vector_type(2)));
__device__ __forceinline__ unsigned pk2(float lo, float hi) { const bf16n2 v = __builtin_convertvector((f32x2){lo, hi}, bf16n2); return __builtin_bit_cast(unsigned, v); }
__device__ __forceinline__ unsigned f2bf(float f) { return pk2(f, 0.f) & 0xffffu; }
__device__ __forceinline__ float sigmoid_(float x) { return __builtin_amdgcn_rcpf(1.f + fexp_(-x)); }
__device__ __forceinline__ float softplus_(float x) { return x > 15.f ? x : flog_(1.f + fexp_(x)); }
__device__ __forceinline__ float silu_(float x) { return x * sigmoid_(x); }
__device__ __forceinline__ float gelu_tanh_(float x) { const float u = 0.7978845608028654f * (x + 0.044715f * x * x * x); return x * sigmoid_(2.f * u); }
__device__ __forceinline__ float tanh_(float x) { return 1.f - 2.f * __builtin_amdgcn_rcpf(1.f + fexp_(2.f * x)); }
__device__ __forceinline__ float wave_sum(float v) {
#pragma unroll
    for (int o = 1; o < 64; o <<= 1) v += __shfl_xor(v, o);
    return v;
}
template <int CTRL> __device__ __forceinline__ float dpp_add(float v) {
    const int t = __builtin_amdgcn_update_dpp(0, __float_as_int(v), CTRL, 0xF, 0xF, true);
    return v + __int_as_float(t);
}
__device__ __forceinline__ float allreduce4(float v) { v = dpp_add<0xB1>(v); v = dpp_add<0x4E>(v); return v; }
__device__ __forceinline__ float allreduce8(float v) { v = allreduce4(v); v = dpp_add<0x141>(v); return v; }
__device__ __forceinline__ float allreduce16(float v) { v = allreduce8(v); v = dpp_add<0x140>(v); return v; }
__device__ __forceinline__ f32x4 mfma16(bf16x8 a, bf16x8 b, f32x4 c) { return __builtin_amdgcn_mfma_f32_16x16x32_bf16(a, b, c, 0, 0, 0); }
__device__ __forceinline__ int bidx_of(int r) { const int s = 4 + r - MP; return r < MP ? (r >> 11) : (s < 255 ? s : 255); }
__device__ __forceinline__ int tid_() { int t = threadIdx.x; asm volatile("" : "+v"(t)); return t; }
#define TIDX tid_()
__device__ __forceinline__ int zero_() { int z = 0; asm volatile("" : "+s"(z)); return z; }
__device__ __forceinline__ float ldb1(const bf16_t* q) { return bf2f(*q); }
__device__ __forceinline__ f32x2 ldb2(const bf16_t* q) { const unsigned u = *(const unsigned*)q; return (f32x2){__uint_as_float(u << 16), __uint_as_float(u & 0xffff0000u)}; }
__device__ __forceinline__ f32x4 ldb4(const bf16_t* q) { const u32x2 u = *(const u32x2*)q; return (f32x4){__uint_as_float(u.x << 16), __uint_as_float(u.x & 0xffff0000u), __uint_as_float(u.y << 16), __uint_as_float(u.y & 0xffff0000u)}; }
#define LDS_BARRIER() do { asm volatile("s_waitcnt lgkmcnt(0)" ::: "memory"); __builtin_amdgcn_s_barrier(); asm volatile("" ::: "memory"); } while (0)
__device__ __forceinline__ u32x4 zero4_() { unsigned z = 0u; asm volatile("" : "+v"(z)); return (u32x4){z, z, z, z}; }
namespace pg8 {
#define PG8_LAS __attribute__((address_space(3)))
typedef unsigned short bf16_t;
typedef short bf16x8 __attribute__((ext_vector_type(8)));
typedef float f32x4 __attribute__((ext_vector_type(4)));
typedef unsigned u32x4 __attribute__((ext_vector_type(4)));
constexpr int BM = 256, BK = 64, HALF = 128, HTB = HALF * BK * 2  , STAGE_BYTES = 8 * HTB, NXCD = 8, WGM = 8;

__host__ __device__ __forceinline__ int lds_byte(int r, int c) { const int st = (r >> 4) * 2 + (c >> 5), rr = r & 15, cc = c & 31, ob = rr * 64 + cc * 2; return st * 1024 + (ob ^ (((ob >> 9) & 1) << 5)); }
__host__ __device__ __forceinline__ void stage_rc(int b, int& R, int& C) { const int st = b / 1024, sb = b % 1024, swz = sb ^ (((sb >> 9) & 1) << 5); R = (st >> 1) * 16 + swz / 64; C = (st & 1) * 32 + (swz % 64) / 2; }
__host__ __device__ __forceinline__ int perm32(int rho) { const int n = rho >> 4, i = rho & 15; return 8 * (i >> 2) + 4 * n + (i & 3); }

struct Unit { int pm, pn, k0; };
struct Gemm { const bf16_t* A; const bf16_t* Bt; int M, N, K, ld; };

struct StaticOrder {
    int nM, nN, nwg, G, c;
    __host__ __device__ void init(int M, int N, int G_, int c_) { nM = M / BM; nN = N / BM; nwg = nM * nN; G = G_; c = c_; }
    __host__ __device__ bool next(int i, Unit& u) const {
        const long L = (long)i * G + c; if (L >= nwg) return false;
        int wgid = (int)L; { const int q = nwg / NXCD, r = nwg % NXCD, xcd = wgid % NXCD, off = wgid / NXCD; wgid = (xcd < r ? xcd * (q + 1) : r * (q + 1) + (xcd - r) * q) + off; }
        const int nig = WGM * nN, gid = wgid / nig, fm = gid * WGM, gsz = (nM - fm) < WGM ? (nM - fm) : WGM;
        u.pm = fm + ((wgid % nig) % gsz); u.pn = (wgid % nig) / gsz; u.k0 = 0; return true;
    }
    __device__ __forceinline__ void a_ready(const Unit&) const {}
    __device__ __forceinline__ void done(const Unit&) const {}
};

struct SplitOrder {
    int pm, nN, nsplit, ksplit, G, c;
    __host__ __device__ void init(int pm_, int nN_, int nsplit_, int ksplit_, int G_, int c_) { pm = pm_; nN = nN_; nsplit = nsplit_; ksplit = ksplit_; G = G_; c = c_; }
    __host__ __device__ bool next(int i, Unit& u) const { const int L = i * G + c; if (L >= nN * nsplit) return false; u.pm = pm; u.pn = L % nN; u.k0 = (L / nN) * ksplit; return true; }
    __device__ __forceinline__ void a_ready(const Unit&) const {}
    __device__ __forceinline__ void done(const Unit&) const {}
};

__device__ __forceinline__ unsigned cvt_pk_bf16(float lo, float hi) { unsigned r; asm volatile("v_cvt_pk_bf16_f32 %0, %1, %2" : "=v"(r) : "v"(lo), "v"(hi)); return r; }

struct EpiF32 {
    static constexpr bool PERM = false, AFTER_DRAIN = false;
    float* C; int ldc; const float* bias;
    __device__ __forceinline__ void operator()(const f32x4 (&acc)[2][2][4][2], const Unit& u, int wr, int wc, int fr, int fq) const {
        const int row0 = u.pm * BM + wr * 64 + fr, col0 = u.pn * BM + wc * 32 + 4 * fq;
        f32x4 bv[2][2];
#pragma unroll
        for (int bj = 0; bj < 2; ++bj)
#pragma unroll
            for (int n = 0; n < 2; ++n) bv[bj][n] = bias ? *(const f32x4*)(bias + col0 + bj * HALF + n * 16) : (f32x4){0.f, 0.f, 0.f, 0.f};
#pragma unroll
        for (int ai = 0; ai < 2; ++ai)
#pragma unroll
            for (int m = 0; m < 4; ++m) { float* rowp = C + (size_t)(row0 + ai * HALF + m * 16) * ldc + col0;
#pragma unroll
                for (int bj = 0; bj < 2; ++bj)
#pragma unroll
                    for (int n = 0; n < 2; ++n) *(f32x4*)(rowp + bj * HALF + n * 16) = acc[ai][bj][m][n] + bv[bj][n]; }
    }
};

struct EpiResid {
    static constexpr bool PERM = false, AFTER_DRAIN = false;
    float* X; const float* gate; const float* Xin;
    __device__ __forceinline__ void ld_row(int it, int row0, int col0, f32x4 (&g)[4], f32x4 (&x)[4]) const {
        const int r = row0 + (it >> 2) * HALF + (it & 3) * 16; const int s = 4 + r - 8192; const int bi = r < 8192 ? (r >> 11) : (s < 255 ? s : 255);
        const float* xi = Xin + (size_t)r * 2048 + col0; const float* gp = gate + (size_t)bi * 49152 + col0;
#pragma unroll
        for (int q = 0; q < 4; ++q) { const int o = (q >> 1) * HALF + (q & 1) * 16; g[q] = *(const f32x4*)(gp + o); x[q] = *(const f32x4*)(xi + o); }
    }
    __device__ __forceinline__ void operator()(const f32x4 (&acc)[2][2][4][2], const Unit& u, int wr, int wc, int fr, int fq) const {
        const int row0 = u.pm * BM + wr * 64 + fr, col0 = u.pn * BM + wc * 32 + 4 * fq;
        f32x4 g[4], x[4], gn[4], xn[4];
        ld_row(0, row0, col0, g, x);
#pragma unroll
        for (int it = 0; it < 8; ++it) {
            if (it < 7) ld_row(it + 1, row0, col0, gn, xn);
            const int ai = it >> 2, m = it & 3; float* xp = X + (size_t)(row0 + ai * HALF + m * 16) * 2048 + col0;
#pragma unroll
            for (int q = 0; q < 4; ++q) { const int bj = q >> 1, n = q & 1; *(f32x4*)(xp + bj * HALF + n * 16) = x[q] + g[q] * acc[ai][bj][m][n]; }
#pragma unroll
            for (int q = 0; q < 4; ++q) { g[q] = gn[q]; x[q] = xn[q]; }
        }
    }
};

struct EpiFfnUp {
    static constexpr bool PERM = true, AFTER_DRAIN = false;
    bf16_t* O; const bf16_t* G; const float* cw; const float* cb; const float* sbuf;
    static __device__ __forceinline__ void unpack8(const u32x4 q, f32x4& lo, f32x4& hi) {
        lo = (f32x4){__uint_as_float(q.x << 16), __uint_as_float(q.x & 0xffff0000u), __uint_as_float(q.y << 16), __uint_as_float(q.y & 0xffff0000u)};
        hi = (f32x4){__uint_as_float(q.z << 16), __uint_as_float(q.z & 0xffff0000u), __uint_as_float(q.w << 16), __uint_as_float(q.w & 0xffff0000u)}; }
    static __device__ __forceinline__ f32x4 act4(const f32x4 uu, const f32x4 a) {
        f32x4 o;
#pragma unroll
        for (int j = 0; j < 4; ++j) { const float x = uu[j]; const float z = x * (0.7978845608028654f + 0.035677408136300125f * x * x);
            o[j] = x * __builtin_amdgcn_rcpf(1.f + __builtin_amdgcn_exp2f(-2.885390081777927f * z)) * a[j]; }
        return o; }
    __device__ __forceinline__ void operator()(const f32x4 (&acc)[2][2][4][2], const Unit& u, int wr, int wc, int fr, int fq) const {
        const int row0 = u.pm * BM + wr * 64 + fr, col0 = u.pn * BM + wc * 32 + 8 * fq;
        const bool prompt = u.pm < 32;
#pragma unroll
        for (int bj = 0; bj < 2; ++bj) {
            const int c = col0 + bj * HALF;
            f32x4 w0[2], w1[2], w2[2], bb[2];
#pragma unroll
            for (int n = 0; n < 2; ++n) { w0[n] = *(const f32x4*)(cw + c + 4 * n); w1[n] = *(const f32x4*)(cw + 5632 + c + 4 * n); w2[n] = *(const f32x4*)(cw + 2 * 5632 + c + 4 * n); bb[n] = *(const f32x4*)(cb + c + 4 * n); }
            if (prompt) {
#pragma unroll
                for (int ai = 0; ai < 2; ++ai)
#pragma unroll
                    for (int m = 0; m < 4; ++m) {
                        const int r = row0 + ai * HALF + m * 16, t = r & 2047;
                        const bf16_t* g0p = G + (size_t)r * 5632 + c;
                        const u32x4 q0 = *(const u32x4*)g0p, q1 = *(const u32x4*)(g0p - (t >= 1 ? 5632 : 0)), q2 = *(const u32x4*)(g0p - (t >= 2 ? 2 * 5632 : 0));
                        f32x4 g0[2], g1[2], g2[2]; unpack8(q0, g0[0], g0[1]); unpack8(q1, g1[0], g1[1]); unpack8(q2, g2[0], g2[1]);
                        const float h1 = t >= 1 ? 1.f : 0.f, h2 = t >= 2 ? 1.f : 0.f;
                        const f32x4 o0 = act4(w0[0] * (g2[0] * h2) + w1[0] * (g1[0] * h1) + w2[0] * g0[0] + bb[0], acc[ai][bj][m][0]);
                        const f32x4 o1 = act4(w0[1] * (g2[1] * h2) + w1[1] * (g1[1] * h1) + w2[1] * g0[1] + bb[1], acc[ai][bj][m][1]);
                        u32x4 w; w.x = cvt_pk_bf16(o0[0], o0[1]); w.y = cvt_pk_bf16(o0[2], o0[3]); w.z = cvt_pk_bf16(o1[0], o1[1]); w.w = cvt_pk_bf16(o1[2], o1[3]);
                        *(u32x4*)(O + (size_t)r * 5632 + c) = w;
                    }
            } else {
#pragma unroll
                for (int ai = 0; ai < 2; ++ai)
#pragma unroll
                    for (int m = 0; m < 4; ++m) {
                        const int r = row0 + ai * HALF + m * 16, b = r - 8192; const bool hv = b < 128; const int bb_ = hv ? b : 0;
                        f32x4 g0[2]; unpack8(*(const u32x4*)(G + (size_t)r * 5632 + c), g0[0], g0[1]);
                        const float* s1 = sbuf + ((size_t)bb_ * 2 + 1) * 5632 + c; const float* s2 = sbuf + ((size_t)bb_ * 2 + 0) * 5632 + c;
                        const float hs = hv ? 1.f : 0.f;
                        const f32x4 o0 = act4(w0[0] * (*(const f32x4*)(s2) * hs) + w1[0] * (*(const f32x4*)(s1) * hs) + w2[0] * g0[0] + bb[0], acc[ai][bj][m][0]);
                        const f32x4 o1 = act4(w0[1] * (*(const f32x4*)(s2 + 4) * hs) + w1[1] * (*(const f32x4*)(s1 + 4) * hs) + w2[1] * g0[1] + bb[1], acc[ai][bj][m][1]);
                        u32x4 w; w.x = cvt_pk_bf16(o0[0], o0[1]); w.y = cvt_pk_bf16(o0[2], o0[3]); w.z = cvt_pk_bf16(o1[0], o1[1]); w.w = cvt_pk_bf16(o1[2], o1[3]);
                        *(u32x4*)(O + (size_t)r * 5632 + c) = w;
                    }
            }
        }
    }
};

struct EpiSlab {
    static constexpr bool PERM = false, AFTER_DRAIN = false;
    float* slab; int ksplit;
    __device__ __forceinline__ void operator()(const f32x4 (&acc)[2][2][4][2], const Unit& u, int wr, int wc, int fr, int fq) const {
        const int row0 = wr * 64 + fr, col0 = u.pn * BM + wc * 32 + 4 * fq;
        float* base = slab + (size_t)(u.k0 / ksplit) * (128 * 2048);
#pragma unroll
        for (int m = 0; m < 4; ++m) { float* rowp = base + (size_t)(row0 + m * 16) * 2048 + col0;
#pragma unroll
            for (int bj = 0; bj < 2; ++bj)
#pragma unroll
                for (int n = 0; n < 2; ++n) *(f32x4*)(rowp + bj * HALF + n * 16) = acc[0][bj][m][n]; }
    }
};

struct EpiBf16Store {
    static constexpr bool PERM = true, AFTER_DRAIN = false;
    bf16_t* O; int ldc;
    __device__ __forceinline__ void operator()(const f32x4 (&acc)[2][2][4][2], const Unit& u, int wr, int wc, int fr, int fq) const {
        const int row0 = u.pm * BM + wr * 64 + fr, col0 = u.pn * BM + wc * 32 + 8 * fq;
#pragma unroll
        for (int ai = 0; ai < 2; ++ai)
#pragma unroll
            for (int m = 0; m < 4; ++m) { bf16_t* rowp = O + (size_t)(row0 + ai * HALF + m * 16) * ldc + col0;
#pragma unroll
                for (int bj = 0; bj < 2; ++bj) { const f32x4 v0 = acc[ai][bj][m][0], v1 = acc[ai][bj][m][1];
                    u32x4 w; w.x = cvt_pk_bf16(v0[0], v0[1]); w.y = cvt_pk_bf16(v0[2], v0[3]); w.z = cvt_pk_bf16(v1[0], v1[1]); w.w = cvt_pk_bf16(v1[2], v1[3]);
                    *(u32x4*)(rowp + bj * HALF) = w; } }
    }
};
template <class Epi, class Sched, bool ALIGN_EPI = false, bool SP2 = false>
__device__ __forceinline__ void gemm_phase(PG8_LAS unsigned char* lds, const Gemm g, const Sched& S, const Epi& E) {
    const int tid = TIDX, wid = __builtin_amdgcn_readfirstlane(tid >> 6), lane = tid & 63, wr = wid >> 2, wc = wid & 3, fr = lane & 15, fq = lane >> 4;
    const int K = g.K, nt = K / BK;
    unsigned voffA[2], voffB[2];
#pragma unroll
    for (int i = 0; i < 2; ++i) { int R, C; stage_rc(tid * 16 + i * 8192, R, C); const int Rb = Epi::PERM ? ((R & ~31) + perm32(R & 31)) : R;
        voffA[i] = (unsigned)(R * g.ld + C) * 2u; voffB[i] = (unsigned)(Rb * g.ld + C) * 2u; }
    const size_t kstep = (size_t)(BK * 2);
    const size_t hstep = (size_t)HALF * g.ld * 2;
    const size_t tstep = 2 * hstep;
    const unsigned ldsw = (unsigned)wid * 1024u;
    const int aoff = lds_byte(wr * 64 + fr, fq * 8), boff = lds_byte(wc * 32 + fr, fq * 8);
#define PG8_SA(b, h) (((b) * 2 + (h)) * HTB)
#define PG8_SB(b, h) ((4 + (b) * 2 + (h)) * HTB)
#define PG8_STAGE(bufoff, gbase, voff) do { _Pragma("unroll") for (int _i = 0; _i < 2; ++_i) \
        __builtin_amdgcn_global_load_lds((const unsigned*)((const char*)(gbase) + (voff)[_i]), (PG8_LAS unsigned*)(lds + (bufoff) + ldsw + _i * 8192), 16, 0, 0); } while (0)
#define PG8_LDA(dst, b, h) do { _Pragma("unroll") for (int m = 0; m < 4; ++m) _Pragma("unroll") for (int k = 0; k < 2; ++k) dst[m][k] = *(const PG8_LAS bf16x8*)(lds + PG8_SA(b, h) + aoff + m * 2048 + k * 1024); } while (0)
#define PG8_LDB(dst, b, h) do { _Pragma("unroll") for (int n = 0; n < 2; ++n) _Pragma("unroll") for (int k = 0; k < 2; ++k) dst[n][k] = *(const PG8_LAS bf16x8*)(lds + PG8_SB(b, h) + boff + n * 2048 + k * 1024); } while (0)
#define PG8_MMA(ai, bj, At, Bt) do { __builtin_amdgcn_s_setprio(1); _Pragma("unroll") for (int m = 0; m < 4; ++m) _Pragma("unroll") for (int n = 0; n < 2; ++n) _Pragma("unroll") for (int k = 0; k < 2; ++k) \
        acc[ai][bj][m][n] = __builtin_amdgcn_mfma_f32_16x16x32_bf16(Bt[n][k], At[m][k], acc[ai][bj][m][n], 0, 0, 0); __builtin_amdgcn_s_setprio(0); } while (0)
#define PG8_WAIT_V(n) asm volatile("s_waitcnt vmcnt(" #n ")" ::: "memory")
#define PG8_WAIT_L(n) asm volatile("s_waitcnt lgkmcnt(" #n ")" ::: "memory")
#define PG8_BAR __builtin_amdgcn_s_barrier()
#define PG8_SCHED __builtin_amdgcn_sched_barrier(0)
    Unit cur, nxt; int ui = 0;
    if (!S.next(0, cur)) return;
    f32x4 acc[2][2][4][2];
#pragma unroll
    for (int a = 0; a < 2; ++a)
#pragma unroll
        for (int b = 0; b < 2; ++b)
#pragma unroll
            for (int m = 0; m < 4; ++m)
#pragma unroll
                for (int n = 0; n < 2; ++n) acc[a][b][m][n] = (f32x4){0.f, 0.f, 0.f, 0.f};
    bf16x8 At[4][2], B0[2][2], B1[2][2];
    const char* cA = (const char*)g.A + (size_t)cur.pm * tstep + (size_t)cur.k0 * 2; const char* cB = (const char*)g.Bt + (size_t)cur.pn * tstep + (size_t)cur.k0 * 2;
    S.a_ready(cur);
    if constexpr (SP2) {
        PG8_STAGE(PG8_SB(0, 0), cB, voffB); PG8_STAGE(PG8_SB(0, 1), cB + hstep, voffB); PG8_STAGE(PG8_SA(0, 0), cA, voffA); PG8_STAGE(PG8_SA(0, 1), cA + hstep, voffA);
        if (wr == 1) PG8_BAR;
        PG8_WAIT_V(2); PG8_BAR;
        PG8_STAGE(PG8_SB(1, 0), cB + kstep, voffB); PG8_STAGE(PG8_SA(1, 0), cA + kstep, voffA); PG8_STAGE(PG8_SB(1, 1), cB + hstep + kstep, voffB);
        PG8_WAIT_V(6); PG8_BAR;
    } else {
        PG8_STAGE(PG8_SB(0, 0), cB, voffB); PG8_STAGE(PG8_SA(0, 0), cA, voffA); PG8_STAGE(PG8_SB(0, 1), cB + hstep, voffB); PG8_STAGE(PG8_SA(0, 1), cA + hstep, voffA);
        if (wr == 1) PG8_BAR;
        PG8_WAIT_V(4); PG8_BAR;
        PG8_STAGE(PG8_SB(1, 0), cB + kstep, voffB); PG8_STAGE(PG8_SA(1, 0), cA + kstep, voffA); PG8_STAGE(PG8_SB(1, 1), cB + hstep + kstep, voffB);
        PG8_WAIT_V(6); PG8_BAR;
    }
    for (;;) {
        const bool has_next = S.next(ui + 1, nxt);
        const char* nA = has_next ? (const char*)g.A + (size_t)nxt.pm * tstep + (size_t)nxt.k0 * 2 : cA; const char* nB = has_next ? (const char*)g.Bt + (size_t)nxt.pn * tstep + (size_t)nxt.k0 * 2 : cB;
        for (int t = 0; t < nt; t += 2) {
            const bool last = (t == nt - 2);
            const char* a1 = cA + (size_t)(t + 1) * kstep;
            const char* a2 = last ? nA : cA + (size_t)(t + 2) * kstep; const char* b2 = last ? nB : cB + (size_t)(t + 2) * kstep;
            const char* a3 = a2 + kstep; const char* b3 = b2 + kstep;
            if (last && has_next) S.a_ready(nxt);
            if constexpr (SP2) {
            PG8_LDB(B0, 0, 0); PG8_LDB(B1, 0, 1); PG8_SCHED; PG8_LDA(At, 0, 0); PG8_STAGE(PG8_SA(1, 1), a1 + hstep, voffA);
            PG8_WAIT_V(8); PG8_WAIT_L(0); PG8_BAR; PG8_MMA(0, 0, At, B0); PG8_MMA(0, 1, At, B1); PG8_BAR; PG8_SCHED;
            PG8_LDA(At, 0, 1); PG8_STAGE(PG8_SB(0, 0), b2, voffB); PG8_STAGE(PG8_SB(0, 1), b2 + hstep, voffB); PG8_STAGE(PG8_SA(0, 0), a2, voffA);
            PG8_WAIT_V(8); PG8_WAIT_L(0); PG8_BAR; PG8_MMA(1, 0, At, B0); PG8_MMA(1, 1, At, B1); PG8_BAR; PG8_SCHED;
            PG8_LDB(B0, 1, 0); PG8_LDB(B1, 1, 1); PG8_SCHED; PG8_LDA(At, 1, 0); PG8_STAGE(PG8_SA(0, 1), a2 + hstep, voffA);
            PG8_WAIT_V(8); PG8_WAIT_L(0); PG8_BAR; PG8_MMA(0, 0, At, B0); PG8_MMA(0, 1, At, B1); PG8_BAR; PG8_SCHED;
            PG8_LDA(At, 1, 1); PG8_STAGE(PG8_SB(1, 0), b3, voffB); PG8_STAGE(PG8_SB(1, 1), b3 + hstep, voffB); PG8_STAGE(PG8_SA(1, 0), a3, voffA);
            PG8_WAIT_V(8); PG8_WAIT_L(0); PG8_BAR; PG8_MMA(1, 0, At, B0); PG8_MMA(1, 1, At, B1); PG8_BAR; PG8_SCHED;
            } else {
            PG8_LDB(B0, 0, 0); PG8_SCHED; PG8_LDA(At, 0, 0); PG8_STAGE(PG8_SA(1, 1), a1 + hstep, voffA);
            PG8_WAIT_L(8); PG8_BAR; PG8_WAIT_L(0); PG8_MMA(0, 0, At, B0); PG8_BAR; PG8_SCHED;
            PG8_LDB(B1, 0, 1); PG8_STAGE(PG8_SB(0, 0), b2, voffB);
            PG8_BAR; PG8_WAIT_L(0); PG8_MMA(0, 1, At, B1); PG8_BAR;
            PG8_LDA(At, 0, 1); PG8_STAGE(PG8_SA(0, 0), a2, voffA);
            PG8_BAR; PG8_WAIT_L(0); PG8_MMA(1, 0, At, B0); PG8_BAR; PG8_SCHED;
            PG8_STAGE(PG8_SB(0, 1), b2 + hstep, voffB);
            PG8_WAIT_V(6); PG8_BAR; PG8_MMA(1, 1, At, B1); PG8_BAR;
            PG8_LDB(B0, 1, 0); PG8_SCHED; PG8_LDA(At, 1, 0); PG8_STAGE(PG8_SA(0, 1), a2 + hstep, voffA);
            PG8_WAIT_L(8); PG8_BAR; PG8_WAIT_L(0); PG8_MMA(0, 0, At, B0); PG8_BAR; PG8_SCHED;
            PG8_LDB(B1, 1, 1); PG8_STAGE(PG8_SB(1, 0), b3, voffB);
            PG8_BAR; PG8_WAIT_L(0); PG8_MMA(0, 1, At, B1); PG8_BAR;
            PG8_LDA(At, 1, 1); PG8_STAGE(PG8_SA(1, 0), a3, voffA);
            PG8_BAR; PG8_WAIT_L(0); PG8_MMA(1, 0, At, B0); PG8_BAR; PG8_SCHED;
            PG8_STAGE(PG8_SB(1, 1), b3 + hstep, voffB);
            PG8_WAIT_V(6); PG8_BAR; PG8_MMA(1, 1, At, B1); PG8_BAR;
            }
        }
        if constexpr (ALIGN_EPI) { if (wr == 0) PG8_BAR; }
        if constexpr (!Epi::AFTER_DRAIN) { E(acc, cur, wr, wc, fr, fq); S.done(cur); }
        if (!has_next) break;
#pragma unroll
        for (int a = 0; a < 2; ++a)
#pragma unroll
            for (int b = 0; b < 2; ++b)
#pragma unroll
                for (int m = 0; m < 4; ++m)
#pragma unroll
                    for (int n = 0; n < 2; ++n) acc[a][b][m][n] = (f32x4){0.f, 0.f, 0.f, 0.f};
        cur = nxt; cA = nA; cB = nB; ++ui;
        if constexpr (ALIGN_EPI) { if (wr == 1) PG8_BAR; }
    }
    PG8_WAIT_V(0);
    if constexpr (!ALIGN_EPI) { if (wr == 0) PG8_BAR; }
    PG8_BAR;
    if constexpr (Epi::AFTER_DRAIN) { E.fused(acc, cur, wr, wc, fr, fq, lds, wid, lane); S.done(cur); }
#undef PG8_SA
#undef PG8_SB
#undef PG8_STAGE
#undef PG8_LDA
#undef PG8_LDB
#undef PG8_MMA
#undef PG8_WAIT_V
#undef PG8_WAIT_L
#undef PG8_BAR
#undef PG8_SCHED
}
}

#define LDS_WAIT() asm volatile("s_waitcnt lgkmcnt(0)" ::: "memory")

__device__ __forceinline__ void transpose_item(const float* __restrict__ W, int K, int N, bf16_t* __restrict__ WT, LAS float* scr, int item, int lane) {
    const int nblk = (N + 63) / 64, kb = item / nblk, nb = item % nblk, k0 = 64 * kb, n0 = 64 * nb;
    const int nq = (lane & 15) * 4, kr = lane >> 4;
    const bool ok = n0 + nq < N;
    f32x4 v[16];
#pragma unroll
    for (int i = 0; i < 16; ++i) v[i] = ok ? __builtin_nontemporal_load((const f32x4*)(W + (size_t)(k0 + 4 * i + kr) * N + n0 + nq)) : (f32x4){0.f, 0.f, 0.f, 0.f};
#pragma unroll
    for (int i = 0; i < 16; ++i) { const int k = 4 * i + kr;
        scr[(nq + 0) * 65 + k] = v[i].x; scr[(nq + 1) * 65 + k] = v[i].y; scr[(nq + 2) * 65 + k] = v[i].z; scr[(nq + 3) * 65 + k] = v[i].w; }
    LDS_WAIT(); asm volatile("" ::: "memory");
    const int kc = (lane & 7) * 8;
#pragma unroll
    for (int j = 0; j < 8; ++j) { const int n = (lane >> 3) + 8 * j; const LAS float* s = scr + n * 65 + kc;
        const u32x4 o = (u32x4){pk2(s[0], s[1]), pk2(s[2], s[3]), pk2(s[4], s[5]), pk2(s[6], s[7])};
        if (n0 + n < N) *(u32x4*)(WT + (size_t)(n0 + n) * K + k0 + kc) = o; }
    LDS_WAIT(); asm volatile("" ::: "memory");
}

struct CvtMat { int in_idx, K, N, Npad; size_t src_off, dst; };
#define CVT_E(idx, K, N, NP, mi, base, stride) {idx, K, N, NP, (size_t)(mi) * (K) * (N), (base) + (size_t)(mi) * (stride)}
__constant__ CvtMat c_mats[24] = {
    CVT_E(I_WMOD, 2048, 12288, 12288, 0, WS_WMOD, (size_t)12288 * 2048 * 2), CVT_E(I_WINAB, 2048, PAB, PAB_PAD, 0, WS_WINAB, (size_t)PAB_PAD * 2048 * 2), CVT_E(I_WOUTAB, 2048, 2048, 2048, 0, WS_WOUTAB, (size_t)2048 * 2048 * 2),
    CVT_E(I_FWG, 2048, DFF, DFF, 0, WS_WGATE, (size_t)DFF * 2048 * 2), CVT_E(I_FWU, 2048, DFF, DFF, 0, WS_WUP, (size_t)DFF * 2048 * 2), CVT_E(I_FWD, DFF, 2048, 2048, 0, WS_WDOWN, (size_t)DFF * 2048 * 2),
    CVT_E(I_WINC, 2048, PC, PC_PAD, 0, WS_WINC, (size_t)PC_PAD * 2048 * 2), CVT_E(I_WOUTC, 4096, 2048, 2048, 0, WS_WOUTC, (size_t)2048 * 4096 * 2),
    CVT_E(I_FWG, 2048, DFF, DFF, 1, WS_WGATE, (size_t)DFF * 2048 * 2), CVT_E(I_FWU, 2048, DFF, DFF, 1, WS_WUP, (size_t)DFF * 2048 * 2), CVT_E(I_FWD, DFF, 2048, 2048, 1, WS_WDOWN, (size_t)DFF * 2048 * 2),
    CVT_E(I_WMOD, 2048, 12288, 12288, 1, WS_WMOD, (size_t)12288 * 2048 * 2), CVT_E(I_WMOD, 2048, 12288, 12288, 2, WS_WMOD, (size_t)12288 * 2048 * 2), CVT_E(I_WMOD, 2048, 12288, 12288, 3, WS_WMOD, (size_t)12288 * 2048 * 2),
    CVT_E(I_WINAB, 2048, PAB, PAB_PAD, 1, WS_WINAB, (size_t)PAB_PAD * 2048 * 2), CVT_E(I_WOUTAB, 2048, 2048, 2048, 1, WS_WOUTAB, (size_t)2048 * 2048 * 2),
    CVT_E(I_FWG, 2048, DFF, DFF, 2, WS_WGATE, (size_t)DFF * 2048 * 2), CVT_E(I_FWU, 2048, DFF, DFF, 2, WS_WUP, (size_t)DFF * 2048 * 2), CVT_E(I_FWD, DFF, 2048, 2048, 2, WS_WDOWN, (size_t)DFF * 2048 * 2),
    CVT_E(I_WINC, 2048, PC, PC_PAD, 1, WS_WINC, (size_t)PC_PAD * 2048 * 2), CVT_E(I_WOUTC, 4096, 2048, 2048, 1, WS_WOUTC, (size_t)2048 * 4096 * 2),
    CVT_E(I_FWG, 2048, DFF, DFF, 3, WS_WGATE, (size_t)DFF * 2048 * 2), CVT_E(I_FWU, 2048, DFF, DFF, 3, WS_WUP, (size_t)DFF * 2048 * 2), CVT_E(I_FWD, DFF, 2048, 2048, 3, WS_WDOWN, (size_t)DFF * 2048 * 2) };
__device__ __forceinline__ void phase_convert(const P& p, LAS unsigned char* lds, int m_lo, int m_hi, int wg_lo, int nwg) {
    const int Z = zero_();
    const int tid = TIDX, lane = tid & 63, wave = tid >> 6;
    const int wg = (int)blockIdx.x - wg_lo;
    if (wg < 0 || wg >= nwg) return;
    const int gw = wg * 8 + wave, NGW = nwg * 8;
    LAS float* scr = (LAS float*)(lds + wave * 16640);
    const CvtMat* mats = c_mats;
#pragma unroll 1
    for (int f = m_lo; f < m_hi; ++f) {
        const int K = mats[f].K, N = mats[f].N, Npad = mats[f].Npad, total = (K / 64) * ((N + 63) / 64);
        const float* src = p.in[Z + mats[f].in_idx] + mats[f].src_off; bf16_t* dstm = (bf16_t*)((p.ws + Z) + mats[f].dst);
        for (int it = gw; it < total; it += NGW) transpose_item(src, K, N, dstm, scr, it, lane);
        if (Npad > N) {
            const size_t nvec = (size_t)(Npad - N) * K / 8; u32x4* dst = (u32x4*)(dstm + (size_t)N * K);
            for (size_t i = (size_t)wg * NT + tid; i < nvec; i += (size_t)nwg * NT) dst[i] = zero4_();
        }
    }
}
__device__ __forceinline__ void phase_convert_small(const P& p) {
    const int Z = zero_();
    const int tid = TIDX;
    const size_t gt = (size_t)blockIdx.x * NT + tid, GT = (size_t)gridDim.x * NT;
    { bf16_t* w2t = (bf16_t*)((p.ws + Z) + WS_W2T); bf16_t* a2t = (bf16_t*)((p.ws + Z) + WS_A2T);
      for (size_t i = gt; i < (size_t)2 * 1024 * 64; i += GT) { const int k = i & 63, n = (i >> 6) & 1023, l = i >> 16;
          w2t[i] = (bf16_t)f2bf(p.in[Z + I_W2][((size_t)l * 64 + k) * 1024 + n]); a2t[i] = (bf16_t)f2bf(p.in[Z + I_A2][((size_t)l * 64 + k) * 1024 + n]); } }
    { bf16_t* g2t = (bf16_t*)((p.ws + Z) + WS_G2T);
      for (size_t i = gt; i < (size_t)2 * 1024 * 160; i += GT) { const int k = i % 160, n = (i / 160) & 1023, l = i / (160 * 1024);
          g2t[i] = (bf16_t)f2bf(p.in[Z + I_G2][((size_t)l * 160 + k) * 1024 + n]); } }
    { bf16_t* wat = (bf16_t*)((p.ws + Z) + WS_WAT); bf16_t* wxt = (bf16_t*)((p.ws + Z) + WS_WXT);
      for (size_t i = gt; i < (size_t)2 * 16 * 64 * 64; i += GT) { const int k = i & 63, n = (i >> 6) & 63, lh = i >> 12;
          wat[i] = (bf16_t)f2bf(p.in[Z + I_LWA][((size_t)lh * 64 + k) * 64 + n]); wxt[i] = (bf16_t)f2bf(p.in[Z + I_LWX][((size_t)lh * 64 + k) * 64 + n]); } }
}

__device__ __forceinline__ void phase_init(const P& p) {
    const int Z = zero_();
    const size_t gt = (size_t)blockIdx.x * NT + TIDX, GT = (size_t)gridDim.x * NT;
    bf16_t* sc = (bf16_t*)((p.ws + Z) + WS_SC);
    for (size_t i = gt; i < (size_t)256 * D; i += GT) {
        const int r = i / D, c = i % D; float v = 0.f;
        if (r < NBP) v = silu_(p.in[Z + I_CP][(size_t)r * D + c]); else if (r < NSEQ) v = silu_(p.in[Z + I_CS][(size_t)(r - NBP) * D + c]);
        sc[i] = (bf16_t)f2bf(v);
    }
    { u32x4* ye = (u32x4*)((bf16_t*)((p.ws + Z) + WS_YE) + (size_t)MV * D); for (size_t i = gt; i < (size_t)(MPAD - MV) * D / 8; i += GT) ye[i] = zero4_(); }
    { u32x4* yo = (u32x4*)((bf16_t*)((p.ws + Z) + WS_YO) + (size_t)MV * 4096); for (size_t i = gt; i < (size_t)(MPAD - MV) * 4096 / 8; i += GT) yo[i] = zero4_(); }
}

__device__ __forceinline__ void phase_norm(const P& p, int layer, int which  , int nsplit, int player, int pslot, bool from_inputs, LAS unsigned char* lds) {
    const int Z = zero_();
    const int tid = TIDX, lane = tid & 63, wave = tid >> 6;
    float* X = (float*)((p.ws + Z) + WS_X); bf16_t* H = (bf16_t*)((p.ws + Z) + WS_H); const float* MOD = (const float*)((p.ws + Z) + WS_MOD);
    const float* gain = p.in[Z + (which ? I_NFFN : I_NMIX)] + (size_t)layer * D;
    for (int r = blockIdx.x * 8 + wave; r < MP; r += gridDim.x * 8) {
        u32x2* hr = (u32x2*)(H + (size_t)r * D);
        const f32x4* xr = (from_inputs && which == 0) ? (const f32x4*)(p.in[Z + I_XP] + (size_t)r * D) : (const f32x4*)(X + (size_t)r * D);
        f32x4 v[8]; float s = 0.f;
#pragma unroll
        for (int j = 0; j < 8; ++j) { v[j] = xr[lane + 64 * j]; s += v[j].x * v[j].x + v[j].y * v[j].y + v[j].z * v[j].z + v[j].w * v[j].w; }
        const float* mrow = MOD + (size_t)(r >> 11) * MODLD + (size_t)layer * 12288 + (which ? 3 * D : 0);
        f32x4 gv[8], shv[8], scv[8];
#pragma unroll
        for (int j = 0; j < 8; ++j) { const int c = (lane + 64 * j) * 4; gv[j] = *(const f32x4*)(gain + c); shv[j] = *(const f32x4*)(mrow + c); scv[j] = *(const f32x4*)(mrow + D + c); }
        float st = allreduce16(s); st += __shfl_xor(st, 16); st += __shfl_xor(st, 32);
        const float rstd = rsqrtf(st * (1.f / D) + 1e-6f);
#pragma unroll
        for (int j = 0; j < 8; ++j) {
            const f32x4 o = v[j] * rstd * gv[j] * (scv[j] + 1.f) + shv[j];
            hr[lane + 64 * j] = (u32x2){pk2(o.x, o.y), pk2(o.z, o.w)};
        }
    }
    LAS float* red = (LAS float*)lds;
    for (int b = ((int)blockIdx.x + 128) % (int)gridDim.x; b < NBS; b += gridDim.x) {
        const int r = MP + b, c = wave * 256 + lane * 4;
        f32x4 v = from_inputs ? *(const f32x4*)(p.in[Z + I_XS] + (size_t)b * D + c) : *(const f32x4*)(X + (size_t)r * D + c);
        const float* mrow = MOD + (size_t)(4 + b) * MODLD + (size_t)layer * 12288 + (which ? 3 * D : 0);
        const f32x4 g = *(const f32x4*)(gain + c), sh = *(const f32x4*)(mrow + c), sc = *(const f32x4*)(mrow + D + c);
        if (nsplit > 0) {
            const float* sl = (const float*)((p.ws + Z) + WS_SLAB) + (size_t)b * D + c;
            f32x4 t[11];
#pragma unroll
            for (int s = 0; s < 11; ++s) if (s < nsplit) t[s] = *(const f32x4*)(sl + (size_t)s * 128 * D);
            __builtin_amdgcn_sched_barrier(0);
            f32x4 a = (f32x4){0.f, 0.f, 0.f, 0.f};
#pragma unroll
            for (int s = 0; s < 11; ++s) if (s < nsplit) a = a + t[s];
            v = v + *(const f32x4*)(MOD + (size_t)(4 + b) * MODLD + (size_t)player * 12288 + (size_t)pslot * D + c) * a;
            *(f32x4*)(X + (size_t)r * D + c) = v;
        } else if (from_inputs && which == 1) *(f32x4*)(X + (size_t)r * D + c) = v;
        float s = v.x * v.x + v.y * v.y + v.z * v.z + v.w * v.w;
        s = allreduce16(s); s += __shfl_xor(s, 16); s += __shfl_xor(s, 32);
        __syncthreads();
        if (lane == 0) red[wave] = s;
        __syncthreads();
        const float rstd = rsqrtf((red[0] + red[1] + red[2] + red[3] + red[4] + red[5] + red[6] + red[7]) * (1.f / D) + 1e-6f);
        const f32x4 o = v * rstd * g * (sc + 1.f) + sh;
        *(u32x2*)(H + (size_t)r * D + c) = (u32x2){pk2(o.x, o.y), pk2(o.z, o.w)};
    }
    for (int i = blockIdx.x * NT + tid; i < (MPAD - MV) * D / 8; i += gridDim.x * NT) ((u32x4*)(H + (size_t)MV * D))[i] = zero4_();
}

__device__ __forceinline__ void phase_final_norm(const P& p, LAS unsigned char* lds) {
    const int Z = zero_();
    const int tid = TIDX, lane = tid & 63, wave = tid >> 6;
    const float* X = (const float*)((p.ws + Z) + WS_X); const float* gain = p.in[Z + I_NOUT]; const float* MOD = (const float*)((p.ws + Z) + WS_MOD);
    for (int r = blockIdx.x * 8 + wave; r < MP; r += gridDim.x * 8) {
        const f32x4* xr = (const f32x4*)(X + (size_t)r * D); f32x4* yr = (f32x4*)((p.out + Z) + (size_t)r * D);
        f32x4 v[8]; float s = 0.f;
#pragma unroll
        for (int j = 0; j < 8; ++j) { v[j] = xr[lane + 64 * j]; s += v[j].x * v[j].x + v[j].y * v[j].y + v[j].z * v[j].z + v[j].w * v[j].w; }
        f32x4 gv[8];
#pragma unroll
        for (int j = 0; j < 8; ++j) gv[j] = *(const f32x4*)(gain + (lane + 64 * j) * 4);
        float st = allreduce16(s); st += __shfl_xor(st, 16); st += __shfl_xor(st, 32);
        const float rstd = rsqrtf(st * (1.f / D) + 1e-6f);
#pragma unroll
        for (int j = 0; j < 8; ++j) yr[lane + 64 * j] = v[j] * rstd * gv[j];
    }
    LAS float* red = (LAS float*)lds;
    for (int b = ((int)blockIdx.x + 128) % (int)gridDim.x; b < NBS; b += gridDim.x) {
        const int r = MP + b, c = wave * 256 + lane * 4;
        f32x4 v = *(const f32x4*)(X + (size_t)r * D + c);
        const float* sl = (const float*)((p.ws + Z) + WS_SLAB) + (size_t)b * D + c;
        f32x4 t[11];
#pragma unroll
        for (int s = 0; s < 11; ++s) t[s] = *(const f32x4*)(sl + (size_t)s * 128 * D);
        __builtin_amdgcn_sched_barrier(0);
        f32x4 a = (f32x4){0.f, 0.f, 0.f, 0.f};
#pragma unroll
        for (int s = 0; s < 11; ++s) a = a + t[s];
        v = v + *(const f32x4*)(MOD + (size_t)(4 + b) * MODLD + (size_t)3 * 12288 + (size_t)5 * D + c) * a;
        float s = v.x * v.x + v.y * v.y + v.z * v.z + v.w * v.w;
        s = allreduce16(s); s += __shfl_xor(s, 16); s += __shfl_xor(s, 32);
        __syncthreads();
        if (lane == 0) red[wave] = s;
        __syncthreads();
        const float rstd = rsqrtf((red[0] + red[1] + red[2] + red[3] + red[4] + red[5] + red[6] + red[7]) * (1.f / D) + 1e-6f);
        *(f32x4*)((p.out + Z) + (size_t)r * D + c) = v * rstd * *(const f32x4*)(gain + c);
    }
}

constexpr int PLD_E = PAB_PAD;

template <bool SAMPLE> __device__ __forceinline__ f32x4 rw_prev4(const bf16_t* prow  , const float* srow  , bool has_prev, int col) {
    if (SAMPLE) return *(const f32x4*)(srow + col);
    const f32x4 v = ldb4(prow + col);
    return has_prev ? v : (f32x4){0.f, 0.f, 0.f, 0.f};
}
template <bool SAMPLE> __device__ __forceinline__ void rwkv_prep_unit(const P& p, int Z, int il, int u, LAS bf16_t* XS, bool alt = false, int hh_lo = 0, int hh_hi = 2) {
    constexpr int XLD = 296;
    const int tid = TIDX, lane = tid & 63, wave = tid >> 6, l15 = lane & 15, kq = lane >> 4;
    const bf16_t* proj = (const bf16_t*)((p.ws + Z) + WS_PROJ);
    float* SCB = (float*)((p.ws + Z) + (alt ? WS_GBUF : WS_MIX + MX_SCB)); float* GG = (float*)((p.ws + Z) + (alt ? WS_GBUF + (size_t)16 * MV * 384 * 4 : WS_MIX + MX_GG)); float* C123 = (float*)((p.ws + Z) + WS_MIX + MX_C123);
    const bf16_t* w2t = (const bf16_t*)((p.ws + Z) + WS_W2T) + (size_t)il * 1024 * 64;
    const bf16_t* a2t = (const bf16_t*)((p.ws + Z) + WS_A2T) + (size_t)il * 1024 * 64;
    const bf16_t* g2t = (const bf16_t*)((p.ws + Z) + WS_G2T) + (size_t)il * 1024 * 160;
    const float* mu = p.in[Z + I_MU] + (size_t)il * PA;
    const float* w0 = p.in[Z + I_W0] + (size_t)il * 1024; const float* a0 = p.in[Z + I_A0] + (size_t)il * 1024;
    const float* k_k = p.in[Z + I_KK] + (size_t)il * 1024; const float* k_a = p.in[Z + I_KA] + (size_t)il * 1024; const float* r_k = p.in[Z + I_RK] + (size_t)il * 1024;
    const float* sst = p.in[Z + I_SSHIFT] + (size_t)il * NBS * PA;
    const int R0 = u * 16;
    __syncthreads();
    {
        f32x4 cur[3], prev[3], mv[3];
#pragma unroll
        for (int q = 0; q < 3; ++q) { const int idx = tid + q * NT;
            if (idx < 16 * 72) { const int r = idx / 72, c = (idx % 72) * 4, col = 3072 + c, R = R0 + r;
                const bool hp = SAMPLE || (R & (SEQ - 1)) != 0;
                cur[q] = ldb4(proj + (size_t)R * PLD_E + col);
                prev[q] = rw_prev4<SAMPLE>(proj + (size_t)(hp ? R - 1 : R) * PLD_E, sst + (size_t)(SAMPLE ? R - MP : 0) * PA, hp, col);
                mv[q] = *(const f32x4*)(mu + col); } }
        __builtin_amdgcn_sched_barrier(0);
#pragma unroll
        for (int q = 0; q < 3; ++q) { const int idx = tid + q * NT;
            if (idx < 16 * 72) { const int r = idx / 72, c = (idx % 72) * 4;
                f32x4 x = cur[q] + (prev[q] - cur[q]) * mv[q];
                if (c < 64) { x.x = tanh_(x.x); x.y = tanh_(x.y); x.z = tanh_(x.z); x.w = tanh_(x.w); }
                else if (c >= 128) { x.x = sigmoid_(x.x); x.y = sigmoid_(x.y); x.z = sigmoid_(x.z); x.w = sigmoid_(x.w); }
                *(LAS u32x2*)(XS + r * XLD + c) = (u32x2){pk2(x.x, x.y), pk2(x.z, x.w)}; } }
    }
    __syncthreads();
    const int R = R0 + l15;
    const bool hp = SAMPLE || (R & (SEQ - 1)) != 0;
    const bf16_t* prow = proj + (size_t)(hp ? R - 1 : R) * PLD_E; const bf16_t* crow = proj + (size_t)R * PLD_E;
    const float* srow = sst + (size_t)(SAMPLE ? R - MP : 0) * PA;
#pragma unroll 1
    for (int hh = hh_lo; hh < hh_hi; ++hh) {
        const int h = wave * 2 + hh;
        f32x4 accw[4], acca[4], accg[4];
#pragma unroll
        for (int nb = 0; nb < 4; ++nb) { accw[nb] = (f32x4){0.f, 0.f, 0.f, 0.f}; acca[nb] = accw[nb]; accg[nb] = accw[nb]; }
        {
            bf16x8 fw[2][4], fa[2][4], fg[5][4];
#pragma unroll
            for (int nb = 0; nb < 4; ++nb) { const int n = h * 64 + nb * 16 + l15;
#pragma unroll
                for (int ks = 0; ks < 2; ++ks) { fw[ks][nb] = *(const bf16x8*)(w2t + (size_t)n * 64 + ks * 32 + kq * 8); fa[ks][nb] = *(const bf16x8*)(a2t + (size_t)n * 64 + ks * 32 + kq * 8); }
#pragma unroll
                for (int ks = 0; ks < 5; ++ks) fg[ks][nb] = *(const bf16x8*)(g2t + (size_t)n * 160 + ks * 32 + kq * 8); }
            __builtin_amdgcn_sched_barrier(0);
#pragma unroll
            for (int ks = 0; ks < 2; ++ks) {
                const bf16x8 bw = *(const LAS bf16x8*)(XS + l15 * XLD + ks * 32 + kq * 8);
                const bf16x8 ba = *(const LAS bf16x8*)(XS + l15 * XLD + 64 + ks * 32 + kq * 8);
#pragma unroll
                for (int nb = 0; nb < 4; ++nb) { accw[nb] = mfma16(fw[ks][nb], bw, accw[nb]); acca[nb] = mfma16(fa[ks][nb], ba, acca[nb]); }
            }
#pragma unroll
            for (int ks = 0; ks < 5; ++ks) {
                const bf16x8 bg = *(const LAS bf16x8*)(XS + l15 * XLD + 128 + ks * 32 + kq * 8);
#pragma unroll
                for (int nb = 0; nb < 4; ++nb) accg[nb] = mfma16(fg[ks][nb], bg, accg[nb]);
            }
        }
        if (!SAMPLE) {
            float* sb = SCB + ((size_t)h * MV + R) * 384;
#pragma unroll
            for (int nb = 0; nb < 4; ++nb) {
                const int cl = nb * 16 + kq * 4, c = h * 64 + cl;
                const f32x4 w0v = *(const f32x4*)(w0 + c), a0v = *(const f32x4*)(a0 + c);
                f32x4 lw, av;
#pragma unroll
                for (int j = 0; j < 4; ++j) { lw[j] = -fexp_(-softplus_(-(w0v[j] + accw[nb][j])) - 0.5f); av[j] = sigmoid_(a0v[j] + acca[nb][j]); }
                *(f32x4*)(sb + 1 * 64 + cl) = lw; *(f32x4*)(sb + 2 * 64 + cl) = av; *(f32x4*)(GG + (size_t)R * 1024 + c) = accg[nb];
            }
            continue;
        }
        f32x4 rr[4], kv[4], vv[4];
        float ss = 0.f;
#pragma unroll
        for (int nb = 0; nb < 4; ++nb) {
            const int c = h * 64 + nb * 16 + kq * 4;
            const f32x4 rc = ldb4(crow + c), kc = ldb4(crow + 1024 + c), vc = ldb4(crow + 2048 + c);
            const f32x4 rp = rw_prev4<SAMPLE>(prow, srow, hp, c), kp_ = rw_prev4<SAMPLE>(prow, srow, hp, c + 1024), vp = rw_prev4<SAMPLE>(prow, srow, hp, c + 2048);
            rr[nb] = rc + (rp - rc) * *(const f32x4*)(mu + c); kv[nb] = kc + (kp_ - kc) * *(const f32x4*)(mu + 1024 + c); vv[nb] = vc + (vp - vc) * *(const f32x4*)(mu + 2048 + c);
            const f32x4 kx = kv[nb] * *(const f32x4*)(k_k + c);
            ss += kx.x * kx.x + kx.y * kx.y + kx.z * kx.z + kx.w * kx.w;
        }
        ss += __shfl_xor(ss, 16); ss += __shfl_xor(ss, 32);
        const float rn = rsqrtf(ss + 1e-12f);
        float c1 = 0.f, c2 = 0.f, c3 = 0.f;
        float* sb = SCB + ((size_t)h * MV + R) * 384;
        f32x4 w0s[4], a0s[4], kks[4], kas[4], rks[4];
#pragma unroll
        for (int nb = 0; nb < 4; ++nb) { const int c = h * 64 + nb * 16 + kq * 4;
            w0s[nb] = *(const f32x4*)(w0 + c); a0s[nb] = *(const f32x4*)(a0 + c); kks[nb] = *(const f32x4*)(k_k + c); kas[nb] = *(const f32x4*)(k_a + c); rks[nb] = *(const f32x4*)(r_k + c); }
#pragma unroll
        for (int nb = 0; nb < 4; ++nb) {
            const int cl = nb * 16 + kq * 4, c = h * 64 + cl;
            const f32x4 r = rr[nb], k = kv[nb];
            const f32x4 w0v = w0s[nb], a0v = a0s[nb], kkv = kks[nb], kav = kas[nb], rkv = rks[nb];
            f32x4 kk, kka, wr, ww, kp;
#pragma unroll
            for (int j = 0; j < 4; ++j) {
                const float wl = -softplus_(-(w0v[j] + accw[nb][j])) - 0.5f;
                ww[j] = -fexp_(wl);
                const float a = sigmoid_(a0v[j] + acca[nb][j]);
                kk[j] = k[j] * kkv[j] * rn; kka[j] = kk[j] * a;
                kp[j] = k[j] * (1.f + (a - 1.f) * kav[j]);
                wr[j] = r[j];
                c1 += kka[j] * r[j]; c2 += kp[j] * r[j]; c3 += r[j] * kp[j] * rkv[j];
            }
            *(f32x4*)(sb + 0 * 64 + cl) = kk; *(f32x4*)(sb + 1 * 64 + cl) = ww; *(f32x4*)(sb + 2 * 64 + cl) = kka;
            *(f32x4*)(sb + 3 * 64 + cl) = kp; *(f32x4*)(sb + 4 * 64 + cl) = wr; *(f32x4*)(sb + 5 * 64 + cl) = vv[nb];
            *(f32x4*)(GG + (size_t)R * 1024 + c) = accg[nb];
        }
        c1 += __shfl_xor(c1, 16); c1 += __shfl_xor(c1, 32);
        c2 += __shfl_xor(c2, 16); c2 += __shfl_xor(c2, 32);
        c3 += __shfl_xor(c3, 16); c3 += __shfl_xor(c3, 32);
        if (kq == 0) *(f32x4*)(C123 + ((size_t)R * 16 + h) * 4) = (f32x4){c1, c2, c3, 0.f};
    }
}
__device__ __forceinline__ void phase_rwkv_prep(const P& p, int il, LAS unsigned char* lds, bool alt = false) {
    const int Z = zero_();
    LAS bf16_t* XS = (LAS bf16_t*)lds;
    for (int u = blockIdx.x; u < MP / 16 + 2 * (NBS / 16); u += gridDim.x) {
        if (u < MP / 16) rwkv_prep_unit<false>(p, Z, il, u, XS, alt);
        else { const int su = u - MP / 16; rwkv_prep_unit<true>(p, Z, il, MP / 16 + (su >> 1), XS, alt, su & 1, (su & 1) + 1); }
    }
    __syncthreads();
}

__device__ __forceinline__ void phase_rwkv_scan(const P& p, int il, LAS unsigned char* lds) {
    const int Z = zero_();
    const int tid = TIDX, il_ = tid >> 4, jq = tid & 15;
    const float* SCB = (const float*)((p.ws + Z) + WS_MIX + MX_SCB); const float* C123 = (const float*)((p.ws + Z) + WS_MIX + MX_C123);
    float* YRAW = (float*)((p.ws + Z) + WS_MIX + MX_YRAW);
    constexpr int TC = 32;
    LAS float* buf = (LAS float*)lds;
    LAS float* scal = (LAS float*)(lds + 2 * TC * 384 * 4);
    LAS float* ybuf = scal + 2 * TC * 4;
    const int NU = NSEQ * 32;
    for (int u = blockIdx.x; u < NU; u += gridDim.x) {
        const int s = u >> 5, h = (u >> 1) & 15, half = u & 1;
        const int T = s < NBP ? SEQ : 1, Rb = s < NBP ? s * SEQ : MP + (s - NBP);
        const int irow = half * 32 + il_;
        float S[4];
        if (s < NBP) { S[0] = S[1] = S[2] = S[3] = 0.f; }
        else { const f32x4 s0 = *(const f32x4*)(p.in[Z + I_SWKV] + (((size_t)il * NBS + (s - NBP)) * 16 + h) * 4096 + irow * 64 + jq * 4); S[0] = s0.x; S[1] = s0.y; S[2] = s0.z; S[3] = s0.w; }
        const float* src = SCB + ((size_t)h * MV + Rb) * 384;
        __syncthreads();
        { const int n = (T < TC ? T : TC) * 96;
          for (int i = tid; i < n; i += NT) *(LAS f32x4*)(buf + i * 4) = *(const f32x4*)(src + (size_t)i * 4);
          if (tid < (T < TC ? T : TC)) *(LAS f32x4*)(scal + tid * 4) = *(const f32x4*)(C123 + ((size_t)(Rb + tid) * 16 + h) * 4); }
        __syncthreads();
        asm volatile("" : "+v"(S[0]), "+v"(S[1]), "+v"(S[2]), "+v"(S[3]));
#define RW_STEP(tt, YOUT) do { const LAS float* st = cbuf + (tt) * 384; \
            const f32x4 kk = *(const LAS f32x4*)(st + jq * 4), w = *(const LAS f32x4*)(st + 64 + jq * 4), kka = *(const LAS f32x4*)(st + 128 + jq * 4); \
            const f32x4 kp = *(const LAS f32x4*)(st + 192 + jq * 4), wr = *(const LAS f32x4*)(st + 256 + jq * 4); \
            const float vi = st[320 + irow]; const f32x2 cc = *(const LAS f32x2*)(csc + (tt) * 4); \
            float sa = S[0] * kk.x + S[1] * kk.y + S[2] * kk.z + S[3] * kk.w; \
            float sr = S[0] * wr.x + S[1] * wr.y + S[2] * wr.z + S[3] * wr.w; \
            sa = allreduce16(sa); sr = allreduce16(sr); \
            S[0] = S[0] * w.x - sa * kka.x + vi * kp.x; S[1] = S[1] * w.y - sa * kka.y + vi * kp.y; \
            S[2] = S[2] * w.z - sa * kka.z + vi * kp.z; S[3] = S[3] * w.w - sa * kka.w + vi * kp.w; \
            YOUT = sr - sa * cc.x + vi * cc.y; } while (0)
        for (int t0 = 0, cb = 0; t0 < T; t0 += TC, cb ^= 1) {
            const int ns = (T - t0) < TC ? (T - t0) : TC;
            const int t1 = t0 + TC; const int nn = t1 < T ? ((T - t1) < TC ? (T - t1) : TC) : 0;
            f32x4 pre[6]; f32x4 pres;
            { const float* nsrc = src + (size_t)(nn == TC ? t1 : 0) * 384;
#pragma unroll
              for (int k = 0; k < 6; ++k) { const int i = tid + k * NT; pre[k] = *(const f32x4*)(nsrc + (size_t)(T >= TC ? i : (i % 96)) * 4); }
              pres = *(const f32x4*)(C123 + ((size_t)(Rb + (nn == TC ? t1 : 0) + (T >= TC ? (tid & 31) : 0)) * 16 + h) * 4); }
            const LAS float* cbuf = buf + cb * TC * 384; const LAS float* csc = scal + cb * TC * 4;
            if (ns == TC) {
#pragma unroll 1
                for (int tt = 0; tt < TC; tt += 16) {
                    float yk = 0.f;
#pragma unroll
                    for (int k = 0; k < 16; ++k) { float y; RW_STEP(tt + k, y); yk = (jq == k) ? y : yk; }
                    ybuf[(tt + jq) * 32 + il_] = yk;
                }
            } else {
                for (int t = 0; t < ns; ++t) { float y; RW_STEP(t, y); if (jq == 0) ybuf[t * 32 + il_] = y; }
            }
            __syncthreads();
            for (int i = tid; i < ns * 32; i += NT) { const int t = i >> 5, r = i & 31; YRAW[(size_t)(Rb + t0 + t) * 1024 + h * 64 + half * 32 + r] = ybuf[i]; }
            if (nn == TC) { LAS float* nb_ = buf + (cb ^ 1) * TC * 384;
#pragma unroll
              for (int k = 0; k < 6; ++k) { const int i = tid + k * NT; *(LAS f32x4*)(nb_ + i * 4) = pre[k]; }
              if (tid < TC) *(LAS f32x4*)(scal + (cb ^ 1) * TC * 4 + tid * 4) = pres; }
            __syncthreads();
        }
#undef RW_STEP
        float* so = (p.out + Z) + (s < NBP ? O_PWKV + (((size_t)il * NBP + s) * 16 + h) * 4096 : O_SWKV + (((size_t)il * NBS + (s - NBP)) * 16 + h) * 4096);
        *(f32x4*)(so + irow * 64 + jq * 4) = (f32x4){S[0], S[1], S[2], S[3]};
    }
}

__device__ __forceinline__ void rwkv_post_task(const float* __restrict__ SCB, const float* __restrict__ GG, const float* __restrict__ C123, const float* __restrict__ YRAW, bf16_t* __restrict__ YE,
                                               const float* __restrict__ gnw, const float* __restrict__ gnb, int R, int h0, int lane) {
    float y[4], v[4], c3[4], g[4], m[4], d[4], var[4];
#pragma unroll
    for (int k = 0; k < 4; ++k) { const int h = h0 + k, c = h * 64 + lane; y[k] = YRAW[(size_t)R * 1024 + c]; v[k] = SCB[((size_t)h * MV + R) * 384 + 320 + lane];
        c3[k] = C123[((size_t)R * 16 + h) * 4 + 2]; g[k] = GG[(size_t)R * 1024 + c]; }
#pragma unroll
    for (int k = 0; k < 4; ++k) m[k] = allreduce16(y[k]);
#pragma unroll
    for (int k = 0; k < 4; ++k) m[k] += __shfl_xor(m[k], 16);
#pragma unroll
    for (int k = 0; k < 4; ++k) { m[k] += __shfl_xor(m[k], 32); d[k] = y[k] - m[k] * (1.f / 64.f); var[k] = allreduce16(d[k] * d[k]); }
#pragma unroll
    for (int k = 0; k < 4; ++k) var[k] += __shfl_xor(var[k], 16);
#pragma unroll
    for (int k = 0; k < 4; ++k) var[k] += __shfl_xor(var[k], 32);
#pragma unroll
    for (int k = 0; k < 4; ++k) { const int c = (h0 + k) * 64 + lane;
        const float o = (d[k] * rsqrtf(var[k] * (1.f / 64.f) + 64e-5f) * gnw[c] + gnb[c] + c3[k] * v[k]) * g[k];
        YE[(size_t)R * D + c] = (bf16_t)f2bf(o); }
}
__device__ __forceinline__ void phase_rwkv_post(const P& p, int il) {
    const int Z = zero_();
    const int lane = TIDX & 63, wave = TIDX >> 6;
    const float* SCB = (const float*)((p.ws + Z) + WS_MIX + MX_SCB); const float* GG = (const float*)((p.ws + Z) + WS_MIX + MX_GG); const float* C123 = (const float*)((p.ws + Z) + WS_MIX + MX_C123);
    const float* YRAW = (const float*)((p.ws + Z) + WS_MIX + MX_YRAW); bf16_t* YE = (bf16_t*)((p.ws + Z) + WS_YE);
    const float* gnw = p.in[Z + I_GNW] + (size_t)il * 1024; const float* gnb = p.in[Z + I_GNB] + (size_t)il * 1024;
    for (int task = blockIdx.x * 8 + wave; task < MV * 4; task += gridDim.x * 8) rwkv_post_task(SCB, GG, C123, YRAW, YE, gnw, gnb, task >> 2, (task & 3) * 4, lane);
}

__device__ __forceinline__ f32x4 lru_conv4(const P& p, int Z, const bf16_t* proj, int il, int R, int c) {
    const float* cw = p.in[Z + I_LCW] + (size_t)il * 4 * 1024; const float* cbias = p.in[Z + I_LCB] + (size_t)il * 1024;
    f32x4 acc = *(const f32x4*)(cbias + c);
    if (R < MP) {
        const int t = R & (SEQ - 1);
#pragma unroll
        for (int j = 0; j < 4; ++j) { if (t - (3 - j) >= 0) acc = acc + *(const f32x4*)(cw + j * 1024 + c) * ldb4(proj + (size_t)(R - (3 - j)) * PLD_E + XB_OFF + c); }
    } else {
        const float* st = p.in[Z + I_SLRUC] + ((size_t)il * NBS + (R - MP)) * 3 * 1024;
#pragma unroll
        for (int j = 0; j < 3; ++j) acc = acc + *(const f32x4*)(cw + j * 1024 + c) * *(const f32x4*)(st + j * 1024 + c);
        acc = acc + *(const f32x4*)(cw + 3 * 1024 + c) * ldb4(proj + (size_t)R * PLD_E + XB_OFF + c);
    }
    return acc;
}

__device__ __forceinline__ void phase_lru_gates(const P& p, int il, LAS unsigned char* lds, int wg_lo) {
    const int Z = zero_();
    const int tid = TIDX, lane = tid & 63, wave = tid >> 6, l15 = lane & 15, kq = lane >> 4;
    const int wgi = (int)blockIdx.x - wg_lo;
    if (wgi < 0) return;
    const bf16_t* proj = (const bf16_t*)((p.ws + Z) + WS_PROJ);
    float* LA = (float*)((p.ws + Z) + WS_MIX + MX_LA); float* LB = (float*)((p.ws + Z) + WS_MIX + MX_LB);
    const bf16_t* wat = (const bf16_t*)((p.ws + Z) + WS_WAT) + (size_t)il * 16 * 4096; const bf16_t* wxt = (const bf16_t*)((p.ws + Z) + WS_WXT) + (size_t)il * 16 * 4096;
    const float* ba = p.in[Z + I_LBA] + (size_t)il * 1024; const float* bx = p.in[Z + I_LBX] + (size_t)il * 1024; const float* lam = p.in[Z + I_LLAM] + (size_t)il * 1024;
    const float* cw = p.in[Z + I_LCW] + (size_t)il * 4 * 1024; const float* cbias = p.in[Z + I_LCB] + (size_t)il * 1024;
    constexpr int XLD = 72;
    LAS bf16_t* XC = (LAS bf16_t*)(lds + wave * (16 * XLD * 2));
    for (int item = wgi * 8 + wave; item < (MV / 16) * 16; item += ((int)gridDim.x - wg_lo) * 8) {
        const int rb = item >> 4, hb = item & 15, R0 = rb * 16;
        bf16x8 fa_[2][4], fx_[2][4]; f32x4 bav_[4], bxv_[4], lv_[4];
#pragma unroll
        for (int nb = 0; nb < 4; ++nb) {
#pragma unroll
            for (int ks = 0; ks < 2; ++ks) { const size_t o = ((size_t)hb * 64 + nb * 16 + l15) * 64 + ks * 32 + kq * 8; fa_[ks][nb] = *(const bf16x8*)(wat + o); fx_[ks][nb] = *(const bf16x8*)(wxt + o); }
            const int c = hb * 64 + nb * 16 + kq * 4; bav_[nb] = *(const f32x4*)(ba + c); bxv_[nb] = *(const f32x4*)(bx + c); lv_[nb] = *(const f32x4*)(lam + c); }
        {
            const int ch = hb * 64 + l15 * 4, r0 = R0 + kq * 4;
            const f32x4 w0 = *(const f32x4*)(cw + ch), w1 = *(const f32x4*)(cw + 1024 + ch), w2 = *(const f32x4*)(cw + 2048 + ch), w3 = *(const f32x4*)(cw + 3072 + ch), cb = *(const f32x4*)(cbias + ch);
            if (R0 < MP) {
                const bool hp = (r0 & (SEQ - 1)) != 0;
                f32x4 x3 = ldb4(proj + (size_t)(hp ? r0 - 3 : r0) * PLD_E + XB_OFF + ch), x2 = ldb4(proj + (size_t)(hp ? r0 - 2 : r0) * PLD_E + XB_OFF + ch), x1 = ldb4(proj + (size_t)(hp ? r0 - 1 : r0) * PLD_E + XB_OFF + ch);
                if (!hp) { x3 = (f32x4){0.f, 0.f, 0.f, 0.f}; x2 = x3; x1 = x3; }
                f32x4 xin[4];
#pragma unroll
                for (int k = 0; k < 4; ++k) xin[k] = ldb4(proj + (size_t)(r0 + k) * PLD_E + XB_OFF + ch);
#pragma unroll
                for (int k = 0; k < 4; ++k) { const f32x4 xc = cb + w0 * x3 + w1 * x2 + w2 * x1 + w3 * xin[k]; x3 = x2; x2 = x1; x1 = xin[k];
                    *(LAS u32x2*)(XC + (kq * 4 + k) * XLD + l15 * 4) = (u32x2){pk2(xc.x, xc.y), pk2(xc.z, xc.w)}; }
            } else {
#pragma unroll
                for (int k = 0; k < 4; ++k) { const int R = r0 + k; const float* st = p.in[Z + I_SLRUC] + ((size_t)il * NBS + (R - MP)) * 3 * 1024 + ch;
                    const f32x4 xc = cb + w0 * *(const f32x4*)(st) + w1 * *(const f32x4*)(st + 1024) + w2 * *(const f32x4*)(st + 2048) + w3 * ldb4(proj + (size_t)R * PLD_E + XB_OFF + ch);
                    *(LAS u32x2*)(XC + (kq * 4 + k) * XLD + l15 * 4) = (u32x2){pk2(xc.x, xc.y), pk2(xc.z, xc.w)}; }
            }
        }
        LDS_WAIT(); asm volatile("" ::: "memory");
        f32x4 ar[4], ai[4];
#pragma unroll
        for (int nb = 0; nb < 4; ++nb) { ar[nb] = (f32x4){0.f, 0.f, 0.f, 0.f}; ai[nb] = ar[nb]; }
        __builtin_amdgcn_sched_barrier(0);
#pragma unroll
        for (int ks = 0; ks < 2; ++ks) { const bf16x8 bx_ = *(const LAS bf16x8*)(XC + l15 * XLD + ks * 32 + kq * 8);
#pragma unroll
            for (int nb = 0; nb < 4; ++nb) { ar[nb] = mfma16(fa_[ks][nb], bx_, ar[nb]); ai[nb] = mfma16(fx_[ks][nb], bx_, ai[nb]); } }
        const int R = R0 + l15;
#pragma unroll
        for (int nb = 0; nb < 4; ++nb) {
            const int c = hb * 64 + nb * 16 + kq * 4;
            const u32x2 xq = *(const LAS u32x2*)(XC + l15 * XLD + nb * 16 + kq * 4);
            const f32x4 xc = (f32x4){__uint_as_float(xq.x << 16), __uint_as_float(xq.x & 0xffff0000u), __uint_as_float(xq.y << 16), __uint_as_float(xq.y & 0xffff0000u)};
            const f32x4 bav = bav_[nb], bxv = bxv_[nb], lv = lv_[nb];
            f32x4 av, bv;
#pragma unroll
            for (int j = 0; j < 4; ++j) {
                const float rg = sigmoid_(ar[nb][j] + bav[j]), ig = sigmoid_(ai[nb][j] + bxv[j]);
                const float la = -8.f * rg * softplus_(-lv[j]);
                av[j] = fexp_(la); bv[j] = __builtin_amdgcn_sqrtf(one_minus_exp_(2.f * la)) * (ig * xc[j]);
            }
            *(f32x4*)(LA + (size_t)R * 1024 + c) = av; *(f32x4*)(LB + (size_t)R * 1024 + c) = bv;
        }
        LDS_WAIT(); asm volatile("" ::: "memory");
    }
}

__device__ __forceinline__ void lru_local_chunk(const float* __restrict__ LA, const float* __restrict__ LB, float* __restrict__ HL, float* __restrict__ PP, float* __restrict__ HEND, float* __restrict__ PEND, size_t base, size_t eoff) {
    float h = 0.f, pr = 1.f;
#pragma unroll
    for (int t0 = 0; t0 < 64; t0 += 16) {
        float a[16], b[16];
#pragma unroll
        for (int t = 0; t < 16; ++t) { a[t] = LA[base + (size_t)(t0 + t) * 1024]; b[t] = LB[base + (size_t)(t0 + t) * 1024]; }
#pragma unroll
        for (int t = 0; t < 16; ++t) { h = a[t] * h + b[t]; pr = pr * a[t]; }
    }
    HEND[eoff] = h; PEND[eoff] = pr;
}
__device__ __forceinline__ void phase_lru_local(const P& p, int rot = 0) {
    const int Z = zero_();
    const int tid = TIDX;
    const float* LA = (const float*)((p.ws + Z) + WS_MIX + MX_LA); const float* LB = (const float*)((p.ws + Z) + WS_MIX + MX_LB);
    float* HL = (float*)((p.ws + Z) + WS_MIX + MX_HL); float* PP = (float*)((p.ws + Z) + WS_MIX + MX_PP);
    float* HEND = (float*)((p.ws + Z) + WS_MIX + MX_HEND); float* PEND = (float*)((p.ws + Z) + WS_MIX + MX_PEND);
    for (int u = (blockIdx.x + rot) % gridDim.x; u < 256; u += gridDim.x) {
        const int ch = u >> 1, c = (u & 1) * 512 + tid;
        lru_local_chunk(LA, LB, HL, PP, HEND, PEND, (size_t)ch * 64 * 1024 + c, (size_t)ch * 1024 + c);
    }
}
__device__ __forceinline__ void phase_lru_carry(const P& p, int il) {
    const int Z = zero_();
    const float* HEND = (const float*)((p.ws + Z) + WS_MIX + MX_HEND); const float* PEND = (const float*)((p.ws + Z) + WS_MIX + MX_PEND);
    float* CARRY = (float*)((p.ws + Z) + WS_MIX + MX_CARRY);
    for (int i = blockIdx.x * NT + TIDX; i < NBP * 1024; i += gridDim.x * NT) {
        const int b = i >> 10, c = i & 1023; float cr = 0.f;
        for (int n = 0; n < 32; ++n) { const size_t o = (size_t)(b * 32 + n) * 1024 + c; CARRY[o] = cr; cr = HEND[o] + PEND[o] * cr; }
        (p.out + Z)[O_PLRUH + ((size_t)il * NBP + b) * 1024 + c] = cr;
    }
}
__device__ __forceinline__ void phase_lru_apply(const P& p, int il) {
    const int Z = zero_();
    const bf16_t* proj = (const bf16_t*)((p.ws + Z) + WS_PROJ);
    const float* LA = (const float*)((p.ws + Z) + WS_MIX + MX_LA); const float* LB = (const float*)((p.ws + Z) + WS_MIX + MX_LB);
    const float* HL = (const float*)((p.ws + Z) + WS_MIX + MX_HL); const float* PP = (const float*)((p.ws + Z) + WS_MIX + MX_PP); const float* CARRY = (const float*)((p.ws + Z) + WS_MIX + MX_CARRY);
    bf16_t* YE = (bf16_t*)((p.ws + Z) + WS_YE);
    for (size_t i = (size_t)blockIdx.x * NT + TIDX; i < (size_t)MV * 256; i += (size_t)gridDim.x * NT) {
        const int R = (int)(i >> 8), c = (int)(i & 255) * 4;
        f32x4 h;
        if (R < MP) { h = *(const f32x4*)(HL + (size_t)R * 1024 + c) + *(const f32x4*)(PP + (size_t)R * 1024 + c) * *(const f32x4*)(CARRY + (size_t)(R >> 6) * 1024 + c); }
        else { const int b = R - MP; h = *(const f32x4*)(LB + (size_t)R * 1024 + c) + *(const f32x4*)(LA + (size_t)R * 1024 + c) * *(const f32x4*)(p.in[Z + I_SLRUH] + ((size_t)il * NBS + b) * 1024 + c);
               *(f32x4*)((p.out + Z) + O_SLRUH + ((size_t)il * NBS + b) * 1024 + c) = h; }
        const f32x4 g = ldb4(proj + (size_t)R * PLD_E + GATE_OFF + c);
        const f32x4 y = (f32x4){h.x * gelu_tanh_(g.x), h.y * gelu_tanh_(g.y), h.z * gelu_tanh_(g.z), h.w * gelu_tanh_(g.w)};
        *(u32x2*)(YE + (size_t)R * D + 1024 + c) = (u32x2){pk2(y.x, y.y), pk2(y.z, y.w)};
    }
}

__device__ __forceinline__ void copy_row(float* __restrict__ dst, const float* __restrict__ src, int n4, int tid) {
    for (int i = tid; i < n4; i += 4 * NT) {
        f32x4 v[4];
#pragma unroll
        for (int k = 0; k < 4; ++k) if (i + k * NT < n4) v[k] = *(const f32x4*)(src + (size_t)(i + k * NT) * 4);
#pragma unroll
        for (int k = 0; k < 4; ++k) if (i + k * NT < n4) *(f32x4*)(dst + (size_t)(i + k * NT) * 4) = v[k];
    }
}
__device__ __forceinline__ void copy_row_bf16(float* __restrict__ dst, const bf16_t* __restrict__ src, int n8, int tid) {
    for (int i = tid; i < n8; i += 2 * NT) {
        u32x4 v[2];
#pragma unroll
        for (int k = 0; k < 2; ++k) if (i + k * NT < n8) v[k] = *(const u32x4*)(src + (size_t)(i + k * NT) * 8);
#pragma unroll
        for (int k = 0; k < 2; ++k) if (i + k * NT < n8) { float* d = dst + (size_t)(i + k * NT) * 8;
            *(f32x4*)(d) = (f32x4){__uint_as_float(v[k].x << 16), __uint_as_float(v[k].x & 0xffff0000u), __uint_as_float(v[k].y << 16), __uint_as_float(v[k].y & 0xffff0000u)};
            *(f32x4*)(d + 4) = (f32x4){__uint_as_float(v[k].z << 16), __uint_as_float(v[k].z & 0xffff0000u), __uint_as_float(v[k].w << 16), __uint_as_float(v[k].w & 0xffff0000u)}; }
    }
}
__device__ __forceinline__ void phase_states_even(const P& p, int il) {
    const int Z = zero_();
    const int tid = TIDX;
    const bf16_t* proj = (const bf16_t*)((p.ws + Z) + WS_PROJ); float* out = (p.out + Z);
    for (int it = blockIdx.x; it < NSEQ * 4; it += gridDim.x) {
        const int s = it >> 2, j = it & 3;
        const int last = s < NBP ? s * SEQ + SEQ - 1 : MP + (s - NBP);
        if (j == 0) copy_row_bf16(out + (s < NBP ? O_PSHIFT + ((size_t)il * NBP + s) * PA : O_SSHIFT + ((size_t)il * NBS + (s - NBP)) * PA), proj + (size_t)last * PLD_E, PA / 8, tid);
        else { const int jj = j - 1;
            float* dst = out + (s < NBP ? O_PLRUC + (((size_t)il * NBP + s) * 3 + jj) * 1024 : O_SLRUC + (((size_t)il * NBS + (s - NBP)) * 3 + jj) * 1024);
            if (s >= NBP && jj < 2) copy_row(dst, p.in[Z + I_SLRUC] + (((size_t)il * NBS + (s - NBP)) * 3 + jj + 1) * 1024, 256, tid);
            else copy_row_bf16(dst, proj + (size_t)(s < NBP ? s * SEQ + SEQ - 3 + jj : last) * PLD_E + XB_OFF, 128, tid); }
    }
}
__device__ __forceinline__ void phase_states_odd(const P& p, int ic) {
    const int Z = zero_();
    const int tid = TIDX;
    const bf16_t* proj = (const bf16_t*)((p.ws + Z) + WS_PROJ); float* out = (p.out + Z);
    for (int it = blockIdx.x; it < NSEQ * 3; it += gridDim.x) {
        const int s = it / 3, j = it % 3;
        float* dst = out + (s < NBP ? O_PGDNC + (((size_t)ic * NBP + s) * 3 + j) * QKV : O_SGDNC + (((size_t)ic * NBS + (s - NBP)) * 3 + j) * QKV);
        if (s >= NBP && j < 2) copy_row(dst, p.in[Z + I_SGDNC] + (((size_t)ic * NBS + (s - NBP)) * 3 + j + 1) * QKV, QKV / 4, tid);
        else copy_row_bf16(dst, proj + (size_t)(s < NBP ? s * SEQ + SEQ - 3 + j : MP + s - NBP) * PC_PAD, QKV / 8, tid);
    }
}
__device__ __forceinline__ void phase_states_ffn(const P& p, int layer) {
    const int Z = zero_();
    const int tid = TIDX;
    const bf16_t* G = (const bf16_t*)((p.ws + Z) + WS_GBUF); float* out = (p.out + Z);
    for (int it = blockIdx.x; it < NSEQ * 2; it += gridDim.x) {
        const int s = it >> 1, j = it & 1;
        float* dst = out + (s < NBP ? O_PFFNC + (((size_t)layer * NBP + s) * 2 + j) * DFF : O_SFFNC + (((size_t)layer * NBS + (s - NBP)) * 2 + j) * DFF);
        if (s >= NBP && j < 1) copy_row(dst, p.in[Z + I_SFFNC] + (((size_t)layer * NBS + (s - NBP)) * 2 + 1) * DFF, DFF / 4, tid);
        else copy_row_bf16(dst, G + (size_t)(s < NBP ? s * SEQ + SEQ - 2 + j : MP + s - NBP) * DFF, DFF / 8, tid);
    }
}

constexpr int PLD_O = PC_PAD;

__device__ __forceinline__ float wave_sum_dpp(float v) { v = allreduce16(v); v += __shfl_xor(v, 16); v += __shfl_xor(v, 32); return v; }
__device__ __forceinline__ void phase_gdn_prep(const P& p, int ic, LAS unsigned char* lds) {
    const int Z = zero_();
    const int tid = TIDX, lane = tid & 63, wave = tid >> 6;
    const bf16_t* proj = (const bf16_t*)((p.ws + Z) + WS_PROJ);
    bf16_t* QN = (bf16_t*)((p.ws + Z) + WS_MIX + MX_QN); bf16_t* KN = (bf16_t*)((p.ws + Z) + WS_MIX + MX_KN);
    bf16_t* KT = (bf16_t*)((p.ws + Z) + WS_MIX + MX_KT); bf16_t* VT = (bf16_t*)((p.ws + Z) + WS_MIX + MX_VT);
    float* VNAT = (float*)((p.ws + Z) + WS_MIX + MX_VNAT); float* BETA = (float*)((p.ws + Z) + WS_MIX + MX_BETA); float* GL = (float*)((p.ws + Z) + WS_MIX + MX_GL);
    const float* cw = p.in[Z + I_GCW] + (size_t)ic * 4 * QKV;
    for (int i = blockIdx.x * NT + tid; i < MV * 32; i += gridDim.x * NT) { const int r = i >> 5, hv = i & 31;
        const float bv = ldb1(proj + (size_t)r * PLD_O + B_OFF + hv), av = ldb1(proj + (size_t)r * PLD_O + A_OFF + hv);
        BETA[i] = sigmoid_(bv); GL[i] = -fexp_(p.in[Z + I_GALOG][ic * 32 + hv]) * softplus_(av + p.in[Z + I_GDTB][ic * 32 + hv]); }
    for (int it2 = blockIdx.x * 8 + wave; it2 < (MP / 64) * 64 + 512; it2 += gridDim.x * 8) {
        const bool sample = it2 >= (MP / 64) * 64;
        const int item = sample ? (MP / 64) * 64 + ((it2 - (MP / 64) * 64) >> 2) : it2, piece = sample ? (it2 & 3) : 0;
        const int tile = item >> 6, slot = item & 63, R0 = tile * 64, ch = slot * 128 + lane * 2;
        const f32x2 w0 = *(const f32x2*)(cw + ch), w1 = *(const f32x2*)(cw + QKV + ch), w2 = *(const f32x2*)(cw + 2 * QKV + ch), w3 = *(const f32x2*)(cw + 3 * QKV + ch);
        f32x2 x3 = (f32x2){0.f, 0.f}, x2 = x3, x1 = x3;
        if (!sample && (R0 & (SEQ - 1)) != 0) { x3 = ldb2(proj + (size_t)(R0 - 3) * PLD_O + ch); x2 = ldb2(proj + (size_t)(R0 - 2) * PLD_O + ch); x1 = ldb2(proj + (size_t)(R0 - 1) * PLD_O + ch); }
        unsigned tr[64];
        if (!sample) {
            f32x2 xin[16], xnx[16];
#pragma unroll
            for (int k = 0; k < 16; ++k) xin[k] = ldb2(proj + (size_t)(R0 + k) * PLD_O + ch);
#pragma unroll
            for (int tb = 0; tb < 64; tb += 16) {
                if (tb + 16 < 64) {
#pragma unroll
                    for (int k = 0; k < 16; ++k) xnx[k] = ldb2(proj + (size_t)(R0 + tb + 16 + k) * PLD_O + ch);
                }
#pragma unroll
                for (int k = 0; k < 16; ++k) {
                    const f32x2 a = w0 * x3 + w1 * x2 + w2 * x1 + w3 * xin[k];
                    x3 = x2; x2 = x1; x1 = xin[k];
                    f32x2 y = (f32x2){silu_(a.x), silu_(a.y)};
                    const int R = R0 + tb + k;
                    if (slot < 32) {
                        const float ss = wave_sum_dpp(y.x * y.x + y.y * y.y);
                        const float sc = rsqrtf(ss + 1e-6f) * (slot < 16 ? 0.08838834764831845f : 1.f);
                        y = y * sc;
                        *(unsigned*)((slot < 16 ? QN : KN) + (size_t)R * D + (slot & 15) * 128 + lane * 2) = pk2(y.x, y.y);
                    }
                    tr[tb + k] = pk2(y.x, y.y);
                }
                if (tb + 16 < 64) {
#pragma unroll
                    for (int k = 0; k < 16; ++k) xin[k] = xnx[k];
                }
            }
        } else {
#pragma unroll 1
            for (int k8 = 0; k8 < 16; k8 += 8) {
            f32x2 s0[8], s1[8], s2[8], xq[8];
#pragma unroll
            for (int k = 0; k < 8; ++k) { const int R = R0 + piece * 16 + k8 + k; const float* st = p.in[Z + I_SGDNC] + ((size_t)ic * NBS + (R - MP)) * 3 * QKV + ch;
                s0[k] = *(const f32x2*)(st); s1[k] = *(const f32x2*)(st + QKV); s2[k] = *(const f32x2*)(st + 2 * QKV); xq[k] = ldb2(proj + (size_t)R * PLD_O + ch); }
            __builtin_amdgcn_sched_barrier(0);
#pragma unroll
            for (int k = 0; k < 8; ++k) {
                const int R = R0 + piece * 16 + k8 + k;
                const f32x2 a = w0 * s0[k] + w1 * s1[k] + w2 * s2[k] + w3 * xq[k];
                f32x2 y = (f32x2){silu_(a.x), silu_(a.y)};
                if (slot < 32) {
                    const float ss = wave_sum_dpp(y.x * y.x + y.y * y.y);
                    const float sc = rsqrtf(ss + 1e-6f) * (slot < 16 ? 0.08838834764831845f : 1.f);
                    y = y * sc;
                    *(unsigned*)((slot < 16 ? QN : KN) + (size_t)R * D + (slot & 15) * 128 + lane * 2) = pk2(y.x, y.y);
                } else {
                    *(f32x2*)(VNAT + (size_t)(R - MP) * 4096 + (slot - 32) * 128 + lane * 2) = y;
                }
            }
            }
        }
        if (slot >= 16 && !sample) {
            const int b = tile >> 5, chunk = tile & 31;
            bf16_t* dst = slot < 32 ? KT + ((((size_t)b * 16 + (slot - 16)) * 32 + chunk) * 128 + lane * 2) * 64
                                    : VT + ((((size_t)b * 32 + (slot - 32)) * 32 + chunk) * 128 + lane * 2) * 64;
#pragma unroll
            for (int q = 0; q < 8; ++q) {
                u32x4 lo, hi;
#pragma unroll
                for (int j = 0; j < 4; ++j) { const unsigned a = tr[q * 8 + 2 * j], c = tr[q * 8 + 2 * j + 1]; lo[j] = (a & 0xffffu) | (c << 16); hi[j] = (a >> 16) | (c & 0xffff0000u); }
                *(u32x4*)(dst + q * 8) = lo; *(u32x4*)(dst + 64 + q * 8) = hi;
            }
        }
    }
}

__device__ __forceinline__ void phase_gdn_wy(const P& p, LAS unsigned char* lds) {
    const int Z = zero_();
    const int tid = TIDX, lane = tid & 63, wave = tid >> 6, l15 = lane & 15, kq = lane >> 4;
    const bf16_t* KN = (const bf16_t*)((p.ws + Z) + WS_MIX + MX_KN); const bf16_t* KT = (const bf16_t*)((p.ws + Z) + WS_MIX + MX_KT); const bf16_t* VT = (const bf16_t*)((p.ws + Z) + WS_MIX + MX_VT);
    const float* BETA = (const float*)((p.ws + Z) + WS_MIX + MX_BETA); const float* GL = (const float*)((p.ws + Z) + WS_MIX + MX_GL);
    bf16_t* U = (bf16_t*)((p.ws + Z) + WS_MIX + MX_U); bf16_t* W = (bf16_t*)((p.ws + Z) + WS_MIX + MX_W);
    constexpr int TLD = 72;
    LAS unsigned char* wl = lds + wave * 18432;
    LAS float* Lm = (LAS float*)wl;
    LAS bf16_t* Tb = (LAS bf16_t*)wl;
    LAS bf16_t* Tg = (LAS bf16_t*)(wl + 64 * TLD * 2);
    for (int u = blockIdx.x * 8 + wave; u < 4096; u += gridDim.x * 8) {
        const int b = u >> 10, hv = (u >> 5) & 31, ch = u & 31, hk = hv >> 1, R0 = b * SEQ + ch * 64;
        const float beta = BETA[(size_t)(R0 + lane) * 32 + hv];
        float G = GL[(size_t)(R0 + lane) * 32 + hv];
#pragma unroll
        for (int o = 1; o < 64; o <<= 1) { const float t = __shfl_up(G, o); if (lane >= o) G += t; }
        bf16x8 kf[4][4];
#pragma unroll
        for (int ib = 0; ib < 4; ++ib)
#pragma unroll
            for (int ks = 0; ks < 4; ++ks) kf[ib][ks] = *(const bf16x8*)(KN + (size_t)(R0 + ib * 16 + l15) * D + hk * 128 + ks * 32 + kq * 8);
        const float Gj[4] = {__shfl(G, l15), __shfl(G, 16 + l15), __shfl(G, 32 + l15), __shfl(G, 48 + l15)};
#pragma unroll
        for (int ib = 0; ib < 4; ++ib) {
            float Gi[4], Bi[4];
#pragma unroll
            for (int r = 0; r < 4; ++r) { Gi[r] = __shfl(G, ib * 16 + kq * 4 + r); Bi[r] = __shfl(beta, ib * 16 + kq * 4 + r); }
#pragma unroll
            for (int jb = 0; jb <= ib; ++jb) {
                f32x4 acc = (f32x4){0.f, 0.f, 0.f, 0.f};
#pragma unroll
                for (int ks = 0; ks < 4; ++ks) acc = mfma16(kf[ib][ks], kf[jb][ks], acc);
#pragma unroll
                for (int r = 0; r < 4; ++r) { const int i = ib * 16 + kq * 4 + r, j = jb * 16 + l15;
                    Lm[i * 64 + j] = (i > j) ? Bi[r] * acc[r] * fexp_(Gi[r] - Gj[jb]) : 0.f; }
            }
        }
        LDS_WAIT(); asm volatile("" ::: "memory");
        float T[64];
#pragma unroll
        for (int i = 0; i < 64; ++i) {
            float a0 = 0.f, a1 = 0.f;
#pragma unroll
            for (int j4 = 0; j4 * 4 < i; ++j4) {
                const f32x4 lv = *(const LAS f32x4*)(Lm + i * 64 + j4 * 4);
                if (j4 * 4 + 0 < i) a0 -= lv.x * T[j4 * 4 + 0];
                if (j4 * 4 + 1 < i) a1 -= lv.y * T[j4 * 4 + 1];
                if (j4 * 4 + 2 < i) a0 -= lv.z * T[j4 * 4 + 2];
                if (j4 * 4 + 3 < i) a1 -= lv.w * T[j4 * 4 + 3];
            }
            { const float sum = a0 + a1; T[i] = (lane == i) ? sum + 1.f : sum; }
        }
        asm volatile("" ::: "memory");
        { const float sb = beta, sg = beta * fexp_(G);
#pragma unroll
          for (int i = 0; i < 64; ++i) { Tb[i * TLD + lane] = (bf16_t)f2bf(T[i] * sb); Tg[i * TLD + lane] = (bf16_t)f2bf(T[i] * sg); } }
        LDS_WAIT(); asm volatile("" ::: "memory");
        const bf16_t* vt = VT + (size_t)u * 128 * 64; const bf16_t* kt = KT + ((((size_t)b * 16 + hk) * 32 + ch) * 128) * 64;
        bf16_t* uo = U + (size_t)u * 64 * 128; bf16_t* wo = W + (size_t)u * 64 * 128;
#pragma unroll 1
        for (int pass = 0; pass < 2; ++pass) {
            const bf16_t* src = pass ? kt : vt; const LAS bf16_t* Tm = pass ? Tg : Tb; bf16_t* dst = pass ? wo : uo;
            bf16x8 tf[4][2];
#pragma unroll
            for (int ib = 0; ib < 4; ++ib)
#pragma unroll
                for (int ks = 0; ks < 2; ++ks) tf[ib][ks] = *(const LAS bf16x8*)(Tm + (ib * 16 + l15) * TLD + ks * 32 + kq * 8);
#pragma unroll 2
            for (int eb = 0; eb < 8; ++eb) {
                const bf16x8 a0 = *(const bf16x8*)(src + (size_t)(eb * 16 + l15) * 64 + kq * 8), a1 = *(const bf16x8*)(src + (size_t)(eb * 16 + l15) * 64 + 32 + kq * 8);
#pragma unroll
                for (int ib = 0; ib < 4; ++ib) {
                    f32x4 acc = mfma16(a0, tf[ib][0], (f32x4){0.f, 0.f, 0.f, 0.f});
                    if (ib >= 2) acc = mfma16(a1, tf[ib][1], acc);
                    *(u32x2*)(dst + (size_t)(ib * 16 + l15) * 128 + eb * 16 + kq * 4) = (u32x2){pk2(acc[0], acc[1]), pk2(acc[2], acc[3])};
                }
            }
        }
        LDS_WAIT(); asm volatile("" ::: "memory");
    }
}

__device__ __forceinline__ void phase_gdn_scan(const P& p, int ic, LAS unsigned char* lds) {
    const int Z = zero_();
    const int tid = TIDX, lane = tid & 63, wave = tid >> 6, l15 = lane & 15, kq = lane >> 4;
    const bf16_t* QN = (const bf16_t*)((p.ws + Z) + WS_MIX + MX_QN); const bf16_t* KN = (const bf16_t*)((p.ws + Z) + WS_MIX + MX_KN); const bf16_t* KT = (const bf16_t*)((p.ws + Z) + WS_MIX + MX_KT);
    const float* GL = (const float*)((p.ws + Z) + WS_MIX + MX_GL);
    const bf16_t* U = (const bf16_t*)((p.ws + Z) + WS_MIX + MX_U); const bf16_t* W = (const bf16_t*)((p.ws + Z) + WS_MIX + MX_W);
    bf16_t* O = (bf16_t*)((p.ws + Z) + WS_MIX + MX_O);
    constexpr int LD1 = 136, LD2 = 72;
    LAS bf16_t* QS = (LAS bf16_t*)lds;
    LAS bf16_t* KS = QS + 64 * LD1;
    LAS bf16_t* WS = KS + 64 * LD1;
    LAS bf16_t* ST0 = WS + 64 * LD1;
    LAS bf16_t* ST1 = ST0 + 64 * LD1;
    LAS bf16_t* KTS = ST1 + 64 * LD1;
    LAS bf16_t* VNT = KTS + 128 * LD2;
    LAS bf16_t* VNS = VNT + 64 * LD2;
    LAS bf16_t* QK = VNS + 64 * LD2;
    for (int u = blockIdx.x; u < 256; u += gridDim.x) {
        const int b = u >> 6, hv = (u >> 1) & 31, eh = u & 1, hk = hv >> 1;
        f32x4 S[4];
#pragma unroll
        for (int eb = 0; eb < 4; ++eb) S[eb] = (f32x4){0.f, 0.f, 0.f, 0.f};
        LDS_BARRIER();
        for (int i = tid; i < 64 * LD1 / 2; i += NT) ((LAS unsigned*)ST0)[i] = 0u;
        u32x4 pq[2], pk[2], pw[2], pt[2]; u32x2 pu[2]; float pg;
#define GDN_PREFETCH(CH) do { const int R0n = b * SEQ + (CH) * 64; const size_t cun = ((size_t)(b * 32 + hv) * 32 + (CH)); const int tz = TIDX; \
            _Pragma("unroll") for (int k = 0; k < 2; ++k) { const int i = tz + k * NT, r = i >> 4, c = (i & 15) * 8; \
                pq[k] = *(const u32x4*)(QN + (size_t)(R0n + r) * D + hk * 128 + c); pk[k] = *(const u32x4*)(KN + (size_t)(R0n + r) * D + hk * 128 + c); \
                pw[k] = *(const u32x4*)(W + cun * 8192 + r * 128 + c); const int r2 = i >> 3, c2 = (i & 7) * 8; \
                pt[k] = *(const u32x4*)(KT + ((((size_t)b * 16 + hk) * 32 + (CH)) * 128 + r2) * 64 + c2); } \
            pg = GL[(size_t)(R0n + (tz & 63)) * 32 + hv]; \
            _Pragma("unroll") for (int tt = 0; tt < 2; ++tt) { const int t = (tz >> 6) * 2 + tt, eb = t >> 2, tb = t & 3; \
                pu[tt] = *(const u32x2*)(U + cun * 8192 + (size_t)(tb * 16 + (tz & 15)) * 128 + eh * 64 + eb * 16 + ((tz >> 4) & 3) * 4); } } while (0)
        GDN_PREFETCH(0);
#pragma unroll 1
        for (int ch = 0; ch < 32; ++ch) {
            const int R0 = b * SEQ + ch * 64;
            LAS bf16_t* STc = (ch & 1) ? ST1 : ST0; LAS bf16_t* STn = (ch & 1) ? ST0 : ST1;
            LDS_BARRIER();
            { const int tz = TIDX;
#pragma unroll
            for (int k = 0; k < 2; ++k) { const int i = tz + k * NT, r = i >> 4, c = (i & 15) * 8;
                *(LAS u32x4*)(QS + r * LD1 + c) = pq[k]; *(LAS u32x4*)(KS + r * LD1 + c) = pk[k]; *(LAS u32x4*)(WS + r * LD1 + c) = pw[k];
                const int r2 = i >> 3, c2 = (i & 7) * 8; *(LAS u32x4*)(KTS + r2 * LD2 + c2) = pt[k]; } }
            float G = pg;
            const u32x2 ucur[2] = {pu[0], pu[1]};
            if (ch + 1 < 32) GDN_PREFETCH(ch + 1);
#pragma unroll
            for (int o = 1; o < 64; o <<= 1) { const float t = __shfl_up(G, o); if (lane >= o) G += t; }
            const float Glast = __shfl(G, 63);
            LDS_BARRIER();
#pragma unroll
            for (int tt = 0; tt < 2; ++tt) {
                const int t = wave * 2 + tt, jb = t >> 2, ib = t & 3;
                f32x4 acc = (f32x4){0.f, 0.f, 0.f, 0.f};
#pragma unroll
                for (int ks = 0; ks < 4; ++ks) acc = mfma16(*(const LAS bf16x8*)(KS + (jb * 16 + l15) * LD1 + ks * 32 + kq * 8), *(const LAS bf16x8*)(QS + (ib * 16 + l15) * LD1 + ks * 32 + kq * 8), acc);
                const int i = ib * 16 + l15; const float Gi = __shfl(G, i);
                float o4[4];
#pragma unroll
                for (int r = 0; r < 4; ++r) { const int j = jb * 16 + kq * 4 + r; const float Gj = __shfl(G, j); o4[r] = (i >= j) ? acc[r] * fexp_(Gi - Gj) : 0.f; }
                *(LAS u32x2*)(QK + i * LD2 + jb * 16 + kq * 4) = (u32x2){pk2(o4[0], o4[1]), pk2(o4[2], o4[3])};
            }
#pragma unroll
            for (int tt = 0; tt < 2; ++tt) {
                const int t = wave * 2 + tt, eb = t >> 2, tb = t & 3;
                f32x4 acc = (f32x4){0.f, 0.f, 0.f, 0.f};
#pragma unroll
                for (int ks = 0; ks < 4; ++ks) acc = mfma16(*(const LAS bf16x8*)(STc + (eb * 16 + l15) * LD1 + ks * 32 + kq * 8), *(const LAS bf16x8*)(WS + (tb * 16 + l15) * LD1 + ks * 32 + kq * 8), acc);
                const int tok = tb * 16 + l15, e0 = eb * 16 + kq * 4;
                const u32x2 uu = ucur[tt];
                const float sc = fexp_(Glast - __shfl(G, tok));
                const float vn[4] = {bf2f(uu.x & 0xffffu) - acc[0], bf2f(uu.x >> 16) - acc[1], bf2f(uu.y & 0xffffu) - acc[2], bf2f(uu.y >> 16) - acc[3]};
#pragma unroll
                for (int r = 0; r < 4; ++r) { VNT[(e0 + r) * LD2 + tok] = (bf16_t)f2bf(vn[r]); VNS[(e0 + r) * LD2 + tok] = (bf16_t)f2bf(vn[r] * sc); }
            }
            LDS_BARRIER();
#pragma unroll
            for (int tt = 0; tt < 2; ++tt) {
                const int t = wave * 2 + tt, eb = t >> 2, tb = t & 3;
                f32x4 a1 = (f32x4){0.f, 0.f, 0.f, 0.f}, a2 = a1;
#pragma unroll
                for (int ks = 0; ks < 4; ++ks) a1 = mfma16(*(const LAS bf16x8*)(STc + (eb * 16 + l15) * LD1 + ks * 32 + kq * 8), *(const LAS bf16x8*)(QS + (tb * 16 + l15) * LD1 + ks * 32 + kq * 8), a1);
#pragma unroll
                for (int ks = 0; ks < 2; ++ks) a2 = mfma16(*(const LAS bf16x8*)(VNT + (eb * 16 + l15) * LD2 + ks * 32 + kq * 8), *(const LAS bf16x8*)(QK + (tb * 16 + l15) * LD2 + ks * 32 + kq * 8), a2);
                const int tok = tb * 16 + l15, e0 = eb * 16 + kq * 4; const float eg = fexp_(__shfl(G, tok));
                { const f32x4 ov = a1 * eg + a2; *(u32x2*)(O + (size_t)(R0 + tok) * 4096 + hv * 128 + eh * 64 + e0) = (u32x2){pk2(ov[0], ov[1]), pk2(ov[2], ov[3])}; }
            }
            { const float ge = fexp_(Glast);
              const bf16x8 k0 = *(const LAS bf16x8*)(KTS + (wave * 16 + l15) * LD2 + kq * 8), k1 = *(const LAS bf16x8*)(KTS + (wave * 16 + l15) * LD2 + 32 + kq * 8);
#pragma unroll
              for (int eb = 0; eb < 4; ++eb) {
                  f32x4 s = S[eb] * ge;
                  s = mfma16(k0, *(const LAS bf16x8*)(VNS + (eb * 16 + l15) * LD2 + kq * 8), s);
                  s = mfma16(k1, *(const LAS bf16x8*)(VNS + (eb * 16 + l15) * LD2 + 32 + kq * 8), s);
                  S[eb] = s;
                  *(LAS u32x2*)(STn + (eb * 16 + l15) * LD1 + wave * 16 + kq * 4) = (u32x2){pk2(s[0], s[1]), pk2(s[2], s[3])};
              } }
        }
#undef GDN_PREFETCH
        float* so = (p.out + Z) + O_PGDN + (((size_t)ic * NBP + b) * 32 + hv) * 16384;
#pragma unroll
        for (int eb = 0; eb < 4; ++eb)
#pragma unroll
            for (int r = 0; r < 4; ++r) so[(size_t)(wave * 16 + kq * 4 + r) * 128 + eh * 64 + eb * 16 + l15] = S[eb][r];
    }
}

__device__ __forceinline__ void phase_gdn_step(const P& p, int ic, LAS unsigned char* lds) {
    const int Z = zero_();
    const int tid = TIDX, e = tid & 127, dq = tid >> 7;
    const bf16_t* QN = (const bf16_t*)((p.ws + Z) + WS_MIX + MX_QN); const bf16_t* KN = (const bf16_t*)((p.ws + Z) + WS_MIX + MX_KN);
    const float* VNAT = (const float*)((p.ws + Z) + WS_MIX + MX_VNAT); const float* BETA = (const float*)((p.ws + Z) + WS_MIX + MX_BETA); const float* GL = (const float*)((p.ws + Z) + WS_MIX + MX_GL);
    bf16_t* O = (bf16_t*)((p.ws + Z) + WS_MIX + MX_O);
    const float* SIN = p.in[Z + I_SGDN] + (size_t)ic * NBS * 32 * 16384; float* SOUT = (p.out + Z) + O_SGDN + (size_t)ic * NBS * 32 * 16384;
    LAS float* qs = (LAS float*)lds; LAS float* ks = qs + 128; LAS float* red = ks + 128;
    float s[32], sn[32];
    int u = blockIdx.x;
    if (u < NBS * 32) {
#pragma unroll
        for (int i = 0; i < 32; ++i) sn[i] = __builtin_nontemporal_load(SIN + (size_t)u * 16384 + (size_t)(dq * 32 + i) * 128 + e);
    }
    for (; u < NBS * 32; u += gridDim.x) {
        const int b = u >> 5, hv = u & 31, hk = hv >> 1, R = MP + b;
#pragma unroll
        for (int i = 0; i < 32; ++i) s[i] = sn[i];
        const int un = u + gridDim.x;
        if (un < NBS * 32) {
#pragma unroll
            for (int i = 0; i < 32; ++i) sn[i] = __builtin_nontemporal_load(SIN + (size_t)un * 16384 + (size_t)(dq * 32 + i) * 128 + e);
        }
        LDS_BARRIER();
        if (tid < 128) qs[tid] = bf2f(QN[(size_t)R * D + hk * 128 + tid]); else if (tid < 256) ks[tid - 128] = bf2f(KN[(size_t)R * D + hk * 128 + tid - 128]);
        const float eg = fexp_(GL[(size_t)R * 32 + hv]), beta = BETA[(size_t)R * 32 + hv];
        const float vv = VNAT[(size_t)b * 4096 + hv * 128 + e];
        float* so = SOUT + (size_t)u * 16384;
        LDS_BARRIER();
        float sk = 0.f;
#pragma unroll
        for (int i = 0; i < 32; ++i) sk += s[i] * ks[dq * 32 + i];
        red[dq * 128 + e] = sk;
        LDS_BARRIER();
        sk = red[e] + red[128 + e] + red[256 + e] + red[384 + e];
        const float vn = beta * (vv - eg * sk);
        float oo = 0.f;
#pragma unroll
        for (int i = 0; i < 32; ++i) { const float x = eg * s[i] + ks[dq * 32 + i] * vn; __builtin_nontemporal_store(x, so + (size_t)(dq * 32 + i) * 128 + e); oo += x * qs[dq * 32 + i]; }
        LDS_BARRIER();
        red[dq * 128 + e] = oo;
        LDS_BARRIER();
        if (dq == 0) O[(size_t)R * 4096 + hv * 128 + e] = (bf16_t)f2bf(red[e] + red[128 + e] + red[256 + e] + red[384 + e]);
    }
}

__device__ __forceinline__ void gdn_post_task(const bf16_t* __restrict__ O, const bf16_t* __restrict__ proj, bf16_t* __restrict__ YO, f32x2 nw, int R, int hv0, int lane) {
    f32x2 o[4], z[4];
#pragma unroll
    for (int k = 0; k < 4; ++k) { o[k] = ldb2(O + (size_t)R * 4096 + (hv0 + k) * 128 + lane * 2); z[k] = ldb2(proj + (size_t)R * PLD_O + Z_OFF + (hv0 + k) * 128 + lane * 2); }
    float ss[4];
#pragma unroll
    for (int k = 0; k < 4; ++k) ss[k] = allreduce16(o[k].x * o[k].x + o[k].y * o[k].y);
#pragma unroll
    for (int k = 0; k < 4; ++k) ss[k] += __shfl_xor(ss[k], 16);
#pragma unroll
    for (int k = 0; k < 4; ++k) ss[k] += __shfl_xor(ss[k], 32);
#pragma unroll
    for (int k = 0; k < 4; ++k) { const float rs = rsqrtf(ss[k] * (1.f / 128.f) + 1e-6f);
        *(unsigned*)(YO + (size_t)R * 4096 + (hv0 + k) * 128 + lane * 2) = pk2(o[k].x * rs * nw.x * silu_(z[k].x), o[k].y * rs * nw.y * silu_(z[k].y)); }
}
__device__ __forceinline__ void phase_gdn_post(const P& p, int ic) {
    const int Z = zero_();
    const int lane = TIDX & 63, wave = TIDX >> 6;
    const bf16_t* proj = (const bf16_t*)((p.ws + Z) + WS_PROJ); const bf16_t* O = (const bf16_t*)((p.ws + Z) + WS_MIX + MX_O); bf16_t* YO = (bf16_t*)((p.ws + Z) + WS_YO);
    const f32x2 nw = *(const f32x2*)(p.in[Z + I_GNORM] + (size_t)ic * 128 + lane * 2);
    for (int task = blockIdx.x * 8 + wave; task < MV * 8; task += gridDim.x * 8) gdn_post_task(O, proj, YO, nw, task >> 3, (task & 7) * 4, lane);
}

constexpr size_t WS_CH = WS_GBUF;
constexpr size_t WS_GC = WS_CH + (size_t)2048 * 65536;
static_assert(WS_GC + (size_t)2048 * 256 <= WS_ACT, "chunk operands must fit in the gate buffer region");

__device__ __forceinline__ void phase_rwkv_chunk(const P& p, int il) {
    const int Z = zero_();
    const int tid = TIDX, lane = tid & 63, wave = tid >> 6;
    float* SCB = (float*)((p.ws + Z) + WS_MIX + MX_SCB); float* C123 = (float*)((p.ws + Z) + WS_MIX + MX_C123);
    const bf16_t* proj = (const bf16_t*)((p.ws + Z) + WS_PROJ);
    bf16_t* CH = (bf16_t*)((p.ws + Z) + WS_CH); float* GC = (float*)((p.ws + Z) + WS_GC);
    const float* mu = p.in[Z + I_MU] + (size_t)il * PA;
    for (int item = blockIdx.x * 8 + wave; item < 2048; item += gridDim.x * 8) {
        const int b = item >> 9, h = (item >> 5) & 15, n = item & 31, R0 = b * SEQ + n * 64, c = h * 64 + lane;
        const float mur = mu[c], muk = mu[1024 + c], muv = mu[2048 + c];
        const float kkw = p.in[Z + I_KK][il * 1024 + c], kaw = p.in[Z + I_KA][il * 1024 + c], rkw = p.in[Z + I_RK][il * 1024 + c];
        float* sb = SCB + ((size_t)h * MV + R0) * 384 + lane;
        const bf16_t* pr = proj + (size_t)R0 * PLD_E + c;
        bf16_t* ch = CH + (size_t)item * 32768;
        float rp = 0.f, kp_ = 0.f, vp = 0.f;
        if (n != 0) { rp = ldb1(pr - PLD_E); kp_ = ldb1(pr - PLD_E + 1024); vp = ldb1(pr - PLD_E + 2048); }
        float G = 0.f, eGprev = 1.f;
#pragma unroll 1
        for (int half = 0; half < 2; ++half) {
            unsigned tK[16], tB[16], tP[16], tV[16];
#pragma unroll
            for (int q = 0; q < 4; ++q) {
                float rc[8], kc[8], vc[8], lw[8], aa[8];
#pragma unroll
                for (int k = 0; k < 8; ++k) { const int t = half * 32 + q * 8 + k; const bf16_t* prt = pr + (size_t)t * PLD_E;
                    rc[k] = ldb1(prt); kc[k] = ldb1(prt + 1024); vc[k] = ldb1(prt + 2048); lw[k] = sb[(size_t)t * 384 + 64]; aa[k] = sb[(size_t)t * 384 + 128]; }
#pragma unroll
                for (int k = 0; k < 8; k += 2) {
                    float o[2][5];
#pragma unroll
                    for (int e = 0; e < 2; ++e) {
                        const int t = half * 32 + q * 8 + k + e;
                        const float r = rc[k + e] + (rp - rc[k + e]) * mur, kx = kc[k + e] + (kp_ - kc[k + e]) * muk, v = vc[k + e] + (vp - vc[k + e]) * muv;
                        rp = rc[k + e]; kp_ = kc[k + e]; vp = vc[k + e];
                        const float kkx = kx * kkw, a = aa[k + e];
                        const float rn = rsqrtf(wave_sum_dpp(kkx * kkx) + 1e-12f);
                        const float kk = kkx * rn, kka = kk * a, kpr = kx * (1.f + (a - 1.f) * kaw);
                        const float c3 = wave_sum_dpp(r * kpr * rkw);
                        if (lane == 0) C123[((size_t)(R0 + t) * 16 + h) * 4 + 2] = c3;
                        sb[(size_t)t * 384 + 320] = v;
                        G += lw[k + e]; const float eG = fexp_(G), ei = fexp_(-G);
                        o[e][0] = kk * eGprev; o[e][1] = r * eG; o[e][2] = kka * ei; o[e][3] = kpr * ei; o[e][4] = v; eGprev = eG;
                        ch[0 * 4096 + t * 64 + lane] = (bf16_t)f2bf(o[e][0]); ch[1 * 4096 + t * 64 + lane] = (bf16_t)f2bf(o[e][1]);
                        ch[2 * 4096 + t * 64 + lane] = (bf16_t)f2bf(o[e][2]); ch[3 * 4096 + t * 64 + lane] = (bf16_t)f2bf(o[e][3]); }
                    const int j = q * 4 + k / 2;
                    tK[j] = pk2(o[0][0], o[1][0]); tB[j] = pk2(o[0][2], o[1][2]); tP[j] = pk2(o[0][3], o[1][3]); tV[j] = pk2(o[0][4], o[1][4]);
                }
            }
#pragma unroll
            for (int q = 0; q < 4; ++q) {
                *(u32x4*)(ch + 4 * 4096 + lane * 64 + half * 32 + q * 8) = (u32x4){tK[q * 4], tK[q * 4 + 1], tK[q * 4 + 2], tK[q * 4 + 3]};
                *(u32x4*)(ch + 5 * 4096 + lane * 64 + half * 32 + q * 8) = (u32x4){tB[q * 4], tB[q * 4 + 1], tB[q * 4 + 2], tB[q * 4 + 3]};
                *(u32x4*)(ch + 6 * 4096 + lane * 64 + half * 32 + q * 8) = (u32x4){tP[q * 4], tP[q * 4 + 1], tP[q * 4 + 2], tP[q * 4 + 3]};
                *(u32x4*)(ch + 7 * 4096 + lane * 64 + half * 32 + q * 8) = (u32x4){tV[q * 4], tV[q * 4 + 1], tV[q * 4 + 2], tV[q * 4 + 3]};
            }
        }
        GC[(size_t)item * 64 + lane] = fexp_(G);
    }
}

__device__ __forceinline__ bf16x8 ch_frag(const bf16_t* m, int rb, int ks, int l15, int kq) { return *(const bf16x8*)(m + (size_t)(rb * 16 + l15) * 64 + ks * 32 + kq * 8); }

__device__ __forceinline__ void phase_rwkv_wy(const P& p, LAS unsigned char* lds) {
    const int Z = zero_();
    const int tid = TIDX, lane = tid & 63, wave = tid >> 6, l15 = lane & 15, kq = lane >> 4;
    bf16_t* CH = (bf16_t*)((p.ws + Z) + WS_CH);
    constexpr int TLD = 72;
    LAS unsigned char* wl = lds + wave * 18432;
    LAS float* Lm = (LAS float*)wl;
    LAS bf16_t* R0m = (LAS bf16_t*)wl;
    LAS bf16_t* R1m = (LAS bf16_t*)(wl + 64 * TLD * 2);
    for (int u = blockIdx.x * 8 + wave; u < 2048; u += gridDim.x * 8) {
        bf16_t* ch = CH + (size_t)u * 32768;
        {   bf16x8 kf[4][2], bf[4][2];
#pragma unroll
            for (int rb = 0; rb < 4; ++rb)
#pragma unroll
                for (int ks = 0; ks < 2; ++ks) { kf[rb][ks] = ch_frag(ch, rb, ks, l15, kq); bf[rb][ks] = ch_frag(ch + 2 * 4096, rb, ks, l15, kq); }
#pragma unroll
            for (int tb = 0; tb < 4; ++tb)
#pragma unroll
                for (int sb = 0; sb <= tb; ++sb) {
                    f32x4 acc = mfma16(kf[tb][0], bf[sb][0], (f32x4){0.f, 0.f, 0.f, 0.f}); acc = mfma16(kf[tb][1], bf[sb][1], acc);
#pragma unroll
                    for (int r = 0; r < 4; ++r) { const int t = tb * 16 + kq * 4 + r, s = sb * 16 + l15; Lm[t * 64 + s] = (t > s) ? acc[r] : 0.f; }
                }
        }
        LDS_WAIT(); asm volatile("" ::: "memory");
        float T[64];
#pragma unroll
        for (int i = 0; i < 64; ++i) {
            float a0 = 0.f, a1 = 0.f;
#pragma unroll
            for (int j4 = 0; j4 * 4 < i; ++j4) {
                const f32x4 lv = *(const LAS f32x4*)(Lm + i * 64 + j4 * 4);
                if (j4 * 4 + 0 < i) a0 -= lv.x * T[j4 * 4 + 0];
                if (j4 * 4 + 1 < i) a1 -= lv.y * T[j4 * 4 + 1];
                if (j4 * 4 + 2 < i) a0 -= lv.z * T[j4 * 4 + 2];
                if (j4 * 4 + 3 < i) a1 -= lv.w * T[j4 * 4 + 3];
            }
            { const float sum = a0 + a1; T[i] = (lane == i) ? sum + 1.f : sum; }
        }
        asm volatile("" ::: "memory");
        { unsigned long long cz = (unsigned long long)ch; asm volatile("" : "+v"(cz)); ch = (bf16_t*)cz; }
#pragma unroll
        for (int i = 0; i < 64; ++i) R0m[i * TLD + lane] = (bf16_t)f2bf(T[i]);
#pragma unroll
        for (int q = 0; q < 9; ++q) *(LAS u32x4*)((LAS unsigned char*)R1m + (q * 64 + lane) * 16) = (u32x4){0u, 0u, 0u, 0u};
        LDS_WAIT(); asm volatile("" ::: "memory");
        {   bf16x8 kf[4][2], pf[4][2];
#pragma unroll
            for (int rb = 0; rb < 4; ++rb)
#pragma unroll
                for (int ks = 0; ks < 2; ++ks) { kf[rb][ks] = ch_frag(ch, rb, ks, l15, kq); pf[rb][ks] = ch_frag(ch + 3 * 4096, rb, ks, l15, kq); }
#pragma unroll
            for (int tb = 0; tb < 4; ++tb)
#pragma unroll
                for (int sb = 0; sb <= tb; ++sb) {
                    f32x4 acc = mfma16(kf[tb][0], pf[sb][0], (f32x4){0.f, 0.f, 0.f, 0.f}); acc = mfma16(kf[tb][1], pf[sb][1], acc);
                    const int s = sb * 16 + l15, t0 = tb * 16 + kq * 4;
                    *(LAS u32x2*)(R1m + s * TLD + t0) = (u32x2){pk2(t0 + 0 > s ? acc[0] : 0.f, t0 + 1 > s ? acc[1] : 0.f), pk2(t0 + 2 > s ? acc[2] : 0.f, t0 + 3 > s ? acc[3] : 0.f)};
                }
        }
        LDS_WAIT(); asm volatile("" ::: "memory");
        {   f32x4 tbr[4][4];
#pragma unroll
            for (int sb = 0; sb < 4; ++sb)
#pragma unroll
                for (int tb = 0; tb < 4; ++tb) {
                    f32x4 acc = (f32x4){0.f, 0.f, 0.f, 0.f};
                    if (tb >= sb) {
#pragma unroll
                        for (int ks = 0; ks < 2; ++ks) acc = mfma16(*(const LAS bf16x8*)(R1m + (sb * 16 + l15) * TLD + ks * 32 + kq * 8), *(const LAS bf16x8*)(R0m + (tb * 16 + l15) * TLD + ks * 32 + kq * 8), acc);
                    }
                    tbr[sb][tb] = acc;
                }
            LDS_WAIT(); asm volatile("" ::: "memory");
#pragma unroll
            for (int sb = 0; sb < 4; ++sb)
#pragma unroll
                for (int tb = 0; tb < 4; ++tb) *(LAS u32x2*)(R1m + (tb * 16 + l15) * TLD + sb * 16 + kq * 4) = (u32x2){pk2(tbr[sb][tb][0], tbr[sb][tb][1]), pk2(tbr[sb][tb][2], tbr[sb][tb][3])};
        }
        LDS_WAIT(); asm volatile("" ::: "memory");
        bf16x8 rf[4][2];
#pragma unroll
        for (int rb = 0; rb < 4; ++rb)
#pragma unroll
            for (int ks = 0; ks < 2; ++ks) rf[rb][ks] = ch_frag(ch + 1 * 4096, rb, ks, l15, kq);
#pragma unroll 1
        for (int pass = 0; pass < 4; ++pass) {
            if ((pass & 1) == 0) {
                const bf16_t* src = ch + (pass ? 7 : 4) * 4096; const LAS bf16_t* Tm = pass ? R1m : R0m; bf16_t* dst = ch + (pass ? 2 : 0) * 4096;
                bf16x8 af[4][2];
#pragma unroll
                for (int rb = 0; rb < 4; ++rb)
#pragma unroll
                    for (int ks = 0; ks < 2; ++ks) af[rb][ks] = ch_frag(src, rb, ks, l15, kq);
#pragma unroll
                for (int tb = 0; tb < 4; ++tb) {
                    const bf16x8 t0 = *(const LAS bf16x8*)(Tm + (tb * 16 + l15) * TLD + kq * 8), t1 = *(const LAS bf16x8*)(Tm + (tb * 16 + l15) * TLD + 32 + kq * 8);
#pragma unroll
                    for (int rb = 0; rb < 4; ++rb) {
                        f32x4 acc = mfma16(af[rb][0], t0, (f32x4){0.f, 0.f, 0.f, 0.f});
                        if (tb >= 2) acc = mfma16(af[rb][1], t1, acc);
                        *(u32x2*)(dst + (size_t)(tb * 16 + l15) * 64 + rb * 16 + kq * 4) = (u32x2){pk2(acc[0], acc[1]), pk2(acc[2], acc[3])};
                    }
                }
            } else {
                bf16x8 sf[4][2];
#pragma unroll
                for (int rb = 0; rb < 4; ++rb)
#pragma unroll
                    for (int ks = 0; ks < 2; ++ks) sf[rb][ks] = ch_frag(ch + (pass == 3 ? 3 : 2) * 4096, rb, ks, l15, kq);
#pragma unroll
                for (int sb = 0; sb < 4; ++sb)
#pragma unroll
                    for (int tb = 0; tb < 4; ++tb) {
                        f32x4 acc = (f32x4){0.f, 0.f, 0.f, 0.f};
                        if (tb >= sb) { acc = mfma16(sf[sb][0], rf[tb][0], acc); acc = mfma16(sf[sb][1], rf[tb][1], acc); }
                        const int t = tb * 16 + l15, s0 = sb * 16 + kq * 4;
                        const u32x2 w = (u32x2){pk2(t >= s0 + 0 ? acc[0] : 0.f, t >= s0 + 1 ? acc[1] : 0.f), pk2(t >= s0 + 2 ? acc[2] : 0.f, t >= s0 + 3 ? acc[3] : 0.f)};
                        if (pass == 3) *(LAS u32x2*)(R0m + t * TLD + s0) = w; else *(u32x2*)(ch + 4 * 4096 + (size_t)t * 64 + s0) = w;
                    }
            }
            LDS_WAIT(); asm volatile("" ::: "memory");
        }
        {   bf16x8 vf[4][2];
#pragma unroll
            for (int rb = 0; rb < 4; ++rb)
#pragma unroll
                for (int ks = 0; ks < 2; ++ks) vf[rb][ks] = ch_frag(ch + 7 * 4096, rb, ks, l15, kq);
#pragma unroll
            for (int tb = 0; tb < 4; ++tb) {
                const bf16x8 t0 = *(const LAS bf16x8*)(R0m + (tb * 16 + l15) * TLD + kq * 8), t1 = *(const LAS bf16x8*)(R0m + (tb * 16 + l15) * TLD + 32 + kq * 8);
#pragma unroll
                for (int ib = 0; ib < 4; ++ib) {
                    f32x4 acc = mfma16(vf[ib][0], t0, (f32x4){0.f, 0.f, 0.f, 0.f});
                    if (tb >= 2) acc = mfma16(vf[ib][1], t1, acc);
                    *(u32x2*)(ch + 3 * 4096 + (size_t)(tb * 16 + l15) * 64 + ib * 16 + kq * 4) = (u32x2){pk2(acc[0], acc[1]), pk2(acc[2], acc[3])};
                }
            }
            bf16x8 pT[4][2];
#pragma unroll
            for (int rb = 0; rb < 4; ++rb)
#pragma unroll
                for (int ks = 0; ks < 2; ++ks) pT[rb][ks] = ch_frag(ch + 6 * 4096, rb, ks, l15, kq);
            f32x4 kv[4][4];
#pragma unroll
            for (int cb = 0; cb < 4; ++cb)
#pragma unroll
                for (int ib = 0; ib < 4; ++ib) { f32x4 acc = mfma16(pT[cb][0], vf[ib][0], (f32x4){0.f, 0.f, 0.f, 0.f}); kv[cb][ib] = mfma16(pT[cb][1], vf[ib][1], acc); }
            float* kvt = (float*)(ch + 6 * 4096);
#pragma unroll
            for (int cb = 0; cb < 4; ++cb)
#pragma unroll
                for (int ib = 0; ib < 4; ++ib) *(f32x4*)(kvt + (size_t)(ib * 16 + l15) * 64 + cb * 16 + kq * 4) = kv[cb][ib];
        }
        LDS_WAIT(); asm volatile("" ::: "memory");
    }
}

__device__ __forceinline__ void phase_rwkv_rec(const P& p, int il, LAS unsigned char* lds) {
    const int Z = zero_();
    const int tid = TIDX, lane = tid & 63, wave = tid >> 6, l15 = lane & 15, kq = lane >> 4;
    const bf16_t* CH = (const bf16_t*)((p.ws + Z) + WS_CH); const float* GC = (const float*)((p.ws + Z) + WS_GC);
    float* YRAW = (float*)((p.ws + Z) + WS_MIX + MX_YRAW);
    constexpr int LD = 72;
    LAS bf16_t* WkS = (LAS bf16_t*)lds; LAS bf16_t* RgS = WkS + 64 * LD; LAS bf16_t* ArS = RgS + 64 * LD; LAS bf16_t* BtS = ArS + 64 * LD;
    LAS bf16_t* MT0 = BtS + 64 * LD; LAS bf16_t* MT1 = MT0 + 32 * LD; LAS bf16_t* PT = MT1 + 32 * LD;
    const int ibw = wave >> 2, tbw = wave & 3, cbw = wave & 3;
    for (int u = blockIdx.x; u < 128; u += gridDim.x) {
        const int b = u >> 5, h = (u >> 1) & 15, ih = u & 1; const size_t cu0 = (size_t)(b * 16 + h) * 32;
        f32x4 M = (f32x4){0.f, 0.f, 0.f, 0.f};
        __syncthreads();
        for (int i = tid; i < 32 * LD / 2; i += NT) ((LAS unsigned*)MT0)[i] = 0u;
        u32x4 pw, pr, pa, pb; u32x2 pu, py; f32x4 pk, pg;
#define RW_PREFETCH(N) do { const bf16_t* chn = CH + (cu0 + (N)) * 32768; const int tz = TIDX, row = tz >> 3, c8 = (tz & 7) * 8, l15z = tz & 15, kqz = (tz >> 4) & 3, wz = tz >> 6; \
            pw = *(const u32x4*)(chn + 0 * 4096 + row * 64 + c8); pr = *(const u32x4*)(chn + 1 * 4096 + row * 64 + c8); \
            pa = *(const u32x4*)(chn + 4 * 4096 + row * 64 + c8); pb = *(const u32x4*)(chn + 5 * 4096 + row * 64 + c8); \
            const int tt = (wz & 3) * 16 + l15z, i0 = ih * 32 + (wz >> 2) * 16 + kqz * 4; \
            pu = *(const u32x2*)(chn + 2 * 4096 + tt * 64 + i0); py = *(const u32x2*)(chn + 3 * 4096 + tt * 64 + i0); \
            pk = *(const f32x4*)((const float*)(chn + 6 * 4096) + (size_t)(ih * 32 + (wz >> 2) * 16 + l15z) * 64 + (wz & 3) * 16 + kqz * 4); \
            pg = *(const f32x4*)(GC + (cu0 + (N)) * 64 + (wz & 3) * 16 + kqz * 4); } while (0)
        RW_PREFETCH(0);
#pragma unroll 1
        for (int n = 0; n < 32; ++n) {
            const int R0 = b * SEQ + n * 64;
            LAS bf16_t* MTc = (n & 1) ? MT1 : MT0; LAS bf16_t* MTn = (n & 1) ? MT0 : MT1;
            __syncthreads();
            { const int tz = TIDX, row = tz >> 3, c8 = (tz & 7) * 8;
              *(LAS u32x4*)(WkS + row * LD + c8) = pw; *(LAS u32x4*)(RgS + row * LD + c8) = pr; *(LAS u32x4*)(ArS + row * LD + c8) = pa; *(LAS u32x4*)(BtS + row * LD + c8) = pb; }
            const u32x2 ucur = pu, ycur = py; const f32x4 kvcur = pk, gcur = pg;
            if (n + 1 < 32) RW_PREFETCH(n + 1);
            __syncthreads();
            {   f32x4 acc = mfma16(*(const LAS bf16x8*)(MTc + (ibw * 16 + l15) * LD + kq * 8), *(const LAS bf16x8*)(WkS + (tbw * 16 + l15) * LD + kq * 8), (f32x4){0.f, 0.f, 0.f, 0.f});
                acc = mfma16(*(const LAS bf16x8*)(MTc + (ibw * 16 + l15) * LD + 32 + kq * 8), *(const LAS bf16x8*)(WkS + (tbw * 16 + l15) * LD + 32 + kq * 8), acc);
                const float pv[4] = {acc[0] + bf2f(ucur.x & 0xffffu), acc[1] + bf2f(ucur.x >> 16), acc[2] + bf2f(ucur.y & 0xffffu), acc[3] + bf2f(ucur.y >> 16)};
#pragma unroll
                for (int r = 0; r < 4; ++r) PT[(ibw * 16 + kq * 4 + r) * LD + tbw * 16 + l15] = (bf16_t)f2bf(pv[r]);
            }
            __syncthreads();
            {   f32x4 a1 = (f32x4){0.f, 0.f, 0.f, 0.f}, a2 = a1;
#pragma unroll
                for (int ks = 0; ks < 2; ++ks) {
                    a1 = mfma16(*(const LAS bf16x8*)(MTc + (ibw * 16 + l15) * LD + ks * 32 + kq * 8), *(const LAS bf16x8*)(RgS + (tbw * 16 + l15) * LD + ks * 32 + kq * 8), a1);
                    a2 = mfma16(*(const LAS bf16x8*)(PT + (ibw * 16 + l15) * LD + ks * 32 + kq * 8), *(const LAS bf16x8*)(ArS + (tbw * 16 + l15) * LD + ks * 32 + kq * 8), a2);
                }
                const f32x4 yl = (f32x4){bf2f(ycur.x & 0xffffu), bf2f(ycur.x >> 16), bf2f(ycur.y & 0xffffu), bf2f(ycur.y >> 16)};
                *(f32x4*)(YRAW + (size_t)(R0 + tbw * 16 + l15) * 1024 + h * 64 + ih * 32 + ibw * 16 + kq * 4) = a1 - a2 + yl;
            }
            {   f32x4 a3 = mfma16(*(const LAS bf16x8*)(BtS + (cbw * 16 + l15) * LD + kq * 8), *(const LAS bf16x8*)(PT + (ibw * 16 + l15) * LD + kq * 8), (f32x4){0.f, 0.f, 0.f, 0.f});
                a3 = mfma16(*(const LAS bf16x8*)(BtS + (cbw * 16 + l15) * LD + 32 + kq * 8), *(const LAS bf16x8*)(PT + (ibw * 16 + l15) * LD + 32 + kq * 8), a3);
                M = gcur * (M - a3 + kvcur);
                *(LAS u32x2*)(MTn + (ibw * 16 + l15) * LD + cbw * 16 + kq * 4) = (u32x2){pk2(M[0], M[1]), pk2(M[2], M[3])};
            }
        }
#undef RW_PREFETCH
        *(f32x4*)((p.out + Z) + O_PWKV + (((size_t)il * NBP + b) * 16 + h) * 4096 + (size_t)(ih * 32 + ibw * 16 + l15) * 64 + cbw * 16 + kq * 4) = M;
    }
}

__device__ __forceinline__ void phase_rwkv_step(const P& p, int il, int rot) {
    const int Z = zero_();
    const int tid = TIDX, i = tid >> 3, jq = tid & 7;
    const float* SCB = (const float*)((p.ws + Z) + WS_MIX + MX_SCB); const float* C123 = (const float*)((p.ws + Z) + WS_MIX + MX_C123);
    float* YRAW = (float*)((p.ws + Z) + WS_MIX + MX_YRAW);
    for (int u = (blockIdx.x + rot) % gridDim.x; u < NBS * 16; u += gridDim.x) {
        const int b = u >> 4, h = u & 15, R = MP + b;
        const float* st = SCB + ((size_t)h * MV + R) * 384 + jq * 8;
        const float* s0 = p.in[Z + I_SWKV] + (((size_t)il * NBS + b) * 16 + h) * 4096 + i * 64 + jq * 8;
        float* so = (p.out + Z) + O_SWKV + (((size_t)il * NBS + b) * 16 + h) * 4096 + i * 64 + jq * 8;
        const f32x4 cc = *(const f32x4*)(C123 + ((size_t)R * 16 + h) * 4);
        const float vi = SCB[((size_t)h * MV + R) * 384 + 320 + i];
        float sa = 0.f, sr = 0.f; f32x4 S[2], kk[2], w[2], ka[2], kp[2], r[2];
#pragma unroll
        for (int q = 0; q < 2; ++q) { S[q] = *(const f32x4*)(s0 + q * 4); kk[q] = *(const f32x4*)(st + q * 4); const f32x4 lw = *(const f32x4*)(st + 64 + q * 4);
            w[q] = (f32x4){fexp_(lw.x), fexp_(lw.y), fexp_(lw.z), fexp_(lw.w)}; ka[q] = *(const f32x4*)(st + 128 + q * 4); kp[q] = *(const f32x4*)(st + 192 + q * 4); r[q] = *(const f32x4*)(st + 256 + q * 4);
            sa += S[q].x * kk[q].x + S[q].y * kk[q].y + S[q].z * kk[q].z + S[q].w * kk[q].w;
            sr += S[q].x * w[q].x * r[q].x + S[q].y * w[q].y * r[q].y + S[q].z * w[q].z * r[q].z + S[q].w * w[q].w * r[q].w; }
        sa = allreduce8(sa); sr = allreduce8(sr);
#pragma unroll
        for (int q = 0; q < 2; ++q) *(f32x4*)(so + q * 4) = S[q] * w[q] - ka[q] * sa + kp[q] * vi;
        if (jq == 0) YRAW[(size_t)R * 1024 + h * 64 + i] = sr - sa * cc.x + vi * cc.y;
    }
}

#define PG8_ALIGN true
#define PG8_SP2 true
template <class Epi> __device__ __forceinline__ void run_gemm(LAS unsigned char* lds, const bf16_t* A, const bf16_t* Bt, int M, int N, int K, const Epi& E) {
    pg8::Gemm g{A, Bt, M, N, K, K}; pg8::StaticOrder S; S.init(M, N, (int)gridDim.x, (int)blockIdx.x);
    pg8::gemm_phase<Epi, pg8::StaticOrder, PG8_ALIGN, PG8_SP2>(lds, g, S, E);
}
__device__ __forceinline__ void run_gemm_split(const P& p, int Z, LAS unsigned char* lds, const bf16_t* A, const bf16_t* Bt, int K) {
    pg8::Gemm g{A, Bt, MPAD, D, 512, K}; pg8::SplitOrder S; S.init(32, 8, K / 512, 512, (int)gridDim.x, (int)((blockIdx.x + 96) % gridDim.x));
    pg8::EpiSlab E{(float*)((p.ws + Z) + WS_SLAB), 512};
    pg8::gemm_phase<pg8::EpiSlab, pg8::SplitOrder, PG8_ALIGN, PG8_SP2>(lds, g, S, E);
}
__device__ __forceinline__ void phase_gemm_mod(const P& p, LAS unsigned char* lds, int l_lo, int l_hi) {
    const int Z = zero_();
    pg8::EpiF32 E{(float*)((p.ws + Z) + WS_MOD) + (size_t)l_lo * 12288, MODLD, p.in[Z + I_BMOD] + (size_t)l_lo * 12288};
    run_gemm(lds, (const bf16_t*)((p.ws + Z) + WS_SC), (const bf16_t*)((p.ws + Z) + WS_WMOD) + (size_t)l_lo * 12288 * D, 256, (l_hi - l_lo) * 12288, D, E);
}
__device__ __forceinline__ void phase_mod_direct(const P& p, LAS unsigned char* lds) {
    const int Z = zero_();
    const int tid = TIDX, lane = tid & 63, wave = tid >> 6, i16 = lane & 15, g = lane >> 4;
    const bf16_t* SC = (const bf16_t*)((p.ws + Z) + WS_SC);
    float* MOD = (float*)((p.ws + Z) + WS_MOD);
    LAS bf16_t* As = (LAS bf16_t*)lds;
    constexpr int ALD = 520, NITEM = MODLD / 32;
    const int per_wg = (NITEM + (int)gridDim.x - 1) / (int)gridDim.x;
    const int lo = (int)blockIdx.x * per_wg, hi = lo + per_wg < NITEM ? lo + per_wg : NITEM;
#pragma unroll 1
    for (int base = lo; base < hi; base += 8) {
        const int item = base + wave; const bool act = item < hi;
        const int ng = (act ? item : lo) * 32, l = ng / 12288, nl = ng - l * 12288;
        const float* Wp = p.in[Z + I_WMOD] + (size_t)l * 2048 * 12288 + nl + 2 * i16 + (size_t)(8 * g) * 12288;
        f32x4 acc[9][2];
#pragma unroll
        for (int mt = 0; mt < 9; ++mt) { acc[mt][0] = (f32x4){0.f, 0.f, 0.f, 0.f}; acc[mt][1] = (f32x4){0.f, 0.f, 0.f, 0.f}; }
        f32x2 w0[8], w1[8];
        if (act) {
#pragma unroll
            for (int j = 0; j < 8; ++j) { w0[j] = __builtin_nontemporal_load((const f32x2*)(Wp + (size_t)j * 12288)); w1[j] = __builtin_nontemporal_load((const f32x2*)(Wp + (size_t)(32 + j) * 12288)); }
        }
        auto step = [&](f32x2 (&w)[8], int s, int sl) {
            const u32x4 p0 = (u32x4){pk2(w[0].x, w[1].x), pk2(w[2].x, w[3].x), pk2(w[4].x, w[5].x), pk2(w[6].x, w[7].x)};
            const u32x4 p1 = (u32x4){pk2(w[0].y, w[1].y), pk2(w[2].y, w[3].y), pk2(w[4].y, w[5].y), pk2(w[6].y, w[7].y)};
            const bf16x8 b0 = __builtin_bit_cast(bf16x8, p0), b1 = __builtin_bit_cast(bf16x8, p1);
            if (s + 2 < 64) {
#pragma unroll
                for (int j = 0; j < 8; ++j) w[j] = __builtin_nontemporal_load((const f32x2*)(Wp + (size_t)((s + 2) * 32 + j) * 12288));
            }
            __builtin_amdgcn_sched_barrier(0);
#pragma unroll
            for (int mt = 0; mt < 9; ++mt) { const bf16x8 a = *(const LAS bf16x8*)(As + (mt * 16 + i16) * ALD + sl * 32 + 8 * g);
                acc[mt][0] = mfma16(a, b0, acc[mt][0]); acc[mt][1] = mfma16(a, b1, acc[mt][1]); }
        };
#pragma unroll 1
        for (int kc = 0; kc < 4; ++kc) {
            LDS_BARRIER();
            for (int q = tid; q < 144 * 64; q += NT) { const int row = q >> 6, c8 = q & 63; *(LAS u32x4*)(As + row * ALD + c8 * 8) = *(const u32x4*)(SC + (size_t)row * D + kc * 512 + c8 * 8); }
            LDS_BARRIER();
            if (act) {
#pragma unroll 1
                for (int s2 = 0; s2 < 16; s2 += 2) { step(w0, kc * 16 + s2, s2); step(w1, kc * 16 + s2 + 1, s2 + 1); }
            }
        }
        if (act) {
            const f32x2 bv = *(const f32x2*)(p.in[Z + I_BMOD] + ng + 2 * i16);
            float* mp = MOD + ng + 2 * i16;
#pragma unroll
            for (int mt = 0; mt < 9; ++mt)
#pragma unroll
                for (int r = 0; r < 4; ++r) *(f32x2*)(mp + (size_t)(mt * 16 + 4 * g + r) * MODLD) = (f32x2){acc[mt][0][r] + bv.x, acc[mt][1][r] + bv.y};
            for (int rr = 144 + g; rr < 256; rr += 4) *(f32x2*)(mp + (size_t)rr * MODLD) = bv;
        }
    }
}
__device__ __forceinline__ void phase_gemm_inab(const P& p, int il, LAS unsigned char* lds) {
    const int Z = zero_();
    pg8::EpiBf16Store E{(bf16_t*)((p.ws + Z) + WS_PROJ), PAB_PAD};
    run_gemm(lds, (const bf16_t*)((p.ws + Z) + WS_H), (const bf16_t*)((p.ws + Z) + WS_WINAB) + (size_t)il * PAB_PAD * D, MPAD, PAB_PAD, D, E);
}
__device__ __forceinline__ void phase_gemm_outab(const P& p, int layer, LAS unsigned char* lds, bool zero_gate = false) {
    const int Z = zero_();
    pg8::EpiResid E{(float*)((p.ws + Z) + WS_X), zero_gate ? (const float*)((p.ws + Z) + WS_X) + (size_t)MV * D : (const float*)((p.ws + Z) + WS_MOD) + (size_t)layer * 12288 + 2 * D, layer == 0 ? p.in[Z + I_XP] : (const float*)((p.ws + Z) + WS_X)};
    run_gemm(lds, (const bf16_t*)((p.ws + Z) + WS_YE), (const bf16_t*)((p.ws + Z) + WS_WOUTAB) + (size_t)(layer >> 1) * D * D, MP, D, D, E);
    run_gemm_split(p, Z, lds, (const bf16_t*)((p.ws + Z) + WS_YE), (const bf16_t*)((p.ws + Z) + WS_WOUTAB) + (size_t)(layer >> 1) * D * D, D);
}
__device__ __forceinline__ void phase_gemm_inc(const P& p, int ic, LAS unsigned char* lds) {
    const int Z = zero_();
    pg8::EpiBf16Store E{(bf16_t*)((p.ws + Z) + WS_PROJ), PC_PAD};
    run_gemm(lds, (const bf16_t*)((p.ws + Z) + WS_H), (const bf16_t*)((p.ws + Z) + WS_WINC) + (size_t)ic * PC_PAD * D, MPAD, PC_PAD, D, E);
}
__device__ __forceinline__ void phase_gemm_outc(const P& p, int layer, LAS unsigned char* lds, bool zero_gate = false) {
    const int Z = zero_();
    pg8::EpiResid E{(float*)((p.ws + Z) + WS_X), zero_gate ? (const float*)((p.ws + Z) + WS_X) + (size_t)MV * D : (const float*)((p.ws + Z) + WS_MOD) + (size_t)layer * 12288 + 2 * D, (const float*)((p.ws + Z) + WS_X)};
    run_gemm(lds, (const bf16_t*)((p.ws + Z) + WS_YO), (const bf16_t*)((p.ws + Z) + WS_WOUTC) + (size_t)(layer >> 1) * D * 4096, MP, D, 4096, E);
    run_gemm_split(p, Z, lds, (const bf16_t*)((p.ws + Z) + WS_YO), (const bf16_t*)((p.ws + Z) + WS_WOUTC) + (size_t)(layer >> 1) * D * 4096, 4096);
}
__device__ __forceinline__ void phase_gemm_gate(const P& p, int layer, LAS unsigned char* lds) {
    const int Z = zero_();
    pg8::EpiBf16Store E{(bf16_t*)((p.ws + Z) + WS_GBUF), DFF};
    run_gemm(lds, (const bf16_t*)((p.ws + Z) + WS_H), (const bf16_t*)((p.ws + Z) + WS_WGATE) + (size_t)layer * DFF * D, MPAD, DFF, D, E);
}
__device__ __forceinline__ void phase_gemm_up(const P& p, int layer, LAS unsigned char* lds) {
    const int Z = zero_();
    pg8::EpiFfnUp E{(bf16_t*)((p.ws + Z) + WS_ACT), (const bf16_t*)((p.ws + Z) + WS_GBUF), p.in[Z + I_FCW] + (size_t)layer * 3 * DFF, p.in[Z + I_FCB] + (size_t)layer * DFF, p.in[Z + I_SFFNC] + (size_t)layer * NBS * 2 * DFF};
    run_gemm(lds, (const bf16_t*)((p.ws + Z) + WS_H), (const bf16_t*)((p.ws + Z) + WS_WUP) + (size_t)layer * DFF * D, MPAD, DFF, D, E);
}
__device__ __forceinline__ void phase_gemm_down(const P& p, int layer, LAS unsigned char* lds, bool zero_gate = false) {
    const int Z = zero_();
    pg8::EpiResid E{(float*)((p.ws + Z) + WS_X), zero_gate ? (const float*)((p.ws + Z) + WS_X) + (size_t)MV * D : (const float*)((p.ws + Z) + WS_MOD) + (size_t)layer * 12288 + 5 * D, (const float*)((p.ws + Z) + WS_X)};
    run_gemm(lds, (const bf16_t*)((p.ws + Z) + WS_ACT), (const bf16_t*)((p.ws + Z) + WS_WDOWN) + (size_t)layer * D * DFF, MP, D, DFF, E);
    run_gemm_split(p, Z, lds, (const bf16_t*)((p.ws + Z) + WS_ACT), (const bf16_t*)((p.ws + Z) + WS_WDOWN) + (size_t)layer * D * DFF, DFF);
}

#define XB_TMO      128
#define XB_XCNT(j)  (256  + 64 * (j))
#define XB_XSUB(j)  (1280 + 64 * (j))
#define XB_XGEN(j)  (2304 + 64 * (j))
#define XB_TOP      3328
#define XB_TOPGEN   3392
#define XCD_BAR_WORDS 3456
#define XB_SPIN_CAP (1u << 18)
#define LAS __attribute__((address_space(3)))

__device__ __forceinline__ unsigned xb_ld(unsigned* p)              { return __hip_atomic_load(p, __ATOMIC_RELAXED, __HIP_MEMORY_SCOPE_AGENT); }
__device__ __forceinline__ unsigned xb_add(unsigned* p, unsigned v) { return __hip_atomic_fetch_add(p, v, __ATOMIC_RELAXED, __HIP_MEMORY_SCOPE_AGENT); }
__device__ __forceinline__ unsigned xb_xcc_id() { return (unsigned)__builtin_amdgcn_s_getreg((3 << 11) | 20) & 0xFu; }
#define XB_SPIN(cond, bar) do { unsigned _sp = 0; while (cond) { __builtin_amdgcn_s_sleep(1); \
    if ((++_sp & 255u) == 0u) { if (xb_ld(&(bar)[XB_TMO])) break; if (_sp > XB_SPIN_CAP) { atomicAdd(&(bar)[XB_TMO], 1u); break; } } } } while (0)

struct XcdBarrier {
    unsigned* bar; unsigned x;
    volatile LAS unsigned* st;
};

__device__ __forceinline__ XcdBarrier xcd_barrier_post(unsigned* bar, volatile LAS unsigned* st) {
    XcdBarrier b; b.bar = bar; b.x = xb_xcc_id(); b.st = st;
    if (threadIdx.x == 0) (void)xb_add(&bar[XB_XCNT(b.x)], 1u);
    return b;
}
__device__ __forceinline__ void xcd_barrier_complete(unsigned* bar, unsigned x, unsigned& nloc, unsigned& nx) {
    const unsigned G = gridDim.x * gridDim.y * gridDim.z;
    unsigned sum, cnt, mine, sp = 0u;
    for (;;) {
        sum = 0u; cnt = 0u; mine = 0u;
#pragma unroll
        for (unsigned j = 0; j < 16; ++j) { const unsigned c = xb_ld(&bar[XB_XCNT(j)]); sum += c; cnt += (c > 0u) ? 1u : 0u; mine = (j == x) ? c : mine; }
        if (sum == G) break;
        __builtin_amdgcn_s_sleep(1);
        if ((++sp & 255u) == 0u) { if (xb_ld(&bar[XB_TMO])) break; if (sp > XB_SPIN_CAP) { atomicAdd(&bar[XB_TMO], 1u); break; } }
    }
    nloc = mine > 0u ? mine : 1u; nx = cnt > 0u ? cnt : 1u;
}

__device__ __forceinline__ void xcd_barrier(const XcdBarrier& b) {
    asm volatile("s_waitcnt vmcnt(0)" ::: "memory");
    __syncthreads();
    if (threadIdx.x == 0) {
        unsigned* bar = b.bar;
        __builtin_amdgcn_s_waitcnt(0);
        unsigned nloc = b.st[0], nx = b.st[1];
        if (nloc == 0u) { xcd_barrier_complete(bar, b.x, nloc, nx); b.st[0] = nloc; b.st[1] = nx; }
        const unsigned old = xb_add(&bar[XB_XSUB(b.x)], 1u);
        const unsigned gen = old / nloc;
        if (old + 1u == (gen + 1u) * nloc) {
            __builtin_amdgcn_fence(__ATOMIC_RELEASE, "agent");
            asm volatile("s_waitcnt vmcnt(0)" ::: "memory");
            const unsigned og = xb_add(&bar[XB_TOP], 1u);
            const unsigned tg = og / nx;
            if (og + 1u == (tg + 1u) * nx) xb_add(&bar[XB_TOPGEN], 1u);
            else XB_SPIN(xb_ld(&bar[XB_TOPGEN]) == tg, bar);
            __builtin_amdgcn_fence(__ATOMIC_ACQUIRE, "agent");
            xb_add(&bar[XB_XGEN(b.x)], 1u);
            asm volatile("s_waitcnt vmcnt(0)" ::: "memory");
        } else {
            XB_SPIN(xb_ld(&bar[XB_XGEN(b.x)]) == gen, bar);
            __builtin_amdgcn_fence(__ATOMIC_ACQUIRE, "agent");
            asm volatile("s_waitcnt vmcnt(0)" ::: "memory");
        }
    }
    __syncthreads();
}

__device__ __forceinline__ void phase_lru_apply2(const P& p, int il, int rot) {
    const int Z = zero_();
    const int tid = TIDX;
    const bf16_t* proj = (const bf16_t*)((p.ws + Z) + WS_PROJ);
    const float* LA = (const float*)((p.ws + Z) + WS_MIX + MX_LA); const float* LB = (const float*)((p.ws + Z) + WS_MIX + MX_LB);
    const float* HL = (const float*)((p.ws + Z) + WS_MIX + MX_HL); const float* PP = (const float*)((p.ws + Z) + WS_MIX + MX_PP);
    const float* HEND = (const float*)((p.ws + Z) + WS_MIX + MX_HEND); const float* PEND = (const float*)((p.ws + Z) + WS_MIX + MX_PEND);
    bf16_t* YE = (bf16_t*)((p.ws + Z) + WS_YE);
    for (int u = (blockIdx.x + rot) % gridDim.x; u < 256; u += gridDim.x) {
        const int chn = u >> 1, c = (u & 1) * 512 + tid, b = chn >> 5, n = chn & 31;
        float cr = 0.f;
        for (int m = 0; m < n; ++m) { const size_t o = (size_t)(b * 32 + m) * 1024 + c; cr = HEND[o] + PEND[o] * cr; }
        if (n == 31) { const size_t o = (size_t)(b * 32 + 31) * 1024 + c; (p.out + Z)[O_PLRUH + ((size_t)il * NBP + b) * 1024 + c] = HEND[o] + PEND[o] * cr; }
        float h = cr;
        float a[8], bb[8], gg[8], an[8], bn[8], gn[8];
#pragma unroll
        for (int k = 0; k < 8; ++k) { const size_t R = (size_t)chn * 64 + k; a[k] = LA[R * 1024 + c]; bb[k] = LB[R * 1024 + c]; gg[k] = ldb1(proj + R * PLD_E + GATE_OFF + c); }
#pragma unroll 1
        for (int t0 = 0; t0 < 64; t0 += 8) {
            if (t0 + 8 < 64) {
#pragma unroll
                for (int k = 0; k < 8; ++k) { const size_t R = (size_t)chn * 64 + t0 + 8 + k; an[k] = LA[R * 1024 + c]; bn[k] = LB[R * 1024 + c]; gn[k] = ldb1(proj + R * PLD_E + GATE_OFF + c); }
            }
#pragma unroll
            for (int k = 0; k < 8; ++k) { const size_t R = (size_t)chn * 64 + t0 + k; h = a[k] * h + bb[k]; YE[R * D + 1024 + c] = (bf16_t)f2bf(h * gelu_tanh_(gg[k])); }
#pragma unroll
            for (int k = 0; k < 8; ++k) { a[k] = an[k]; bb[k] = bn[k]; gg[k] = gn[k]; }
        }
    }
    for (int i = blockIdx.x * NT + tid; i < NBS * 256; i += gridDim.x * NT) {
        const int b = i >> 8, c = (i & 255) * 4; const size_t R = (size_t)MP + b;
        const f32x4 h = *(const f32x4*)(LB + R * 1024 + c) + *(const f32x4*)(LA + R * 1024 + c) * *(const f32x4*)(p.in[Z + I_SLRUH] + ((size_t)il * NBS + b) * 1024 + c);
        *(f32x4*)((p.out + Z) + O_SLRUH + ((size_t)il * NBS + b) * 1024 + c) = h;
        const f32x4 g = ldb4(proj + R * PLD_E + GATE_OFF + c);
        *(u32x2*)(YE + R * D + 1024 + c) = (u32x2){pk2(h.x * gelu_tanh_(g.x), h.y * gelu_tanh_(g.y)), pk2(h.z * gelu_tanh_(g.z), h.w * gelu_tanh_(g.w))};
    }
}

constexpr int CW_BAR = 4096;
constexpr int XB_LDS_OFF = LDS_BYTES - 16;

__global__ void __launch_bounds__(NT, 2) fwd_kernel(P p) {
    extern __shared__ __attribute__((aligned(16))) unsigned char smem[];
    LAS unsigned char* lds = (LAS unsigned char*)smem;
    if (threadIdx.x == 0) *(LAS u32x4*)(lds + XB_LDS_OFF) = (u32x4){0u, 0u, 0u, 0u};
    __syncthreads();
    (void)xcd_barrier_post((unsigned*)((p.ws + zero_()) + WS_CTL) + CW_BAR, (volatile LAS unsigned*)(lds + XB_LDS_OFF));
#define GRID_BAR() do { XcdBarrier b2; b2.bar = (unsigned*)((p.ws + zero_()) + WS_CTL) + CW_BAR; unsigned xx = xb_xcc_id(); asm volatile("" : "+s"(xx)); b2.x = xx; b2.st = (volatile LAS unsigned*)(lds + XB_LDS_OFF); xcd_barrier(b2); } while (0)

    phase_init(p);
    phase_convert_small(p);
    phase_convert(p, lds, 1, 6, 0, (int)gridDim.x);
    phase_convert(p, lds, 7, 11, 0, (int)gridDim.x);
    phase_convert(p, lds, 14, 19, 0, (int)gridDim.x);
    phase_convert(p, lds, 20, 24, 0, (int)gridDim.x);
    GRID_BAR();
    phase_mod_direct(p, lds);
    GRID_BAR();
#pragma unroll 1
    for (int layer = 0; layer < 4; ++layer) {
        const int il = layer >> 1;
        phase_norm(p, layer, 0, layer > 0 ? 11 : 0, layer - 1, 5, layer == 0, lds);
        GRID_BAR();
        if ((layer & 1) == 0) {
            phase_gemm_inab(p, il, lds);
            GRID_BAR();
            phase_rwkv_prep(p, il, lds);
            phase_lru_gates(p, il, lds, 16);
            phase_states_even(p, il);
            GRID_BAR();
            phase_rwkv_chunk(p, il);
            GRID_BAR();
            phase_rwkv_wy(p, lds);
            phase_rwkv_step(p, il, 128);
            phase_lru_local(p, 64);
            GRID_BAR();
            phase_rwkv_rec(p, il, lds);
            phase_convert(p, lds, layer == 0 ? 6 : 19, layer == 0 ? 7 : 20, (int)gridDim.x / 2, (int)gridDim.x / 2);
            GRID_BAR();
            phase_rwkv_post(p, il);
            phase_lru_apply2(p, il, 0);
            GRID_BAR();
            phase_gemm_outab(p, layer, lds);
        } else {
            phase_gemm_inc(p, il, lds);
            GRID_BAR();
            phase_gdn_prep(p, il, lds);
            phase_states_odd(p, il);
            GRID_BAR();
            phase_gdn_wy(p, lds);
            phase_gdn_step(p, il, lds);
            GRID_BAR();
            phase_gdn_scan(p, il, lds);
            GRID_BAR();
            phase_gdn_post(p, il);
            GRID_BAR();
            phase_gemm_outc(p, layer, lds);
        }
        GRID_BAR();
        phase_norm(p, layer, 1, (layer & 1) ? 8 : 4, layer, 2, layer == 0, lds);
        GRID_BAR();
        phase_gemm_gate(p, layer, lds);
        GRID_BAR();
        phase_gemm_up(p, layer, lds);
        phase_states_ffn(p, layer);
        GRID_BAR();
        phase_gemm_down(p, layer, lds);
        GRID_BAR();
    }
    phase_final_norm(p, lds);
}

extern "C" void kernel_launch(void* const* d_in, const int* in_sizes, int n_in, void* d_out, int out_size, void* d_ws, size_t ws_size, hipStream_t stream) {
    static int grid = 0;
    if (grid == 0) {
        if (n_in != N_IN || (size_t)out_size != O_TOTAL || ws_size < WS_END) { fprintf(stderr, "kernel_launch: unexpected shapes (n_in %d, out %d, ws %zu need %zu)\n", n_in, out_size, ws_size, (size_t)WS_END); grid = -1; return; }
        int dev = 0, cus = 0, per_cu = 0;
        if (hipGetDevice(&dev) != hipSuccess || hipDeviceGetAttribute(&cus, hipDeviceAttributeMultiprocessorCount, dev) != hipSuccess) { grid = -1; return; }
        if (hipFuncSetAttribute((const void*)fwd_kernel, hipFuncAttributeMaxDynamicSharedMemorySize, LDS_BYTES) != hipSuccess) { fprintf(stderr, "kernel_launch: hipFuncSetAttribute failed\n"); grid = -1; return; }
        if (hipOccupancyMaxActiveBlocksPerMultiprocessor(&per_cu, (const void*)fwd_kernel, NT, LDS_BYTES) != hipSuccess || per_cu < 1) fprintf(stderr, "kernel_launch: occupancy query reports %d workgroups per CU\n", per_cu);
        (void)hipGetLastError();
        grid = cus;
    }
    if (grid < 0) return;
    (void)hipMemsetAsync((char*)d_ws + WS_CTL, 0, CTL_BYTES, stream);
    P p{};
    for (int i = 0; i < N_IN; ++i) p.in[i] = (const float*)d_in[i];
    p.out = (float*)d_out; p.ws = (unsigned char*)d_ws;
    hipLaunchKernelGGL(fwd_kernel, dim3(grid), dim3(NT), LDS_BYTES, stream, p);
}
```
